# Optimizing an MI355X kernel written in HIP

```python
import math
import jax, jax.numpy as jnp
from jax import lax
import numpy as np

D_MODEL = 4096
BATCH = 2
SEQ = 4096
DEPTH = 4

PLE_DIM = 256
BLOCK = 128
EPS = 1e-6
FOX_HEADS = 16
FOX_HEAD_DIM = 128
FOX_WIDTH = FOX_HEADS * FOX_HEAD_DIM
SWA_Q_HEADS = 32
SWA_KV_HEADS = 4
SWA_HEAD_DIM = 64
SWA_WIDTH = SWA_Q_HEADS * SWA_HEAD_DIM
SWA_KV_WIDTH = SWA_KV_HEADS * SWA_HEAD_DIM
SWA_WINDOW = 128
DSA_HEADS = 32
DSA_QK_DIM = 128
DSA_V_DIM = 128
DSA_WIDTH = DSA_HEADS * DSA_V_DIM
DSA_Q_LATENT = 1024
DSA_KV_LATENT = 512
IDX_HEADS = 32
IDX_DIM = 64
TOPK_MAX = 256
T5_BUCKETS = 32
T5_MAX_DIST = 128
T5_COLS = SWA_Q_HEADS + DSA_HEADS

EVEN_SIZES = (FOX_WIDTH, FOX_WIDTH, FOX_WIDTH, FOX_HEADS, FOX_WIDTH,
              SWA_WIDTH, SWA_KV_WIDTH, SWA_KV_WIDTH, SWA_WIDTH)
EVEN_IN = 4 * FOX_WIDTH + FOX_HEADS + 2 * SWA_WIDTH + 2 * SWA_KV_WIDTH
EVEN_OUT = FOX_WIDTH + SWA_WIDTH
ODD_SIZES = (DSA_Q_LATENT, DSA_KV_LATENT, IDX_DIM, IDX_HEADS, DSA_WIDTH)
ODD_IN = DSA_Q_LATENT + DSA_KV_LATENT + IDX_DIM + IDX_HEADS + DSA_WIDTH
N_EVEN = (DEPTH + 1) // 2
N_ODD = DEPTH // 2

kernel_name = 'hybrid_fox_swa_dsa_block'

F32 = jnp.float32


def _split(t, sizes):
    offs = [int(v) for v in np.cumsum(sizes)[:-1]]
    return jnp.split(t, offs, axis=-1)


def rms_norm(x, g):
    xf = x.astype(F32)
    y = xf * lax.rsqrt(jnp.mean(xf * xf, axis=-1, keepdims=True) + EPS)
    return (y * g.astype(F32)).astype(x.dtype)


def layer_norm(x, g, b):
    xf = x.astype(F32)
    mu = jnp.mean(xf, axis=-1, keepdims=True)
    xc = xf - mu
    var = jnp.mean(xc * xc, axis=-1, keepdims=True)
    return (xc * lax.rsqrt(var + EPS) * g.astype(F32) + b.astype(F32)).astype(x.dtype)


def t5_bucket(rel):
    n = jnp.maximum(rel, 0)
    max_exact = T5_BUCKETS // 2
    nf = jnp.maximum(n, 1).astype(F32)
    large = max_exact + (jnp.log(nf / max_exact) / math.log(T5_MAX_DIST / max_exact)
                         * (T5_BUCKETS - max_exact)).astype(jnp.int32)
    large = jnp.minimum(large, T5_BUCKETS - 1)
    return jnp.where(n < max_exact, n, large)


def fox_attention(q, k, v, log_f):
    B, S, H, Dh = q.shape
    nb = S // BLOCK
    scale = Dh ** -0.5
    cum = jnp.cumsum(log_f, axis=1)
    cum_t = cum.transpose(0, 2, 1)
    kpos = jnp.arange(S)
    qb = q.reshape(B, nb, BLOCK, H, Dh).swapaxes(0, 1)
    cb = cum.reshape(B, nb, BLOCK, H).swapaxes(0, 1)

    def one_block(args):
        blk, q_blk, c_blk = args
        s = jnp.einsum('bqhd,bkhd->bhqk', q_blk, k, preferred_element_type=F32) * scale
        s = s + (c_blk.transpose(0, 2, 1)[:, :, :, None] - cum_t[:, :, None, :])
        qpos = blk * BLOCK + jnp.arange(BLOCK)
        causal = kpos[None, :] <= qpos[:, None]
        s = jnp.where(causal[None, None], s, -jnp.inf)
        pr = jax.nn.softmax(s, axis=-1)
        return jnp.einsum('bhqk,bkhd->bqhd', pr.astype(v.dtype), v)

    out = lax.map(one_block, (jnp.arange(nb), qb, cb))
    return out.swapaxes(0, 1).reshape(B, S, H, Dh)


def swa_sink_attention(q, k, v, sinks, band_bias):
    B, S, Hq, Dh = q.shape
    Hkv = k.shape[2]
    G = Hq // Hkv
    nb = S // BLOCK
    qb = q.reshape(B, nb, BLOCK, Hkv, G, Dh)

    def band(t):
        tb = t.reshape(B, nb, BLOCK, Hkv, Dh)
        prev = jnp.pad(tb, ((0, 0), (1, 0), (0, 0), (0, 0), (0, 0)))[:, :-1]
        return jnp.concatenate([prev, tb], axis=2)

    kb, vb = band(k), band(v)
    s = jnp.einsum('bnqhgd,bnkhd->bnhgqk', qb, kb, preferred_element_type=F32) * (Dh ** -0.5)
    s = s + band_bias.reshape(Hkv, G, BLOCK, 2 * BLOCK)
    qi = jnp.arange(BLOCK)[:, None]
    kj = jnp.arange(2 * BLOCK)[None, :]
    rel = qi + BLOCK - kj
    in_window = (rel >= 0) & (rel < SWA_WINDOW)
    has_prev = (jnp.arange(nb)[:, None, None] > 0) | (kj[None] >= BLOCK)
    valid = in_window[None] & has_prev
    s = jnp.where(valid[None, :, None, None], s, -jnp.inf)
    sink_col = jnp.broadcast_to(sinks.astype(F32).reshape(1, 1, Hkv, G, 1, 1), s.shape[:-1] + (1,))
    pr = jax.nn.softmax(jnp.concatenate([s, sink_col], axis=-1), axis=-1)[..., :-1]
    out = jnp.einsum('bnhgqk,bnkhd->bnqhgd', pr.astype(v.dtype), vb)
    return out.reshape(B, S, Hq, Dh)


def dsa_attention(q, c_kv, q_idx, k_idx, w_idx, w_uk, w_uv, t5_c, topk):
    B, S, H, _ = q.shape
    nb = S // BLOCK
    scale = DSA_QK_DIM ** -0.5
    kpos = jnp.arange(S)

    def to_blocks(t):
        return t.reshape((B, nb, BLOCK) + t.shape[2:]).swapaxes(0, 1)

    def one_block(args):
        blk, q_b, qi_b, wi_b = args
        qpos = blk * BLOCK + jnp.arange(BLOCK)
        causal = kpos[None, :] <= qpos[:, None]
        dots = jnp.einsum('bqhd,bkd->bqkh', qi_b, k_idx, preferred_element_type=F32)
        score = jnp.einsum('bqkh,bqh->bqk', jax.nn.relu(dots), wi_b.astype(F32))
        score = jnp.where(causal[None], score, -jnp.inf)
        _, idx = lax.top_k(score, topk)
        lat = jax.vmap(lambda c, i: c[i])(c_kv, idx)
        rel = qpos[None, :, None] - idx
        valid = rel >= 0
        bias = t5_c[t5_bucket(rel)]
        q_abs = jnp.einsum('bqhd,lhd->bqhl', q_b, w_uk)
        s = jnp.einsum('bqhl,bqkl->bqhk', q_abs, lat, preferred_element_type=F32) * scale
        s = s + bias.transpose(0, 1, 3, 2)
        s = jnp.where(valid[:, :, None, :], s, -jnp.inf)
        pr = jax.nn.softmax(s, axis=-1)
        o_lat = jnp.einsum('bqhk,bqkl->bqhl', pr.astype(lat.dtype), lat)
        return jnp.einsum('bqhl,lhd->bqhd', o_lat, w_uv)

    out = lax.map(one_block, (jnp.arange(nb), to_blocks(q), to_blocks(q_idx), to_blocks(w_idx)))
    return out.swapaxes(0, 1).reshape(B, S, H, DSA_V_DIM)


def even_mixer(hn, w_in, b_f, sinks, w_out, band_bias):
    B, S, _ = hn.shape
    proj = hn @ w_in
    q_a, k_a, v_a, f_a, g_a, q_b, k_b, v_b, g_b = _split(proj, EVEN_SIZES)
    log_f = jax.nn.log_sigmoid(f_a.astype(F32) + b_f.astype(F32))
    o_a = fox_attention(q_a.reshape(B, S, FOX_HEADS, FOX_HEAD_DIM),
                        k_a.reshape(B, S, FOX_HEADS, FOX_HEAD_DIM),
                        v_a.reshape(B, S, FOX_HEADS, FOX_HEAD_DIM), log_f)
    o_b = swa_sink_attention(q_b.reshape(B, S, SWA_Q_HEADS, SWA_HEAD_DIM),
                             k_b.reshape(B, S, SWA_KV_HEADS, SWA_HEAD_DIM),
                             v_b.reshape(B, S, SWA_KV_HEADS, SWA_HEAD_DIM), sinks, band_bias)
    y = jnp.concatenate([o_a.reshape(B, S, FOX_WIDTH) * jax.nn.silu(g_a),
                         o_b.reshape(B, S, SWA_WIDTH) * jax.nn.silu(g_b)], axis=-1)
    return y @ w_out


def odd_mixer(hn, w_in, q_norm_g, kv_norm_g, w_uq, w_uq_idx, ln_g, ln_b, w_uk, w_uv, w_out, t5_c, topk):
    B, S, _ = hn.shape
    proj = hn @ w_in
    c_q, c_kv, k_idx, w_idx, g_c = _split(proj, ODD_SIZES)
    c_q = rms_norm(c_q, q_norm_g)
    c_kv = rms_norm(c_kv, kv_norm_g)
    q = (c_q @ w_uq).reshape(B, S, DSA_HEADS, DSA_QK_DIM)
    q_idx = (c_q @ w_uq_idx).reshape(B, S, IDX_HEADS, IDX_DIM)
    k_idx = layer_norm(k_idx, ln_g, ln_b)
    w_idx = w_idx * (IDX_HEADS ** -0.5 * IDX_DIM ** -0.5)
    o = dsa_attention(q, c_kv, q_idx, k_idx, w_idx, w_uk, w_uv, t5_c, topk)
    y = o.reshape(B, S, DSA_WIDTH) * jax.nn.silu(g_c)
    return y @ w_out


def setup_inputs(seed: int = 0) -> dict:
    key = jax.random.key(seed)
    ks = jax.random.split(key, 24)
    n = jax.random.normal
    D = D_MODEL
    return {
        'x': n(ks[0], (BATCH, SEQ, D), F32),
        'p': n(ks[1], (DEPTH, BATCH, SEQ, PLE_DIM), F32),
        't5_table': 0.5 * n(ks[2], (T5_BUCKETS, T5_COLS), F32),
        'norm_g': 1.0 + 0.02 * n(ks[3], (DEPTH, D), F32),
        'even_w_in': n(ks[4], (N_EVEN, D, EVEN_IN), F32) * D ** -0.5,
        'even_b_f': 2.0 + 0.5 * n(ks[5], (N_EVEN, FOX_HEADS), F32),
        'even_sinks': 0.5 * n(ks[6], (N_EVEN, SWA_Q_HEADS), F32),
        'even_w_out': n(ks[7], (N_EVEN, EVEN_OUT, D), F32) * EVEN_OUT ** -0.5,
        'odd_w_in': n(ks[8], (N_ODD, D, ODD_IN), F32) * D ** -0.5,
        'odd_q_norm_g': 1.0 + 0.02 * n(ks[9], (N_ODD, DSA_Q_LATENT), F32),
        'odd_kv_norm_g': 1.0 + 0.02 * n(ks[10], (N_ODD, DSA_KV_LATENT), F32),
        'odd_w_uq': n(ks[11], (N_ODD, DSA_Q_LATENT, DSA_HEADS * DSA_QK_DIM), F32) * DSA_Q_LATENT ** -0.5,
        'odd_w_uq_idx': n(ks[12], (N_ODD, DSA_Q_LATENT, IDX_HEADS * IDX_DIM), F32) * DSA_Q_LATENT ** -0.5,
        'odd_idx_ln_g': 1.0 + 0.02 * n(ks[13], (N_ODD, IDX_DIM), F32),
        'odd_idx_ln_b': 0.02 * n(ks[14], (N_ODD, IDX_DIM), F32),
        'odd_w_uk': n(ks[15], (N_ODD, DSA_KV_LATENT, DSA_HEADS, DSA_QK_DIM), F32) * DSA_KV_LATENT ** -0.5,
        'odd_w_uv': n(ks[16], (N_ODD, DSA_KV_LATENT, DSA_HEADS, DSA_V_DIM), F32) * DSA_KV_LATENT ** -0.5,
        'odd_w_out': n(ks[17], (N_ODD, DSA_WIDTH, D), F32) * DSA_WIDTH ** -0.5,
        'ple_w_proj': n(ks[18], (DEPTH, PLE_DIM, D), F32) * PLE_DIM ** -0.5,
        'ple_norm_g': 1.0 + 0.02 * n(ks[19], (DEPTH, D), F32),
        'ple_w_gate': n(ks[20], (DEPTH, D, D), F32) * D ** -0.5,
        'final_g': 1.0 + 0.02 * n(ks[21], (D,), F32),
    }


def reference(x, p, t5_table, norm_g, even_w_in, even_b_f, even_sinks, even_w_out,
              odd_w_in, odd_q_norm_g, odd_kv_norm_g, odd_w_uq, odd_w_uq_idx, odd_idx_ln_g,
              odd_idx_ln_b, odd_w_uk, odd_w_uv, odd_w_out, ple_w_proj, ple_norm_g,
              ple_w_gate, final_g):
    S = x.shape[1]
    topk = min(TOPK_MAX, S // 4)
    rel_band = jnp.arange(BLOCK)[:, None] + BLOCK - jnp.arange(2 * BLOCK)[None, :]
    band_bias = t5_table[t5_bucket(rel_band)][..., :SWA_Q_HEADS].transpose(2, 0, 1)
    t5_c = t5_table[:, SWA_Q_HEADS:]
    h = x
    for i in range(DEPTH):
        j = i // 2
        hn = rms_norm(h, norm_g[i])
        if i % 2 == 0:
            y = even_mixer(hn, even_w_in[j], even_b_f[j], even_sinks[j], even_w_out[j], band_bias)
        else:
            y = odd_mixer(hn, odd_w_in[j], odd_q_norm_g[j], odd_kv_norm_g[j], odd_w_uq[j],
                          odd_w_uq_idx[j], odd_idx_ln_g[j], odd_idx_ln_b[j], odd_w_uk[j],
                          odd_w_uv[j], odd_w_out[j], t5_c, topk)
        h = h + y
        gate = jax.nn.sigmoid(rms_norm(h, ple_norm_g[i]) @ ple_w_gate[i])
        h = h + gate * (p[i] @ ple_w_proj[i])
    return rms_norm(h, final_g)
```

```cpp
#include <hip/hip_runtime.h>
#include <cstdio>
#include <cstdint>

#define LAS __attribute__((address_space(3)))
#define GAS __attribute__((address_space(1)))
typedef unsigned short bf16_t;
typedef short bf16x8 __attribute__((ext_vector_type(8)));
typedef short s16x4 __attribute__((ext_vector_type(4)));
typedef short v4i16_t __attribute__((ext_vector_type(4)));
typedef float f32x2 __attribute__((ext_vector_type(2)));
typedef float f32x4 __attribute__((ext_vector_type(4)));
typedef float f32x16 __attribute__((ext_vector_type(16)));
typedef unsigned u32x2 __attribute__((ext_vector_type(2)));
typedef unsigned u32x4 __attribute__((ext_vector_type(4)));
typedef __bf16 bf16x2_t __attribute__((ext_vector_type(2)));
typedef GAS unsigned gu32;

#ifndef MK_STAGE
#define MK_STAGE 3
#endif
#ifndef MK_DUP
#define MK_DUP 0
#endif
#ifndef MK_ONE_LAUNCH
#define MK_ONE_LAUNCH 1
#endif

constexpr int M = 8192, DM = 4096, SEQ = 4096;
constexpr float EPS = 1e-6f;
constexpr float LOG2E = 1.4426950408889634f;
constexpr int EN = 13056;
constexpr int ON = 5888;
constexpr int E_QA = 0, E_KA = 2048, E_VA = 4096, E_GA = 6144, E_QB = 8192, E_GB = 10240, E_KB = 12288, E_VB = 12544, E_FA = 12800;
constexpr int O_GC = 0, O_CQ = 4096, O_CKV = 5120, O_KIDX = 5632, O_WIDX = 5696;
constexpr int QW = 6144;

constexpr size_t MiB = 1u << 20;
constexpr size_t WS_CTL = 0;
constexpr size_t WS_SUMSQ = 1 * MiB;
constexpr size_t WS_KN = 2 * MiB;
constexpr size_t WS_ZERO_BYTES = 4 * MiB;
constexpr size_t SZ_SQ = (size_t)4096 * 4096 * 2;
constexpr size_t SZ_WPROJ = (size_t)4096 * 256 * 2;
constexpr size_t WS_EWIN = 4 * MiB;
constexpr size_t WS_EWOUT = WS_EWIN + (size_t)EN * 4096 * 2;
constexpr size_t WS_EGATE = WS_EWOUT + SZ_SQ;
constexpr size_t WS_EPROJ = WS_EGATE + SZ_SQ;
constexpr size_t WS_OWIN = WS_EPROJ + SZ_WPROJ;
constexpr size_t WS_OWIN8 = WS_OWIN + (size_t)1792 * 4096 * 2;
constexpr size_t WS_OWUQ = WS_OWIN + (size_t)ON * 4096 * 2;
constexpr size_t WS_OWUK = WS_OWUQ + (size_t)QW * 1024 * 2;
constexpr size_t WS_OWUV = WS_OWUK + (size_t)512 * 4096 * 2;
constexpr size_t WS_OWOUT = WS_OWUV + (size_t)16 * 256 * 1024 * 2;
constexpr size_t WS_OGATE = WS_OWOUT + SZ_SQ;
constexpr size_t WS_OPROJ = WS_OGATE + SZ_SQ;
constexpr size_t WS_H = WS_OPROJ + SZ_WPROJ;
constexpr size_t WS_HBA = WS_H + (size_t)M * 4096 * 4;
constexpr size_t SZ_ACT = (size_t)M * 4096 * 2;
constexpr size_t WS_HBB = WS_HBA + SZ_ACT;
constexpr size_t WS_YIN = WS_HBB + SZ_ACT;
constexpr size_t WS_SCORE = WS_YIN;
constexpr size_t WS_PP = WS_YIN + SZ_ACT;
constexpr size_t WS_PB = WS_PP + SZ_ACT;
constexpr size_t WS_PROJ = WS_PB + (size_t)4 * M * 256 * 2;
constexpr size_t WS_CQN = WS_PROJ + (size_t)M * EN * 2;
constexpr size_t WS_LAT = WS_CQN + (size_t)M * 1024 * 2;
constexpr size_t WS_KIDX = WS_LAT + (size_t)M * 512 * 2;
constexpr size_t WS_WIDX = WS_KIDX + (size_t)M * 64 * 2;
constexpr size_t WS_SEL = WS_WIDX + (size_t)M * 32 * 4;
constexpr size_t WS_QBUF = WS_SEL + (size_t)M * 256 * 4;
constexpr size_t WS_QABS = WS_QBUF + (size_t)M * QW * 2;
constexpr size_t WS_OLAT = WS_QABS + (size_t)M * 16384 * 2;
constexpr size_t WS_HQ = WS_OLAT + (size_t)M * 16384 * 2;
constexpr size_t WS_ASCALE = WS_HQ + (size_t)M * 4096;
constexpr size_t WS_ASCALE1 = WS_ASCALE + (size_t)M * 4;
constexpr size_t WS_ASCALEY = WS_ASCALE1 + (size_t)M * 4;
constexpr size_t WS_YQ = WS_PROJ;
constexpr size_t WS_END = WS_ASCALEY + (size_t)M * 4;
static_assert(WS_END <= (size_t)4 * 2 * 4096 * 12816 * 4, "workspace map exceeds the guaranteed size (4 x the largest input)");

constexpr int LDS_BYTES = 155648;
constexpr int MISC_OFF = LDS_BYTES - 256;

__device__ __forceinline__ unsigned cvtpk(float lo, float hi) { f32x2 v = {lo, hi}; bf16x2_t b = __builtin_convertvector(v, bf16x2_t); return __builtin_bit_cast(unsigned, b); }
__device__ __forceinline__ float bf2f(unsigned short b) { return __uint_as_float(((unsigned)b) << 16); }
__device__ __forceinline__ float bflo(unsigned w) { return __uint_as_float(w << 16); }
__device__ __forceinline__ float bfhi(unsigned w) { return __uint_as_float(w & 0xffff0000u); }
__device__ __forceinline__ float wave_sum(float v) {
#pragma unroll
    for (int o = 1; o < 64; o <<= 1) v += __shfl_xor(v, o);
    return v;
}
__device__ __forceinline__ float xhalf_max(float m) { auto rr = __builtin_amdgcn_permlane32_swap(__float_as_uint(m), __float_as_uint(m), false, false); return fmaxf(__uint_as_float(rr[0]), __uint_as_float(rr[1])); }
__device__ __forceinline__ float xhalf_sum(float m) { auto rr = __builtin_amdgcn_permlane32_swap(__float_as_uint(m), __float_as_uint(m), false, false); return __uint_as_float(rr[0]) + __uint_as_float(rr[1]); }
__device__ __forceinline__ int lane_id_() { int l = (int)__builtin_amdgcn_mbcnt_hi(~0u, __builtin_amdgcn_mbcnt_lo(~0u, 0u)); asm volatile("" : "+v"(l)); return l; }
typedef unsigned long long u64;
__device__ __forceinline__ u64 ss_fix(float s2) { return (u64)(s2 * 16777216.0f); }
__device__ __forceinline__ float ss_rstd(u64 v) { return __builtin_amdgcn_rsqf((float)v * (1.0f / 16777216.0f) * (1.0f / 4096.0f) + EPS); }
__device__ __forceinline__ unsigned opaque_vu_(unsigned v) { asm volatile("" : "+v"(v)); return v; }
__device__ __forceinline__ u32x4 zero4_() { unsigned z = 0u; asm volatile("" : "+v"(z)); return (u32x4){z, z, z, z}; }
typedef int i32x4 __attribute__((ext_vector_type(4)));
constexpr float W8_SCALE = 1354.0f;
__device__ __forceinline__ int q8_(float v) { const int q = (int)__builtin_rintf(v); return q < -127 ? -127 : (q > 127 ? 127 : q); }
__device__ __forceinline__ unsigned pack4_q8_(float a, float b, float c, float d) { return (unsigned)(q8_(a) & 255) | ((unsigned)(q8_(b) & 255) << 8) | ((unsigned)(q8_(c) & 255) << 16) | ((unsigned)(q8_(d) & 255) << 24); }
__device__ __forceinline__ float fast_exp2(float x) { return __builtin_amdgcn_exp2f(x); }
__device__ __forceinline__ float sigmoidf_(float x) { return 1.0f / (1.0f + __expf(-x)); }
__device__ __forceinline__ float siluf_(float x) { return x / (1.0f + __expf(-x)); }
#define OPAQUE_S(p) do { unsigned long long _v = (unsigned long long)(p); unsigned _lo = (unsigned)_v, _hi = (unsigned)(_v >> 32); asm volatile("" : "+v"(_lo), "+v"(_hi)); \
    _lo = __builtin_amdgcn_readfirstlane(_lo); _hi = __builtin_amdgcn_readfirstlane(_hi); (p) = (decltype(p))(((unsigned long long)_hi << 32) | _lo); } while (0)
#define G1(T, p) ((GAS T*)(p))
#define LDS_WAIT() asm volatile("s_waitcnt lgkmcnt(0)" ::: "memory")
#define VM_WAIT() asm volatile("s_waitcnt vmcnt(0)" ::: "memory")

#define XB_TMO      128
#define XB_XCNT(j)  (256  + 64 * (j))
#define XB_XSUB(j)  (1280 + 64 * (j))
#define XB_XGEN(j)  (2304 + 64 * (j))
#define XB_TOP      3328
#define XB_TOPGEN   3392
#define XCD_BAR_WORDS 3456
#define XB_SPIN_CAP (1u << 22)
__device__ __forceinline__ unsigned xb_ld(unsigned* p)              { return __hip_atomic_load((gu32*)p, __ATOMIC_RELAXED, __HIP_MEMORY_SCOPE_AGENT); }
__device__ __forceinline__ unsigned xb_add(unsigned* p, unsigned v) { return __hip_atomic_fetch_add((gu32*)p, v, __ATOMIC_RELAXED, __HIP_MEMORY_SCOPE_AGENT); }
__device__ __forceinline__ unsigned xb_xcc_id() { return (unsigned)__builtin_amdgcn_s_getreg((3 << 11) | 20) & 0xFu; }
#define XB_SPIN(cond, bar) do { unsigned _sp = 0; while (cond) { __builtin_amdgcn_s_sleep(1); \
    if ((++_sp & 255u) == 0u) { if (xb_ld(&(bar)[XB_TMO])) break; if (_sp > XB_SPIN_CAP) { (void)xb_add(&(bar)[XB_TMO], 1u); break; } } } } while (0)
struct XcdBarrier { unsigned* bar; unsigned x; volatile LAS unsigned* st; };
__device__ __forceinline__ XcdBarrier xcd_barrier_post(unsigned* bar, volatile LAS unsigned* st, const int wave) {
    XcdBarrier b; b.bar = bar; b.x = xb_xcc_id(); b.st = st;
    if (wave == 0 && lane_id_() == 0) (void)xb_add(&bar[XB_XCNT(b.x)], 1u);
    return b;
}
__device__ __forceinline__ void xcd_barrier_complete(unsigned* bar, unsigned x, unsigned& nloc, unsigned& nx) {
    const unsigned G = gridDim.x * gridDim.y * gridDim.z;
    unsigned sum, cnt, mine, sp = 0u;
    for (;;) {
        sum = 0u; cnt = 0u; mine = 0u;
#pragma unroll 1
        for (unsigned j = 0; j < 16; ++j) { const unsigned c = xb_ld(&bar[XB_XCNT(j)]); sum += c; cnt += (c > 0u) ? 1u : 0u; mine = (j == x) ? c : mine; }
        if (sum == G) break;
        __builtin_amdgcn_s_sleep(1);
        if ((++sp & 255u) == 0u) { if (xb_ld(&bar[XB_TMO])) break; if (sp > XB_SPIN_CAP) { (void)xb_add(&bar[XB_TMO], 1u); break; } }
    }
    nloc = mine > 0u ? mine : 1u; nx = cnt > 0u ? cnt : 1u;
}
__device__ __forceinline__ void xcd_barrier(const XcdBarrier& b, const int wave) {
    asm volatile("s_waitcnt vmcnt(0)" ::: "memory");
    __syncthreads();
    if (wave == 0 && lane_id_() == 0) {
        unsigned* bar = b.bar;
        __builtin_amdgcn_s_waitcnt(0);
        unsigned nloc = b.st[0], nx = b.st[1];
        if (nloc == 0u) { xcd_barrier_complete(bar, b.x, nloc, nx); b.st[0] = nloc; b.st[1] = nx; }
        const unsigned old = xb_add(&bar[XB_XSUB(b.x)], 1u);
        const unsigned gen = old / nloc;
        if (old + 1u == (gen + 1u) * nloc) {
            __builtin_amdgcn_fence(__ATOMIC_RELEASE, "agent");
            asm volatile("s_waitcnt vmcnt(0)" ::: "memory");
            const unsigned og = xb_add(&bar[XB_TOP], 1u);
            const unsigned tg = og / nx;
            if (og + 1u == (tg + 1u) * nx) xb_add(&bar[XB_TOPGEN], 1u);
            else XB_SPIN(xb_ld(&bar[XB_TOPGEN]) == tg, bar);
            __builtin_amdgcn_fence(__ATOMIC_ACQUIRE, "agent");
            xb_add(&bar[XB_XGEN(b.x)], 1u);
            asm volatile("s_waitcnt vmcnt(0)" ::: "memory");
        } else {
            XB_SPIN(xb_ld(&bar[XB_XGEN(b.x)]) == gen, bar);
            __builtin_amdgcn_fence(__ATOMIC_ACQUIRE, "agent");
            asm volatile("s_waitcnt vmcnt(0)" ::: "memory");
        }
    }
    __syncthreads();
}

namespace pg8 {
__device__ __forceinline__ void glds16_s(const void* sbase, unsigned voff, unsigned lds_dst) {
    unsigned keep;
    asm volatile("s_mov_b32 %0, m0\n\ts_mov_b32 m0, %3\n\ts_nop 0\n\tglobal_load_lds_dwordx4 %1, %2\n\ts_mov_b32 m0, %0" : "=&s"(keep) : "v"(voff), "s"(sbase), "s"(lds_dst) : "memory");
}
constexpr int BM = 256, BK = 64, HALF = 128, HTB = HALF * BK * 2, STAGE_BYTES = 8 * HTB, NXCD = 8, WGM = 8;
__host__ __device__ __forceinline__ int lds_byte(int r, int c) { const int st = (r >> 4) * 2 + (c >> 5), rr = r & 15, cc = c & 31, ob = rr * 64 + cc * 2; return st * 1024 + (ob ^ (((ob >> 9) & 1) << 5)); }
__host__ __device__ __forceinline__ void stage_rc(int b, int& R, int& C) { const int st = b / 1024, sb = b % 1024, swz = sb ^ (((sb >> 9) & 1) << 5); R = (st >> 1) * 16 + swz / 64; C = (st & 1) * 32 + (swz % 64) / 2; }
__host__ __device__ __forceinline__ int perm32(int rho) { const int n = rho >> 4, i = rho & 15; return 8 * (i >> 2) + 4 * n + (i & 3); }

struct Unit { int pm, pn, g; };
struct Gemm { const bf16_t* A; const bf16_t* Bt; int lda, ldb, K, nM, nN, ng; size_t gsA, gsB; };

struct Sched {
    int nM, nN, nwg, total, G, c;
    __device__ void init(const Gemm& g, int G_, int c_) { nM = g.nM; nN = g.nN; nwg = nM * nN; total = nwg * g.ng; G = G_; c = c_; }
    __device__ bool next(int i, Unit& u) const {
        const long L = (long)i * G + c; if (L >= total) return false;
        u.g = (int)(L / nwg); int wgid = (int)(L % nwg);
        { const int q = nwg / NXCD, r = nwg % NXCD, xcd = wgid % NXCD, off = wgid / NXCD; wgid = (xcd < r ? xcd * (q + 1) : r * (q + 1) + (xcd - r) * q) + off; }
        const int nig = WGM * nN, gid = wgid / nig, fm = gid * WGM, gsz = (nM - fm) < WGM ? (nM - fm) : WGM;
        u.pm = fm + ((wgid % nig) % gsz); u.pn = (wgid % nig) / gsz; return true;
    }
};

template <class Epi, bool I8 = false>
__device__ __forceinline__ void gemm_phase(LAS unsigned char* lds, const Gemm g, const Sched& S, const Epi& E, const int wid) {
    const int lane = lane_id_(), tid = wid * 64 + lane;
    const int wr = wid >> 2, wc = wid & 3, fr = lane & 15, fq = lane >> 4;
    const bf16_t* gA = g.A; const bf16_t* gB = g.Bt; OPAQUE_S(gA); OPAQUE_S(gB);
    constexpr int ESZ = I8 ? 1 : 2;
    const int K = g.K, nt = K * ESZ / (BK * 2);
    unsigned voffA[2], voffB[2];
#pragma unroll
    for (int i = 0; i < 2; ++i) { int R, C; stage_rc(tid * 16 + i * 8192, R, C); const int Rb = (R & ~31) + perm32(R & 31);
        voffA[i] = (unsigned)(R * g.lda * ESZ + C * 2); voffB[i] = (unsigned)(Rb * g.ldb * ESZ + C * 2); }
    const size_t kstep = (size_t)(BK * 2);
    const size_t hstepA = (size_t)HALF * g.lda * ESZ, hstepB = (size_t)HALF * g.ldb * ESZ;
    const size_t tstepA = 2 * hstepA, tstepB = 2 * hstepB;
    const unsigned ldsbase = (unsigned)(size_t)lds + (unsigned)wid * 1024u;
    const int aoff = lds_byte(wr * 64 + fr, fq * 8), boff = lds_byte(wc * 32 + fr, fq * 8);
#define PG8_SA(b, h) (((b) * 2 + (h)) * HTB)
#define PG8_SB(b, h) ((4 + (b) * 2 + (h)) * HTB)
#define PG8_STAGE(bufoff, gbase, voff) do { _Pragma("unroll") for (int _i = 0; _i < 2; ++_i) glds16_s((const void*)(gbase), (voff)[_i], ldsbase + (unsigned)((bufoff) + _i * 8192)); } while (0)
#define PG8_LDA(dst, b, h) do { _Pragma("unroll") for (int m = 0; m < 4; ++m) _Pragma("unroll") for (int k = 0; k < 2; ++k) dst[m][k] = *(const LAS bf16x8*)(lds + PG8_SA(b, h) + aoff + m * 2048 + k * 1024); } while (0)
#define PG8_LDB(dst, b, h) do { _Pragma("unroll") for (int n = 0; n < 2; ++n) _Pragma("unroll") for (int k = 0; k < 2; ++k) dst[n][k] = *(const LAS bf16x8*)(lds + PG8_SB(b, h) + boff + n * 2048 + k * 1024); } while (0)
#define PG8_MMA(ai, bj, At, Bt) do { __builtin_amdgcn_s_setprio(1); _Pragma("unroll") for (int m = 0; m < 4; ++m) _Pragma("unroll") for (int n = 0; n < 2; ++n) _Pragma("unroll") for (int k = 0; k < 2; ++k) { \
        if constexpr (I8) acc[ai][bj][m][n] = __builtin_bit_cast(f32x4, __builtin_amdgcn_mfma_i32_16x16x64_i8(__builtin_bit_cast(i32x4, Bt[n][k]), __builtin_bit_cast(i32x4, At[m][k]), __builtin_bit_cast(i32x4, acc[ai][bj][m][n]), 0, 0, 0)); \
        else acc[ai][bj][m][n] = __builtin_amdgcn_mfma_f32_16x16x32_bf16(Bt[n][k], At[m][k], acc[ai][bj][m][n], 0, 0, 0); } __builtin_amdgcn_s_setprio(0); } while (0)
#define PG8_WAIT_V(n) asm volatile("s_waitcnt vmcnt(" #n ")" ::: "memory")
#define PG8_WAIT_L(n) asm volatile("s_waitcnt lgkmcnt(" #n ")" ::: "memory")
#define PG8_BAR __builtin_amdgcn_s_barrier()
#define PG8_SCHED __builtin_amdgcn_sched_barrier(0)
    Unit cur, nxt; int ui = 0;
    if (!S.next(0, cur)) return;
    f32x4 acc[2][2][4][2];
#pragma unroll
    for (int a = 0; a < 2; ++a)
#pragma unroll
        for (int b = 0; b < 2; ++b)
#pragma unroll
            for (int m = 0; m < 4; ++m)
#pragma unroll
                for (int n = 0; n < 2; ++n) acc[a][b][m][n] = (f32x4){0.f, 0.f, 0.f, 0.f};
    bf16x8 At[4][2], B0[2][2], B1[2][2];
    const char* cA = (const char*)(gA + (size_t)cur.g * g.gsA) + (size_t)cur.pm * tstepA; const char* cB = (const char*)(gB + (size_t)cur.g * g.gsB) + (size_t)cur.pn * tstepB;
    PG8_STAGE(PG8_SB(0, 0), cB, voffB); PG8_STAGE(PG8_SB(0, 1), cB + hstepB, voffB); PG8_STAGE(PG8_SA(0, 0), cA, voffA); PG8_STAGE(PG8_SA(0, 1), cA + hstepA, voffA);
    if (wr == 1) PG8_BAR;
    PG8_WAIT_V(2); PG8_BAR;
    PG8_STAGE(PG8_SB(1, 0), cB + kstep, voffB); PG8_STAGE(PG8_SA(1, 0), cA + kstep, voffA); PG8_STAGE(PG8_SB(1, 1), cB + hstepB + kstep, voffB);
    PG8_WAIT_V(6); PG8_BAR;
    for (;;) {
        const bool has_next = S.next(ui + 1, nxt);
        const char* nA = has_next ? (const char*)(gA + (size_t)nxt.g * g.gsA) + (size_t)nxt.pm * tstepA : cA; const char* nB = has_next ? (const char*)(gB + (size_t)nxt.g * g.gsB) + (size_t)nxt.pn * tstepB : cB;
        for (int t = 0; t < nt; t += 2) {
            const bool last = (t == nt - 2);
            const char* a1 = cA + (size_t)(t + 1) * kstep;
            const char* a2 = last ? nA : cA + (size_t)(t + 2) * kstep; const char* b2 = last ? nB : cB + (size_t)(t + 2) * kstep;
            const char* a3 = a2 + kstep; const char* b3 = b2 + kstep;
            PG8_LDB(B0, 0, 0); PG8_LDB(B1, 0, 1); PG8_SCHED; PG8_LDA(At, 0, 0); PG8_STAGE(PG8_SA(1, 1), a1 + hstepA, voffA);
            PG8_WAIT_V(8); PG8_WAIT_L(0); PG8_BAR; PG8_MMA(0, 0, At, B0); PG8_MMA(0, 1, At, B1); PG8_BAR; PG8_SCHED;
            PG8_LDA(At, 0, 1); PG8_STAGE(PG8_SB(0, 0), b2, voffB); PG8_STAGE(PG8_SB(0, 1), b2 + hstepB, voffB); PG8_STAGE(PG8_SA(0, 0), a2, voffA);
            PG8_WAIT_V(8); PG8_WAIT_L(0); PG8_BAR; PG8_MMA(1, 0, At, B0); PG8_MMA(1, 1, At, B1); PG8_BAR; PG8_SCHED;
            PG8_LDB(B0, 1, 0); PG8_LDB(B1, 1, 1); PG8_SCHED; PG8_LDA(At, 1, 0); PG8_STAGE(PG8_SA(0, 1), a2 + hstepA, voffA);
            PG8_WAIT_V(8); PG8_WAIT_L(0); PG8_BAR; PG8_MMA(0, 0, At, B0); PG8_MMA(0, 1, At, B1); PG8_BAR; PG8_SCHED;
            PG8_LDA(At, 1, 1); PG8_STAGE(PG8_SB(1, 0), b3, voffB); PG8_STAGE(PG8_SB(1, 1), b3 + hstepB, voffB); PG8_STAGE(PG8_SA(1, 0), a3, voffA);
            PG8_WAIT_V(8); PG8_WAIT_L(0); PG8_BAR; PG8_MMA(1, 0, At, B0); PG8_MMA(1, 1, At, B1); PG8_BAR; PG8_SCHED;
        }
        if (wr == 0) PG8_BAR;
        { const int l2 = lane_id_(); E(acc, cur, wid >> 2, wid & 3, l2 & 15, l2 >> 4); }
        if (!has_next) break;
#pragma unroll
        for (int a = 0; a < 2; ++a)
#pragma unroll
            for (int b = 0; b < 2; ++b)
#pragma unroll
                for (int m = 0; m < 4; ++m)
#pragma unroll
                    for (int n = 0; n < 2; ++n) acc[a][b][m][n] = (f32x4){0.f, 0.f, 0.f, 0.f};
        cur = nxt; cA = nA; cB = nB; ++ui;
        if (wr == 1) PG8_BAR;
    }
    PG8_WAIT_V(0);
    PG8_BAR;
#undef PG8_SA
#undef PG8_SB
#undef PG8_STAGE
#undef PG8_LDA
#undef PG8_LDB
#undef PG8_MMA
#undef PG8_WAIT_V
#undef PG8_WAIT_L
#undef PG8_BAR
#undef PG8_SCHED
}

struct EpiBf16 {
    bf16_t* O; int ldc; size_t gsO; const u64* ss;
    __device__ __forceinline__ void operator()(const f32x4 (&acc)[2][2][4][2], const Unit& u, int wr, int wc, int fr, int fq) const {
        const int row0 = u.pm * BM + wr * 64 + fr, col0 = u.pn * BM + wc * 32 + 8 * fq;
        bf16_t* base = O + (size_t)u.g * gsO;
#pragma unroll
        for (int ai = 0; ai < 2; ++ai)
#pragma unroll
            for (int m = 0; m < 4; ++m) { const int row = row0 + ai * HALF + m * 16; bf16_t* rowp = base + (size_t)row * ldc + col0;
                const float sc = ss ? ss_rstd(*G1(const u64, ss + row)) : 1.0f;
#pragma unroll
                for (int bj = 0; bj < 2; ++bj) { const f32x4 v0 = acc[ai][bj][m][0] * sc, v1 = acc[ai][bj][m][1] * sc;
                    u32x4 w; w.x = cvtpk(v0[0], v0[1]); w.y = cvtpk(v0[2], v0[3]); w.z = cvtpk(v1[0], v1[1]); w.w = cvtpk(v1[2], v1[3]);
                    *G1(u32x4, rowp + bj * HALF) = w; } }
    }
};
struct EpiBf16Q {
    bf16_t* O; int ldc; const u64* ss; const float* ascale; u64* kn; int dry;
    __device__ __forceinline__ void operator()(const f32x4 (&acc)[2][2][4][2], const Unit& u, int wr, int wc, int fr, int fq) const {
        const int row0 = u.pm * BM + wr * 64 + fr, col0 = u.pn * BM + wc * 32 + 8 * fq;
        const bool ktile = kn != nullptr && u.pn >= 8 && u.pn < 16;
        if (dry) { float t_ = 0.f;
#pragma unroll
            for (int ai = 0; ai < 2; ++ai)
#pragma unroll
                for (int bj = 0; bj < 2; ++bj)
#pragma unroll
                    for (int m = 0; m < 4; ++m) t_ += acc[ai][bj][m][0][0] + acc[ai][bj][m][1][3];
            if (t_ == 1.2345e38f) *G1(float, (float*)O) = t_; return; }
#pragma unroll
        for (int ai = 0; ai < 2; ++ai)
#pragma unroll
            for (int m = 0; m < 4; ++m) { const int row = row0 + ai * HALF + m * 16; bf16_t* rowp = O + (size_t)row * ldc + col0;
                const float sc = ss_rstd(*G1(const u64, ss + row)) * *G1(const float, ascale + row) * (1.0f / W8_SCALE);
#pragma unroll
                for (int bj = 0; bj < 2; ++bj) { const i32x4 i0 = __builtin_bit_cast(i32x4, acc[ai][bj][m][0]), i1 = __builtin_bit_cast(i32x4, acc[ai][bj][m][1]);
                    const float f0 = (float)i0[0] * sc, f1 = (float)i0[1] * sc, f2 = (float)i0[2] * sc, f3 = (float)i0[3] * sc, f4 = (float)i1[0] * sc, f5 = (float)i1[1] * sc, f6 = (float)i1[2] * sc, f7 = (float)i1[3] * sc;
                    u32x4 w; w.x = cvtpk(f0, f1); w.y = cvtpk(f2, f3); w.z = cvtpk(f4, f5); w.w = cvtpk(f6, f7);
                    *G1(u32x4, rowp + bj * HALF) = w;
                    if (ktile) { float s2 = (f0 * f0 + f1 * f1) + (f2 * f2 + f3 * f3) + (f4 * f4 + f5 * f5) + (f6 * f6 + f7 * f7); s2 += __shfl_xor(s2, 16); s2 += __shfl_xor(s2, 32);
                        if (fq == 0) (void)__hip_atomic_fetch_add(G1(u64, kn + (size_t)((u.pn - 8) * 2 + bj) * M + row), ss_fix(s2), __ATOMIC_RELAXED, __HIP_MEMORY_SCOPE_AGENT); } } }
    }
};
struct EpiResid {
    const float* Hin; float* H; signed char* HQ; float* ascale; const u64* ssin; u64* ssout; const float* ascale_y;
    __device__ __forceinline__ void operator()(const f32x4 (&acc)[2][2][4][2], const Unit& u, int wr, int wc, int fr, int fq) const {
        const int row0 = u.pm * BM + wr * 64 + fr, col0 = u.pn * BM + wc * 32 + 8 * fq;
#pragma unroll
        for (int ai = 0; ai < 2; ++ai)
#pragma unroll
            for (int m = 0; m < 4; ++m) { const int row = row0 + ai * HALF + m * 16; float* hp = H + (size_t)row * DM + col0; const float* hi = Hin + (size_t)row * DM + col0; signed char* bp = HQ + (size_t)row * DM + col0; float s2 = 0.f;
                const float qs = 15.875f * ss_rstd(*G1(const u64, ssin + row));
                if (fq == 0 && wc == 0 && u.pn == 0) *G1(float, ascale + row) = 1.0f / qs;
                const float ys = *G1(const float, ascale_y + row) * (1.0f / W8_SCALE);
#pragma unroll
                for (int bj = 0; bj < 2; ++bj) { const i32x4 i0 = __builtin_bit_cast(i32x4, acc[ai][bj][m][0]), i1 = __builtin_bit_cast(i32x4, acc[ai][bj][m][1]);
                    const f32x4 v0 = *G1(const f32x4, hi + bj * HALF) + (f32x4){(float)i0[0], (float)i0[1], (float)i0[2], (float)i0[3]} * ys, v1 = *G1(const f32x4, hi + bj * HALF + 4) + (f32x4){(float)i1[0], (float)i1[1], (float)i1[2], (float)i1[3]} * ys;
                    *G1(f32x4, hp + bj * HALF) = v0; *G1(f32x4, hp + bj * HALF + 4) = v1;
                    s2 += (v0[0] * v0[0] + v0[1] * v0[1]) + (v0[2] * v0[2] + v0[3] * v0[3]) + (v1[0] * v1[0] + v1[1] * v1[1]) + (v1[2] * v1[2] + v1[3] * v1[3]);
                    u32x2 q; q.x = pack4_q8_(v0[0] * qs, v0[1] * qs, v0[2] * qs, v0[3] * qs); q.y = pack4_q8_(v1[0] * qs, v1[1] * qs, v1[2] * qs, v1[3] * qs);
                    *G1(u32x2, bp + bj * HALF) = q; }
                s2 += __shfl_xor(s2, 16); s2 += __shfl_xor(s2, 32);
                if (fq == 0) (void)__hip_atomic_fetch_add(G1(u64, ssout + row), ss_fix(s2), __ATOMIC_RELAXED, __HIP_MEMORY_SCOPE_AGENT); }
    }
};
struct EpiGate {
    float* H; bf16_t* HB; const bf16_t* PP; const u64* ssin; u64* ssout; signed char* HQ; float* ascale; const float* ascale_in;
    __device__ __forceinline__ void operator()(const f32x4 (&acc)[2][2][4][2], const Unit& u, int wr, int wc, int fr, int fq) const {
        const int row0 = u.pm * BM + wr * 64 + fr, col0 = u.pn * BM + wc * 32 + 8 * fq;
#pragma unroll
        for (int ai = 0; ai < 2; ++ai)
#pragma unroll
            for (int m = 0; m < 4; ++m) { const int row = row0 + ai * HALF + m * 16; float* hp = H + (size_t)row * DM + col0; bf16_t* bp = HB + (size_t)row * DM + col0; const bf16_t* pp = PP + (size_t)row * DM + col0;
                const float sc = ss_rstd(*G1(const u64, ssin + row)); float s2 = 0.f;
                const float qs = 15.875f * sc;
                const float scq = sc * *G1(const float, ascale_in + row) * (1.0f / W8_SCALE);
                if (HQ && fq == 0 && wc == 0 && u.pn == 0) *G1(float, ascale + row) = 1.0f / qs;
#pragma unroll
                for (int bj = 0; bj < 2; ++bj) { const u32x4 pw = *G1(const u32x4, pp + bj * HALF);
                    f32x4 v0 = *G1(const f32x4, hp + bj * HALF), v1 = *G1(const f32x4, hp + bj * HALF + 4);
                    const i32x4 i0 = __builtin_bit_cast(i32x4, acc[ai][bj][m][0]), i1 = __builtin_bit_cast(i32x4, acc[ai][bj][m][1]);
                    const f32x4 a0 = (f32x4){(float)i0[0], (float)i0[1], (float)i0[2], (float)i0[3]} * scq, a1 = (f32x4){(float)i1[0], (float)i1[1], (float)i1[2], (float)i1[3]} * scq;
                    v0[0] += sigmoidf_(a0[0]) * bflo(pw.x); v0[1] += sigmoidf_(a0[1]) * bfhi(pw.x); v0[2] += sigmoidf_(a0[2]) * bflo(pw.y); v0[3] += sigmoidf_(a0[3]) * bfhi(pw.y);
                    v1[0] += sigmoidf_(a1[0]) * bflo(pw.z); v1[1] += sigmoidf_(a1[1]) * bfhi(pw.z); v1[2] += sigmoidf_(a1[2]) * bflo(pw.w); v1[3] += sigmoidf_(a1[3]) * bfhi(pw.w);
                    *G1(f32x4, hp + bj * HALF) = v0; *G1(f32x4, hp + bj * HALF + 4) = v1;
                    s2 += (v0[0] * v0[0] + v0[1] * v0[1]) + (v0[2] * v0[2] + v0[3] * v0[3]) + (v1[0] * v1[0] + v1[1] * v1[1]) + (v1[2] * v1[2] + v1[3] * v1[3]);
                    if (HQ) { u32x2 q; q.x = pack4_q8_(v0[0] * qs, v0[1] * qs, v0[2] * qs, v0[3] * qs); q.y = pack4_q8_(v1[0] * qs, v1[1] * qs, v1[2] * qs, v1[3] * qs); *G1(u32x2, HQ + (size_t)row * DM + col0 + bj * HALF) = q; }
                    if (HB) { u32x4 w; w.x = cvtpk(v0[0], v0[1]); w.y = cvtpk(v0[2], v0[3]); w.z = cvtpk(v1[0], v1[1]); w.w = cvtpk(v1[2], v1[3]);
                        *G1(u32x4, bp + bj * HALF) = w; } }
                s2 += __shfl_xor(s2, 16); s2 += __shfl_xor(s2, 32);
                if (fq == 0) (void)__hip_atomic_fetch_add(G1(u64, ssout + row), ss_fix(s2), __ATOMIC_RELAXED, __HIP_MEMORY_SCOPE_AGENT); }
    }
};
struct EpiOGate {
    bf16_t* Y; const bf16_t* GC; int ldg;
    __device__ __forceinline__ void operator()(const f32x4 (&acc)[2][2][4][2], const Unit& u, int wr, int wc, int fr, int fq) const {
        const int row0 = u.pm * BM + wr * 64 + fr, col0 = u.g * 256 + wc * 32 + 8 * fq;
#pragma unroll
        for (int ai = 0; ai < 2; ++ai)
#pragma unroll
            for (int m = 0; m < 4; ++m) { const int row = row0 + ai * HALF + m * 16; bf16_t* yp = Y + (size_t)row * DM + col0; const bf16_t* gp = GC + (size_t)row * ldg + col0;
#pragma unroll
                for (int bj = 0; bj < 2; ++bj) { const u32x4 gw = *G1(const u32x4, gp + bj * HALF); const f32x4 a0 = acc[ai][bj][m][0], a1 = acc[ai][bj][m][1];
                    u32x4 w; w.x = cvtpk(a0[0] * siluf_(bflo(gw.x)), a0[1] * siluf_(bfhi(gw.x))); w.y = cvtpk(a0[2] * siluf_(bflo(gw.y)), a0[3] * siluf_(bfhi(gw.y)));
                    w.z = cvtpk(a1[0] * siluf_(bflo(gw.z)), a1[1] * siluf_(bfhi(gw.z))); w.w = cvtpk(a1[2] * siluf_(bflo(gw.w)), a1[3] * siluf_(bfhi(gw.w)));
                    *G1(u32x4, yp + bj * HALF) = w; } }
    }
};
}

struct Args { const float* in[22]; float* out; unsigned char* ws; int ph_lo, ph_hi; };
enum { I_X = 0, I_P, I_T5, I_NORMG, I_EWIN, I_EBF, I_ESINK, I_EWOUT, I_OWIN, I_OQNG, I_OKVNG, I_OWUQ, I_OWUQI, I_OLNG, I_OLNB, I_OWUK, I_OWUV, I_OWOUT, I_PWPROJ, I_PNORMG, I_PWGATE, I_FINALG };


__device__ __forceinline__ unsigned off_b(unsigned row, unsigned ch) { return 256u * row + 16u * (ch ^ (((row & 3) << 2) | ((row >> 2) & 3))); }
__device__ __forceinline__ s16x4 vtr(LAS const unsigned char* p) { return __builtin_bit_cast(s16x4, __builtin_amdgcn_ds_read_tr16_b64_v4i16((LAS v4i16_t*)p)); }
__device__ __forceinline__ bf16x8 pack8(const f32x16& s, int o) {
    u32x4 w; w.x = cvtpk(s[o + 0], s[o + 1]); w.y = cvtpk(s[o + 2], s[o + 3]); w.z = cvtpk(s[o + 4], s[o + 5]); w.w = cvtpk(s[o + 6], s[o + 7]);
    return __builtin_bit_cast(bf16x8, w);
}
template <int NSB, int NOB>
__device__ __forceinline__ void sm_step(f32x16 (&s)[NSB], float& m, float& l, f32x16 (&o)[NOB], bf16x8 (&p)[NSB][2]) {
    float mx = s[0][0];
#pragma unroll
    for (int b = 0; b < NSB; ++b)
#pragma unroll
        for (int r = 0; r < 16; ++r) mx = fmaxf(mx, s[b][r]);
    mx = xhalf_max(mx);
    if (__any(mx > m + 8.0f)) {
        const float mn = fmaxf(m, mx), alpha = fast_exp2(m - mn);
        l *= alpha; m = mn;
#pragma unroll
        for (int c = 0; c < NOB; ++c) o[c] = o[c] * alpha;
    }
    float sum = 0.f;
#pragma unroll
    for (int b = 0; b < NSB; ++b)
#pragma unroll
        for (int r = 0; r < 16; ++r) { s[b][r] = fast_exp2(s[b][r] - m); sum += s[b][r]; }
    sum = xhalf_sum(sum);
    l += sum;
#pragma unroll
    for (int b = 0; b < NSB; ++b) { p[b][0] = pack8(s[b], 0); p[b][1] = pack8(s[b], 8); }
}
__device__ __forceinline__ unsigned vt_addr(int lane, int krow0, int c, int t) {
    const unsigned h = lane >> 5, blk = (lane >> 4) & 1, q = (lane & 15) >> 2, p = lane & 3;
    return off_b(krow0 + 8 * t + 4 * h + q, 4 * c + 2 * blk + (p >> 1)) + 8 * (p & 1);
}
__device__ __forceinline__ bf16x8 vfrag(LAS const unsigned char* img, int lane, int krow0, int c) {
    const s16x4 lo = vtr(img + vt_addr(lane, krow0, c, 0)), hi = vtr(img + vt_addr(lane, krow0, c, 1));
    return (bf16x8){lo[0], lo[1], lo[2], lo[3], hi[0], hi[1], hi[2], hi[3]};
}
__device__ __forceinline__ unsigned krow_base(int lane) { const unsigned r = lane & 31, h = lane >> 5, x = ((r & 3) << 2) | ((r >> 2) & 3); return 256u * r + 16u * ((x & 14u) | (h ^ (x & 1u))); }
__device__ __forceinline__ unsigned vt_base(int lane) { const unsigned h = lane >> 5, blk = (lane >> 4) & 1, q = (lane & 15) >> 2, p = lane & 3; const unsigned low0 = (2 * blk + (p >> 1)) ^ h;
    return 256u * (4 * h + q) + 64u * q + 16u * low0 + 8u * (p & 1); }
__device__ __forceinline__ bf16x8 vfrag2(LAS const unsigned char* img, unsigned vb, int c, int imm) {
    const unsigned a0 = vb ^ (unsigned)(c << 6);
    const s16x4 lo = vtr(img + a0 + imm), hi = vtr(img + (a0 ^ 32u) + imm + 2048);
    return (bf16x8){lo[0], lo[1], lo[2], lo[3], hi[0], hi[1], hi[2], hi[3]};
}
__device__ __forceinline__ float log_sigmoid_(float x) { return x > 0.f ? -log1pf(expf(-x)) : x - log1pf(expf(x)); }

constexpr int FOX_KV = 0, FOX_CUM = 65536, FOX_SCAN = FOX_CUM + 16384, FOX_KMAX = FOX_SCAN + 64, FOX_FLAGS = FOX_SCAN + 128;
constexpr float FOX_SKIP_LOG2 = 64.0f;
template <int CTRL> __device__ __forceinline__ float dpp_(float v) { return __int_as_float(__builtin_amdgcn_update_dpp(0, __float_as_int(v), CTRL, 0xF, 0xF, true)); }
__device__ __forceinline__ float row16_sum(float s) { s += dpp_<0xB1>(s); s += dpp_<0x4E>(s); s += dpp_<0x141>(s); s += dpp_<0x140>(s); return s; }
__device__ __forceinline__ float wave_max_u(float v) {
    v = fmaxf(v, dpp_<0xB1>(v)); v = fmaxf(v, dpp_<0x4E>(v)); v = fmaxf(v, dpp_<0x141>(v)); v = fmaxf(v, dpp_<0x140>(v));
    const float a0 = __int_as_float(__builtin_amdgcn_readlane(__float_as_int(v), 0)), a1 = __int_as_float(__builtin_amdgcn_readlane(__float_as_int(v), 16));
    const float a2 = __int_as_float(__builtin_amdgcn_readlane(__float_as_int(v), 32)), a3 = __int_as_float(__builtin_amdgcn_readlane(__float_as_int(v), 48));
    return fmaxf(fmaxf(a0, a1), fmaxf(a2, a3));
}
__device__ __forceinline__ void fox_scan(const GAS bf16_t* proj, const GAS u64* kn, const GAS float* bfp, int b, int hd, LAS unsigned char* lds, int tid, int lane, int wave) {
    LAS float* cumL = (LAS float*)(lds + FOX_CUM); LAS float* scanL = (LAS float*)(lds + FOX_SCAN); LAS float* kmaxL = (LAS float*)(lds + FOX_KMAX);
    const float bias = bfp[hd]; float v[8]; float run = 0.f;
#pragma unroll
    for (int i = 0; i < 8; ++i) { const float f = bf2f(proj[(size_t)(b * SEQ + 8 * tid + i) * EN + E_FA + hd]); run += log_sigmoid_(f + bias); v[i] = run; }
    float inc = run;
#pragma unroll
    for (int o = 1; o < 64; o <<= 1) { const float t = __shfl_up(inc, o); if (lane >= o) inc += t; }
    float kq = 0.f;
    { const GAS u64* kp = kn + (size_t)hd * M + (size_t)b * SEQ + 8 * tid;
#pragma unroll
      for (int i = 0; i < 8; ++i) kq = fmaxf(kq, (float)kp[i] * (1.0f / 16777216.0f)); }
    kq = wave_max_u(kq);
    if (lane == 63) scanL[wave] = inc;
    if (lane == 0) scanL[8 + wave] = kq;
    __syncthreads();
    float wbase = 0.f, km = 0.f;
#pragma unroll
    for (int w = 0; w < 8; ++w) { const float t = scanL[w]; if (w < wave) wbase += t; km = fmaxf(km, scanL[8 + w]); }
    const float excl = wbase + inc - run;
#pragma unroll
    for (int i = 0; i < 8; ++i) cumL[8 * tid + i] = -(excl + v[i]) * LOG2E;
    if (tid == 0) kmaxL[0] = sqrtf(km) * 1.005f;
    __syncthreads();
}
__device__ __forceinline__ void fox_unit(const GAS bf16_t* proj, GAS bf16_t* yin, int b, int hd, int qb, LAS unsigned char* lds, int tid, int lane, int wave) {
    const LAS float* cumL = (const LAS float*)(lds + FOX_CUM); volatile LAS int* flags = (volatile LAS int*)(lds + FOX_FLAGS);
    const int t0 = 256 * qb, q0 = t0 + 32 * wave, qme = q0 + (lane & 31), h = lane >> 5;
    const size_t rowb = (size_t)b * SEQ;
    const float cs = 0.08838834764831845f * LOG2E;
    const unsigned kbase = krow_base(lane), vbase = vt_base(lane);
    bf16x8 qf[8];
    { const GAS bf16_t* qp = proj + (rowb + qme) * EN + E_QA + hd * 128 + 8 * h;
#pragma unroll
      for (int s = 0; s < 8; ++s) qf[s] = *(const GAS bf16x8*)(qp + 16 * s); }
    float qn2 = 0.f;
#pragma unroll
    for (int s = 0; s < 8; ++s)
#pragma unroll
        for (int e = 0; e < 8; ++e) { const float x = bf2f((unsigned short)qf[s][e]); qn2 += x * x; }
    qn2 = xhalf_sum(qn2);
    const float cbound = sqrtf(qn2) * 1.0001f * ((const LAS float*)(lds + FOX_KMAX))[0] * cs;
    f32x16 o[4];
#pragma unroll
    for (int c = 0; c < 4; ++c)
#pragma unroll
        for (int r = 0; r < 16; ++r) o[c][r] = 0.f;
    float m = -1e30f, l = 0.f;
    const int ntile = 4 * (qb + 1);
    const int r0 = tid >> 4, c0 = tid & 15;
    const GAS bf16_t* kg = proj + (rowb + r0) * EN + E_KA + hd * 128 + c0 * 8;
    const GAS bf16_t* vg = proj + (rowb + r0) * EN + E_VA + hd * 128 + c0 * 8;
    const unsigned so0 = off_b(r0, c0), so1 = off_b(r0 + 32, c0);
    u32x4 sk0, sk1, sv0, sv1;
    { const size_t adv = (size_t)64 * (ntile - 1) * EN; sk0 = *(const GAS u32x4*)(kg + adv); sk1 = *(const GAS u32x4*)(kg + adv + (size_t)32 * EN); sv0 = *(const GAS u32x4*)(vg + adv); sv1 = *(const GAS u32x4*)(vg + adv + (size_t)32 * EN); }
    __syncthreads();
    { LAS unsigned char* kb = lds + FOX_KV; *(LAS u32x4*)(kb + so0) = sk0; *(LAS u32x4*)(kb + so1) = sk1; *(LAS u32x4*)(kb + 16384 + so0) = sv0; *(LAS u32x4*)(kb + 16384 + so1) = sv1; }
    __syncthreads();
    bool done_w = false;
    for (int it = 0; it < ntile; ++it) {
        const int kt = ntile - 1 - it, cur = it & 1; const LAS unsigned char* Kt = lds + FOX_KV + cur * 32768; const LAS unsigned char* Vt = Kt + 16384;
        const bool more = kt > 0;
        if (more) { const size_t adv = (size_t)64 * (kt - 1) * EN; sk0 = *(const GAS u32x4*)(kg + adv); sk1 = *(const GAS u32x4*)(kg + adv + (size_t)32 * EN); sv0 = *(const GAS u32x4*)(vg + adv); sv1 = *(const GAS u32x4*)(vg + adv + (size_t)32 * EN); }
        const int k0 = 64 * kt;
        if (k0 <= q0 + 31 && !done_w) {
            f32x16 sc[2];
#pragma unroll
            for (int kb = 0; kb < 2; ++kb) {
#pragma unroll
                for (int r = 0; r < 16; ++r) sc[kb][r] = 0.f;
#pragma unroll
                for (int s = 0; s < 8; ++s) { const bf16x8 a = *(const LAS bf16x8*)(Kt + (kbase ^ (unsigned)(s << 5)) + 8192 * kb); sc[kb] = __builtin_amdgcn_mfma_f32_32x32x16_bf16(a, qf[s], sc[kb], 0, 0, 0); }
            }
            const bool diag = (k0 + 63 > q0);
#pragma unroll
            for (int kb = 0; kb < 2; ++kb)
#pragma unroll
                for (int g4 = 0; g4 < 4; ++g4) { const int key0 = k0 + 32 * kb + 8 * g4 + 4 * h; const f32x4 nb = *(const LAS f32x4*)(cumL + key0);
#pragma unroll
                    for (int e = 0; e < 4; ++e) { float v = sc[kb][4 * g4 + e] * cs + nb[e]; if (diag && (key0 + e > qme)) v = -1e30f; sc[kb][4 * g4 + e] = v; } }
            bf16x8 p[2][2];
            sm_step<2, 4>(sc, m, l, o, p);
#pragma unroll
            for (int c = 0; c < 4; ++c)
#pragma unroll
                for (int kb = 0; kb < 2; ++kb)
#pragma unroll
                    for (int s = 0; s < 2; ++s) { const bf16x8 a = vfrag2(Vt, vbase, c, 256 * (32 * kb + 16 * s)); o[c] = __builtin_amdgcn_mfma_f32_32x32x16_bf16(a, p[kb][s], o[c], 0, 0, 0); }
            if (more) { const float amax = wave_max_u(cbound - m); done_w = (amax + cumL[k0 - 1] < -FOX_SKIP_LOG2); }
        }
        if (lane == 0) flags[cur * 8 + wave] = done_w ? 1 : 0;
        if (more) { LAS unsigned char* kb = lds + FOX_KV + (cur ^ 1) * 32768; *(LAS u32x4*)(kb + so0) = sk0; *(LAS u32x4*)(kb + so1) = sk1; *(LAS u32x4*)(kb + 16384 + so0) = sv0; *(LAS u32x4*)(kb + 16384 + so1) = sv1; }
        __syncthreads();
        int alld = 1;
#pragma unroll
        for (int w = 0; w < 8; ++w) alld &= flags[cur * 8 + w];
        if (alld) break;
    }
    const float il = 1.0f / l;
    const GAS bf16_t* gp = proj + (rowb + qme) * EN + E_GA + hd * 128 + 4 * h; GAS bf16_t* yp = yin + (rowb + qme) * DM + hd * 128 + 4 * h;
#pragma unroll
    for (int c = 0; c < 4; ++c)
#pragma unroll
        for (int g4 = 0; g4 < 4; ++g4) { const u32x2 gw = *(const GAS u32x2*)(gp + 32 * c + 8 * g4);
            u32x2 w; w.x = cvtpk(o[c][4 * g4 + 0] * il * siluf_(bflo(gw.x)), o[c][4 * g4 + 1] * il * siluf_(bfhi(gw.x))); w.y = cvtpk(o[c][4 * g4 + 2] * il * siluf_(bflo(gw.y)), o[c][4 * g4 + 3] * il * siluf_(bfhi(gw.y)));
            *(GAS u32x2*)(yp + 32 * c + 8 * g4) = w; }
}

constexpr int SWA_K = 0, SWA_V = 65536, SWA_TB = 131072;
__device__ __forceinline__ int t5_bucket_(int rel) {
    if (rel < 16) return rel;
    if (rel >= 128) return 31;
    const int v = 16 + (int)(logf((float)rel * (1.0f / 16.0f)) / 2.0794415416798357f * 16.0f);
    return v < 31 ? v : 31;
}
__device__ __forceinline__ void swa_unit(const GAS bf16_t* proj, GAS bf16_t* yin, const GAS float* t5, const GAS float* sinks, int b, int nb, int kvh, LAS unsigned char* lds, int tid, int lane, int wave) {
    const size_t rowb = (size_t)b * SEQ; const int hq = kvh * 8 + wave, h = lane >> 5;
    __syncthreads();
#pragma unroll
    for (int i = 0; i < 4; ++i) { const int c = tid + 512 * i, row = c >> 3, ch = c & 7; const int key = 128 * (nb - 1) + row;
        u32x4 kv = zero4_(), vv = kv;
        if (key >= 0) { const GAS bf16_t* src = proj + (rowb + key) * EN + kvh * 64 + ch * 8; kv = *(const GAS u32x4*)(src + E_KB); vv = *(const GAS u32x4*)(src + E_VB); }
        *(LAS u32x4*)(lds + SWA_K + off_b(row, ch)) = kv; *(LAS u32x4*)(lds + SWA_V + off_b(row, ch)) = vv; }
    LAS float* tb = (LAS float*)(lds + SWA_TB + wave * 512);
#pragma unroll
    for (int i = 0; i < 2; ++i) { const int rel = lane + 64 * i; tb[rel] = t5[t5_bucket_(rel) * 64 + hq] * LOG2E; }
    __syncthreads();
    const float cs = 0.125f * LOG2E, sink2 = sinks[hq] * LOG2E;
    const unsigned kbase = krow_base(lane), vbase = vt_base(lane);
    for (int cg = 0; cg < 4; ++cg) {
        const int qi = 32 * cg + (lane & 31); const size_t row = rowb + 128 * nb + qi;
        bf16x8 qf[4];
        { const GAS bf16_t* qp = proj + row * EN + E_QB + hq * 64 + 8 * h;
#pragma unroll
          for (int s = 0; s < 4; ++s) qf[s] = *(const GAS bf16x8*)(qp + 16 * s); }
        f32x16 o[2];
#pragma unroll
        for (int c = 0; c < 2; ++c)
#pragma unroll
            for (int r = 0; r < 16; ++r) o[c][r] = 0.f;
        float m = sink2, l = 1.0f;
        for (int kb = cg; kb < cg + 5; ++kb) {
            f32x16 sc[1];
#pragma unroll
            for (int r = 0; r < 16; ++r) sc[0][r] = 0.f;
#pragma unroll
            for (int s = 0; s < 4; ++s) { const bf16x8 a = *(const LAS bf16x8*)(lds + SWA_K + (kbase ^ (unsigned)(s << 5)) + 8192 * kb); sc[0] = __builtin_amdgcn_mfma_f32_32x32x16_bf16(a, qf[s], sc[0], 0, 0, 0); }
#pragma unroll
            for (int r = 0; r < 16; ++r) { const int kj = 32 * kb + (r & 3) + 8 * (r >> 2) + 4 * h, rel = qi + 128 - kj;
                const bool valid = (rel >= 0) && (rel < 128) && (nb > 0 || kj >= 128);
                const float bias = tb[rel & 127];
                sc[0][r] = sc[0][r] * cs + bias + (valid ? 0.f : -1e30f); }
            bf16x8 p[1][2];
            sm_step<1, 2>(sc, m, l, o, p);
#pragma unroll
            for (int c = 0; c < 2; ++c)
#pragma unroll
                for (int s = 0; s < 2; ++s) { const bf16x8 a = vfrag2(lds + SWA_V + 8192 * kb, vbase, c, 4096 * s); o[c] = __builtin_amdgcn_mfma_f32_32x32x16_bf16(a, p[0][s], o[c], 0, 0, 0); }
        }
        const float il = 1.0f / l;
        const GAS bf16_t* gp = proj + row * EN + E_GB + hq * 64 + 4 * h; GAS bf16_t* yp = yin + row * DM + 2048 + hq * 64 + 4 * h;
#pragma unroll
        for (int c = 0; c < 2; ++c)
#pragma unroll
            for (int g4 = 0; g4 < 4; ++g4) { const u32x2 gw = *(const GAS u32x2*)(gp + 32 * c + 8 * g4);
                u32x2 w; w.x = cvtpk(o[c][4 * g4 + 0] * il * siluf_(bflo(gw.x)), o[c][4 * g4 + 1] * il * siluf_(bfhi(gw.x))); w.y = cvtpk(o[c][4 * g4 + 2] * il * siluf_(bflo(gw.y)), o[c][4 * g4 + 3] * il * siluf_(bfhi(gw.y)));
                *(GAS u32x2*)(yp + 32 * c + 8 * g4) = w; }
    }
}
__device__ __forceinline__ void phase_even_attn(const Args& a, int j, LAS unsigned char* lds, int G, int bx, const int wave, const int which) {
    const int lane = lane_id_(), tid = wave * 64 + lane;
    unsigned char* ws_ = a.ws; OPAQUE_S(ws_); GAS unsigned char* ws = (GAS unsigned char*)ws_;
    const GAS bf16_t* proj = (const GAS bf16_t*)(ws + WS_PROJ); GAS bf16_t* yin = (GAS bf16_t*)(ws + WS_YIN);
    if (which & 1) for (int u = bx; u < 256; u += G) {
        const int b = u >> 7, hd = (u >> 3) & 15, i = u & 7;
        __syncthreads();
        fox_scan(proj, (const GAS u64*)(ws + WS_KN) + (size_t)j * 16 * M, ((const GAS float*)a.in[I_EBF]) + j * 16, b, hd, lds, tid, lane, wave);
        fox_unit(proj, yin, b, hd, 15 - i, lds, tid, lane, wave);
        fox_unit(proj, yin, b, hd, i, lds, tid, lane, wave);
    }
    if (which & 2) for (int u = bx; u < 256; u += G) {
        const int b = u >> 7, nb = (u >> 2) & 31, kvh = u & 3;
        swa_unit(proj, yin, ((const GAS float*)a.in[I_T5]), ((const GAS float*)a.in[I_ESINK]) + j * 32, b, nb, kvh, lds, tid, lane, wave);
    }
    __syncthreads();
}

#define BAR_LDS() asm volatile("s_waitcnt lgkmcnt(0)\n\ts_barrier" ::: "memory")
__device__ __forceinline__ void phase_odd_norms(const Args& a, int j, int gw, int NGW) {
    const int lane = lane_id_();
    unsigned char* ws_ = a.ws; OPAQUE_S(ws_); GAS unsigned char* ws = (GAS unsigned char*)ws_;
    const GAS bf16_t* proj = (const GAS bf16_t*)(ws + WS_PROJ); GAS bf16_t* cqn = (GAS bf16_t*)(ws + WS_CQN); GAS bf16_t* lat = (GAS bf16_t*)(ws + WS_LAT); GAS bf16_t* kidx = (GAS bf16_t*)(ws + WS_KIDX); GAS float* widx = (GAS float*)(ws + WS_WIDX);
    const GAS float* qg = ((const GAS float*)a.in[I_OQNG]) + j * 1024; const GAS float* kvg = ((const GAS float*)a.in[I_OKVNG]) + j * 512; const GAS float* lng = ((const GAS float*)a.in[I_OLNG]) + j * 64; const GAS float* lnb = ((const GAS float*)a.in[I_OLNB]) + j * 64;
    for (int row = gw; row < M; row += NGW) {
        const GAS bf16_t* pr = proj + (size_t)row * ON;
        {
            const u32x4 w0 = *(const GAS u32x4*)(pr + O_CQ + lane * 8), w1 = *(const GAS u32x4*)(pr + O_CQ + 512 + lane * 8);
            float v[16] = {bflo(w0.x), bfhi(w0.x), bflo(w0.y), bfhi(w0.y), bflo(w0.z), bfhi(w0.z), bflo(w0.w), bfhi(w0.w), bflo(w1.x), bfhi(w1.x), bflo(w1.y), bfhi(w1.y), bflo(w1.z), bfhi(w1.z), bflo(w1.w), bfhi(w1.w)};
            float ss = 0.f;
#pragma unroll
            for (int i = 0; i < 16; ++i) ss += v[i] * v[i];
            ss = wave_sum(ss); const float r = 1.0f / sqrtf(ss * (1.0f / 1024.0f) + EPS);
            const f32x4 g0 = *(const GAS f32x4*)(qg + lane * 8), g1 = *(const GAS f32x4*)(qg + lane * 8 + 4), g2 = *(const GAS f32x4*)(qg + 512 + lane * 8), g3 = *(const GAS f32x4*)(qg + 512 + lane * 8 + 4);
            u32x4 o0, o1;
            o0.x = cvtpk(v[0] * r * g0[0], v[1] * r * g0[1]); o0.y = cvtpk(v[2] * r * g0[2], v[3] * r * g0[3]); o0.z = cvtpk(v[4] * r * g1[0], v[5] * r * g1[1]); o0.w = cvtpk(v[6] * r * g1[2], v[7] * r * g1[3]);
            o1.x = cvtpk(v[8] * r * g2[0], v[9] * r * g2[1]); o1.y = cvtpk(v[10] * r * g2[2], v[11] * r * g2[3]); o1.z = cvtpk(v[12] * r * g3[0], v[13] * r * g3[1]); o1.w = cvtpk(v[14] * r * g3[2], v[15] * r * g3[3]);
            *(GAS u32x4*)(cqn + (size_t)row * 1024 + lane * 8) = o0; *(GAS u32x4*)(cqn + (size_t)row * 1024 + 512 + lane * 8) = o1;
        }
        {
            const u32x4 w0 = *(const GAS u32x4*)(pr + O_CKV + lane * 8);
            float v[8] = {bflo(w0.x), bfhi(w0.x), bflo(w0.y), bfhi(w0.y), bflo(w0.z), bfhi(w0.z), bflo(w0.w), bfhi(w0.w)};
            float ss = 0.f;
#pragma unroll
            for (int i = 0; i < 8; ++i) ss += v[i] * v[i];
            ss = wave_sum(ss); const float r = 1.0f / sqrtf(ss * (1.0f / 512.0f) + EPS);
            const f32x4 g0 = *(const GAS f32x4*)(kvg + lane * 8), g1 = *(const GAS f32x4*)(kvg + lane * 8 + 4);
            u32x4 o0; o0.x = cvtpk(v[0] * r * g0[0], v[1] * r * g0[1]); o0.y = cvtpk(v[2] * r * g0[2], v[3] * r * g0[3]); o0.z = cvtpk(v[4] * r * g1[0], v[5] * r * g1[1]); o0.w = cvtpk(v[6] * r * g1[2], v[7] * r * g1[3]);
            *(GAS u32x4*)(lat + (size_t)row * 512 + lane * 8) = o0;
        }
        {
            const float x = bf2f(pr[O_KIDX + lane]); const float mu = wave_sum(x) * (1.0f / 64.0f); const float xc = x - mu; const float var = wave_sum(xc * xc) * (1.0f / 64.0f);
            const float y = xc * (1.0f / sqrtf(var + EPS)) * lng[lane] + lnb[lane];
            kidx[(size_t)row * 64 + lane] = (bf16_t)(cvtpk(y, 0.f) & 0xffffu);
        }
        if (lane < 32) widx[(size_t)row * 32 + lane] = bf2f(pr[O_WIDX + lane]) * 0.022097086912079608f;
    }
}

__device__ __forceinline__ unsigned sortable_(float f) { const unsigned u = __float_as_uint(f); return (u & 0x80000000u) ? ~u : (u | 0x80000000u); }
__device__ __forceinline__ int wave_isum(int v) {
#pragma unroll
    for (int o = 1; o < 64; o <<= 1) v += __shfl_xor(v, o);
    return v;
}
__device__ __forceinline__ void topk_row(const GAS float* srow, GAS int* sel, int t, int lane) {
    const int nvalid = t + 1;
    if (nvalid <= 256) {
#pragma unroll
        for (int i = 0; i < 4; ++i) sel[64 * i + lane] = (64 * i + lane < nvalid) ? 64 * i + lane : 0;
        return;
    }
    unsigned key[64];
    const int ngrp = (nvalid + 511) >> 9;
#pragma unroll
    for (int g = 0; g < 8; ++g) {
        if (g < ngrp) {
#pragma unroll
            for (int i = 8 * g; i < 8 * g + 8; ++i) { const int e = 64 * i + lane; const float v = srow[e]; key[i] = (e < nvalid) ? sortable_(v) : 0u; }
        } else {
#pragma unroll
            for (int i = 8 * g; i < 8 * g + 8; ++i) key[i] = 0u;
        }
    }
    unsigned T = 0u;
#pragma unroll 1
    for (int bit = 31; bit >= 0; --bit) {
        const unsigned cand = T | (1u << bit); int cnt = 0;
#pragma unroll
        for (int g = 0; g < 8; ++g) {
            if (g < ngrp) {
#pragma unroll
                for (int i = 0; i < 8; ++i) cnt += __builtin_popcountll(__ballot(key[8 * g + i] >= cand));
            }
            __builtin_amdgcn_sched_barrier(0);
        }
        if (cnt >= 256) T = cand;
        if (cnt == 256) break;
    }
    int cgt = 0;
#pragma unroll
    for (int g = 0; g < 8; ++g) {
        if (g < ngrp) {
#pragma unroll
            for (int i = 0; i < 8; ++i) cgt += __builtin_popcountll(__ballot(key[8 * g + i] > T));
        }
        __builtin_amdgcn_sched_barrier(0);
    }
    const int need = 256 - cgt; int pos = 0, eqseen = 0;
#pragma unroll
    for (int g = 0; g < 8; ++g) {
        if (g < ngrp) {
#pragma unroll
            for (int i = 8 * g; i < 8 * g + 8; ++i) {
                const bool gt = key[i] > T, eq = key[i] == T;
                const unsigned long long meq = __ballot(eq);
                const int rank = eqseen + (int)__builtin_amdgcn_mbcnt_hi((unsigned)(meq >> 32), __builtin_amdgcn_mbcnt_lo((unsigned)meq, 0u));
                const bool take = gt || (eq && rank < need);
                const unsigned long long mt = __ballot(take);
                const int p = pos + (int)__builtin_amdgcn_mbcnt_hi((unsigned)(mt >> 32), __builtin_amdgcn_mbcnt_lo((unsigned)mt, 0u));
                if (take && p < 256) sel[p] = 64 * i + lane;
                pos += __builtin_popcountll(mt); eqseen += __builtin_popcountll(meq);
            }
        }
    }
}
__device__ __forceinline__ void phase_indexer(const Args& a, LAS unsigned char* lds, int G, int bx, const int wave, const bool do_topk) {
    unsigned char* ws_ = a.ws; OPAQUE_S(ws_); GAS unsigned char* ws = (GAS unsigned char*)ws_;
    const GAS bf16_t* qbuf = (const GAS bf16_t*)(ws + WS_QBUF); const GAS bf16_t* kidx = (const GAS bf16_t*)(ws + WS_KIDX); const GAS float* widx = (const GAS float*)(ws + WS_WIDX);
    GAS float* score = (GAS float*)(ws + WS_SCORE) + (size_t)bx * 16 * 4096; GAS int* sel = (GAS int*)(ws + WS_SEL);
    for (int u = bx; u < 256; u += G) {
        const int b = u >> 7, i0 = u & 127;
        for (int half = 0; half < 2; ++half) {
            const int lane = lane_id_(), tid = wave * 64 + lane, h = lane >> 5;
            const unsigned key = lane & 31, x = (key >> 1) & 7;
            const unsigned bbase = 128u * key + 16u * ((x & 6u) | ((unsigned)h ^ (x & 1u)));
            const int qg = half ? 255 - i0 : i0;
            const int tq = 16 * qg + 2 * wave; const size_t rowb = (size_t)b * SEQ;
            bf16x8 qa[2][4]; f32x4 wv[2][4];
#pragma unroll
            for (int q = 0; q < 2; ++q) { const GAS bf16_t* qp = qbuf + (rowb + tq + q) * QW + 4096 + (lane & 31) * 64 + 8 * h; const GAS float* wp = widx + (rowb + tq + q) * 32 + 4 * h;
#pragma unroll
                for (int s = 0; s < 4; ++s) qa[q][s] = *(const GAS bf16x8*)(qp + 16 * s);
#pragma unroll
                for (int g4 = 0; g4 < 4; ++g4) wv[q][g4] = *(const GAS f32x4*)(wp + 8 * g4); }
            const int kmax = 16 * qg + 15, ntile = kmax / 256 + 1;
            const GAS bf16_t* kg = kidx + rowb * 64 + tid * 8;
            u32x4 st[4];
#pragma unroll
            for (int i = 0; i < 4; ++i) st[i] = *(const GAS u32x4*)(kg + i * 4096);
            __syncthreads();
#pragma unroll
            for (int i = 0; i < 4; ++i) { const int c = tid + 512 * i, row = c >> 3, ch = c & 7; *(LAS u32x4*)(lds + row * 128 + ((ch ^ ((row >> 1) & 7)) << 4)) = st[i]; }
            __syncthreads();
            for (int kt = 0; kt < ntile; ++kt) {
                const int cur = kt & 1; const bool more = kt + 1 < ntile;
                if (more) {
#pragma unroll
                    for (int i = 0; i < 4; ++i) st[i] = *(const GAS u32x4*)(kg + (size_t)(kt + 1) * 16384 + i * 4096); }
                const LAS unsigned char* Kt = lds + cur * 32768;
                const int nkb = (kmax - 256 * kt) / 32 + 1 < 8 ? (kmax - 256 * kt) / 32 + 1 : 8;
#define IDX_LOAD(B, kb_) do { _Pragma("unroll") for (int s_ = 0; s_ < 4; ++s_) B[s_] = *(const LAS bf16x8*)(Kt + (bbase ^ (unsigned)(s_ << 5)) + 4096 * (kb_)); } while (0)
#define IDX_BLOCK(B, kb_) do { f32x16 acc0, acc1; \
                    _Pragma("unroll") for (int r = 0; r < 16; ++r) { acc0[r] = 0.f; acc1[r] = 0.f; } \
                    _Pragma("unroll") for (int s_ = 0; s_ < 4; ++s_) acc0 = __builtin_amdgcn_mfma_f32_32x32x16_bf16(qa[0][s_], B[s_], acc0, 0, 0, 0); \
                    _Pragma("unroll") for (int s_ = 0; s_ < 4; ++s_) acc1 = __builtin_amdgcn_mfma_f32_32x32x16_bf16(qa[1][s_], B[s_], acc1, 0, 0, 0); \
                    float sc0 = 0.f, sc1 = 0.f; \
                    _Pragma("unroll") for (int r = 0; r < 16; ++r) sc0 += wv[0][r >> 2][r & 3] * fmaxf(acc0[r], 0.f); \
                    _Pragma("unroll") for (int r = 0; r < 16; ++r) sc1 += wv[1][r >> 2][r & 3] * fmaxf(acc1[r], 0.f); \
                    sc0 = xhalf_sum(sc0); sc1 = xhalf_sum(sc1); \
                    if (lane < 32) { score[(size_t)(2 * wave) * 4096 + 256 * kt + 32 * (kb_) + lane] = sc0; score[(size_t)(2 * wave + 1) * 4096 + 256 * kt + 32 * (kb_) + lane] = sc1; } } while (0)
                { bf16x8 fa[4], fb[4];
                  IDX_LOAD(fa, 0);
                  for (int kb = 0; kb < nkb; kb += 2) {
                      if (kb + 1 < nkb) IDX_LOAD(fb, kb + 1);
                      IDX_BLOCK(fa, kb);
                      if (kb + 1 < nkb) { if (kb + 2 < nkb) IDX_LOAD(fa, kb + 2); IDX_BLOCK(fb, kb + 1); }
                  } }
#undef IDX_LOAD
#undef IDX_BLOCK
                if (more) {
#pragma unroll
                    for (int i = 0; i < 4; ++i) { const int c = tid + 512 * i, row = c >> 3, ch = c & 7; *(LAS u32x4*)(lds + (cur ^ 1) * 32768 + row * 128 + ((ch ^ ((row >> 1) & 7)) << 4)) = st[i]; } }
                __syncthreads();
            }
            VM_WAIT();
            __builtin_amdgcn_fence(__ATOMIC_ACQUIRE, "agent");
            VM_WAIT();
            if (do_topk) { const int lane2 = lane_id_();
#pragma unroll 1
              for (int q = 0; q < 2; ++q) topk_row(score + (size_t)(2 * wave + q) * 4096, sel + (rowb + tq + q) * 256, tq + q, lane2); }
        }
    }
    __syncthreads();
}

constexpr int DSA_LAT = 0, DSA_XCH = 65536, DSA_TAB = 131072, DSA_T5 = 143360, DSA_TCNT = 147456;
__device__ __forceinline__ void phase_dsa(const Args& a, LAS unsigned char* lds, int G, int bx, const int wave, const int mode) {
    (void)mode;
    const int lane = lane_id_(), tid = wave * 64 + lane, h = lane >> 5, team = wave >> 2, wq = wave & 3, ttid = tid & 255;
    unsigned char* ws_ = a.ws; OPAQUE_S(ws_); GAS unsigned char* ws = (GAS unsigned char*)ws_;
    const GAS bf16_t* qabs = (const GAS bf16_t*)(ws + WS_QABS); const GAS bf16_t* lat = (const GAS bf16_t*)(ws + WS_LAT); const GAS int* sel = (const GAS int*)(ws + WS_SEL); GAS bf16_t* olat = (GAS bf16_t*)(ws + WS_OLAT);
    LAS float* t5c = (LAS float*)(lds + DSA_T5);
    volatile LAS unsigned* tcnt = (volatile LAS unsigned*)(lds + DSA_TCNT + team * 64);
    __syncthreads();
    for (int i = tid; i < 1024; i += 512) t5c[i] = ((const GAS float*)a.in[I_T5])[(i >> 5) * 64 + 32 + (i & 31)] * LOG2E;
    if (tid < 32) ((volatile LAS unsigned*)(lds + DSA_TCNT))[tid] = 0u;
    __syncthreads();
    LAS unsigned char* latw = lds + DSA_LAT + wave * 8192; LAS unsigned char* xch = lds + DSA_XCH + team * 32768;
    LAS unsigned char* tabs = lds + DSA_TAB + team * 6144;
#define TAB_SEL(p) ((LAS int*)(tabs + (p) * 3072))
#define TAB_BKT(p) ((LAS int*)(tabs + (p) * 3072 + 1024))
#define TAB_MADD(p) ((LAS float*)(tabs + (p) * 3072 + 2048))
    const unsigned kbase = krow_base(lane), vbase = vt_base(lane);
    const float cs = 0.08838834764831845f * LOG2E;
    unsigned tepoch = 0u;
#define TEAM_BAR() do { asm volatile("s_waitcnt lgkmcnt(0)" ::: "memory"); ++tepoch; if (lane == 0) __hip_atomic_fetch_add((LAS unsigned*)tcnt, 1u, __ATOMIC_RELAXED, __HIP_MEMORY_SCOPE_WORKGROUP); \
        while (__builtin_amdgcn_readfirstlane((int)*tcnt) < (int)(4u * tepoch)) __builtin_amdgcn_s_sleep(1); asm volatile("" ::: "memory"); } while (0)
    const int gr = lane >> 4, gc = lane & 15;
    const unsigned wbase = 256u * gr + 16u * (gc ^ (gr << 2));
#define DSA_TABLES(p, qq, idxv) do { const int t_ = (qq) & 4095, ns_ = t_ + 1 < 256 ? t_ + 1 : 256; const bool valid_ = ttid < ns_; const int id_ = valid_ ? (idxv) : 0; \
        TAB_SEL(p)[ttid] = id_; TAB_BKT(p)[ttid] = 128 * t5_bucket_(valid_ ? t_ - id_ : 0); TAB_MADD(p)[ttid] = valid_ ? 0.f : -1e30f; } while (0)
#define DSA_SELLOAD(qq) ((ttid < ((((qq) & 4095) + 1 < 256) ? ((qq) & 4095) + 1 : 256)) ? sel[(size_t)(qq) * 256 + ttid] : 0)
#define DSA_QLOAD(qq) do { const GAS bf16_t* qp_ = qabs + (size_t)(qq) * 16384 + (lane & 31) * 512 + 128 * wq + 8 * h; _Pragma("unroll") for (int s_ = 0; s_ < 8; ++s_) qf[s_] = *(const GAS bf16x8*)(qp_ + 16 * s_); } while (0)
#define DSA_GATHER(ST, lr, tab, cc) do { _Pragma("unroll") for (int i = 0; i < 8; ++i) ST[i] = *(const GAS u32x4*)((lr) + (size_t)(tab)[32 * (cc) + gr + 4 * i] * 512); } while (0)
    int qp = bx, par = 0;
    bf16x8 qf[8]; u32x4 stA[8], stB[8];
    int nxt_idx = 0;
    { const int q0 = 2 * qp + team;
      DSA_TABLES(0, q0, sel[(size_t)q0 * 256 + ttid]);
      if (qp + G < 4096) nxt_idx = DSA_SELLOAD(q0 + 2 * G);
      DSA_QLOAD(q0);
      TEAM_BAR();
      const GAS bf16_t* lr0 = lat + (size_t)(q0 >> 12) * SEQ * 512 + 128 * wq + gc * 8;
      DSA_GATHER(stA, lr0, TAB_SEL(0), 0); DSA_GATHER(stB, lr0, TAB_SEL(0), 1); }
    for (; qp < 4096; qp += G, par ^= 1) {
        const int q = 2 * qp + team, b = q >> 12;
        const bool has_next = qp + G < 4096; const int qn = q + 2 * G;
        const LAS int* selP = TAB_SEL(par); const LAS int* bktP = TAB_BKT(par); const LAS float* maddP = TAB_MADD(par); const LAS int* selN = TAB_SEL(par ^ 1);
        const GAS bf16_t* lrow = lat + (size_t)b * SEQ * 512 + 128 * wq + gc * 8;
        const GAS bf16_t* lrowN = lat + (size_t)(qn >> 12) * SEQ * 512 + 128 * wq + gc * 8;
        f32x16 o[4];
#pragma unroll
        for (int c = 0; c < 4; ++c)
#pragma unroll
            for (int r = 0; r < 16; ++r) o[c][r] = 0.f;
        float m = -1e30f, l = 0.f;
#define DSA_CHUNK(ST, c) do { \
            _Pragma("unroll") for (int i = 0; i < 8; ++i) *(LAS u32x4*)(latw + (wbase ^ (unsigned)((i & 3) << 4)) + 1024 * i) = ST[i];        \
            if ((c) + 2 < 8) DSA_GATHER(ST, lrow, selP, (c) + 2); else if (has_next) DSA_GATHER(ST, lrowN, selN, (c) + 2 - 8);        \
            f32x16 sc[1]; \
            _Pragma("unroll") for (int r = 0; r < 16; ++r) sc[0][r] = 0.f; \
            _Pragma("unroll") for (int s_ = 0; s_ < 8; ++s_) { const bf16x8 af = *(const LAS bf16x8*)(latw + (kbase ^ (unsigned)(s_ << 5))); sc[0] = __builtin_amdgcn_mfma_f32_32x32x16_bf16(af, qf[s_], sc[0], 0, 0, 0); } \
            if ((c) == 7 && has_next) DSA_QLOAD(qn);            \
            LAS unsigned char* xc = xch + ((c) & 1) * 8192; \
            _Pragma("unroll") for (int g8 = 0; g8 < 2; ++g8) *(LAS bf16x8*)(xc + wq * 2048 + (g8 * 64 + lane) * 16) = pack8(sc[0], 8 * g8);        \
            TEAM_BAR();                                        \
            _Pragma("unroll") for (int g4 = 0; g4 < 4; ++g4) { \
                f32x4 v = {0.f, 0.f, 0.f, 0.f}; \
                _Pragma("unroll") for (int w = 0; w < 4; ++w) { const u32x2 pw = *(const LAS u32x2*)(xc + w * 2048 + ((g4 >> 1) * 64 + lane) * 16 + (g4 & 1) * 8); v = v + (f32x4){bflo(pw.x), bfhi(pw.x), bflo(pw.y), bfhi(pw.y)}; } \
                const int j0 = 32 * (c) + 8 * g4 + 4 * h; \
                const u32x4 bk4 = *(const LAS u32x4*)(bktP + j0); const f32x4 md4 = *(const LAS f32x4*)(maddP + j0); \
                _Pragma("unroll") for (int e = 0; e < 4; ++e) { const float bias = *(const LAS float*)((const LAS unsigned char*)t5c + bk4[e] + 4 * (lane & 31)); sc[0][4 * g4 + e] = v[e] * cs + bias + md4[e]; } \
            } \
            bf16x8 p[1][2]; \
            sm_step<1, 4>(sc, m, l, o, p); \
            _Pragma("unroll") for (int cc = 0; cc < 4; ++cc) \
                _Pragma("unroll") for (int s_ = 0; s_ < 2; ++s_) { const bf16x8 af = vfrag2(latw, vbase, cc, 4096 * s_); o[cc] = __builtin_amdgcn_mfma_f32_32x32x16_bf16(af, p[0][s_], o[cc], 0, 0, 0); } \
            if ((c) == 3 && has_next) { DSA_TABLES(par ^ 1, qn, nxt_idx);        \
                if (qp + 2 * G < 4096) nxt_idx = DSA_SELLOAD(qn + 2 * G); } \
        } while (0)
        for (int c2 = 0; c2 < 8; c2 += 2) { DSA_CHUNK(stA, c2); DSA_CHUNK(stB, c2 + 1); }
#undef DSA_CHUNK
        const float il = 1.0f / l;
        GAS bf16_t* op = olat + (size_t)q * 16384 + (lane & 31) * 512 + 128 * wq + 4 * h;
#pragma unroll
        for (int cc = 0; cc < 4; ++cc)
#pragma unroll
            for (int g4 = 0; g4 < 4; ++g4) { u32x2 w; w.x = cvtpk(o[cc][4 * g4] * il, o[cc][4 * g4 + 1] * il); w.y = cvtpk(o[cc][4 * g4 + 2] * il, o[cc][4 * g4 + 3] * il); *(GAS u32x2*)(op + 32 * cc + 8 * g4) = w; }
    }
    __syncthreads();
#undef TEAM_BAR
#undef TAB_SEL
#undef TAB_BKT
#undef TAB_MADD
#undef DSA_TABLES
#undef DSA_SELLOAD
#undef DSA_QLOAD
#undef DSA_GATHER
}

constexpr int PH_FINAL = 50, NPH = PH_FINAL + 1;

struct TJob { int in_id; long src_lstride; int ldsrc, K, src_col0, ncols; long dst_off  ; int ldt, dst_row0, gain_id; long gain_lstride, gain_off0; int lsel, flags; };
constexpr int NTJ_E = 12, NTJ_O = 11;
__constant__ TJob g_tj_even[NTJ_E] = {
#define EWIN_JOB(c0, n, r0) {I_EWIN, (long)4096 * 12816, 12816, 4096, c0, n, (long)WS_EWIN, 4096, r0, I_NORMG, (long)2 * 4096, 0, 0, 2}
    EWIN_JOB(0, 2048, E_QA), EWIN_JOB(2048, 2048, E_KA), EWIN_JOB(4096, 2048, E_VA), EWIN_JOB(6160, 2048, E_GA), EWIN_JOB(8208, 2048, E_QB),
    EWIN_JOB(10768, 2048, E_GB), EWIN_JOB(10256, 256, E_KB), EWIN_JOB(10512, 256, E_VB), EWIN_JOB(6144, 16, E_FA),
    {I_EWOUT, (long)4096 * 4096, 4096, 4096, 0, 4096, (long)WS_EWOUT, 4096, 0, -1, 0, 0, 0, 2},
    {I_PWGATE, (long)4096 * 4096, 4096, 4096, 0, 4096, (long)WS_EGATE, 4096, 0, I_PNORMG, (long)4096, 0, 1, 2},
    {I_PWPROJ, (long)256 * 4096, 4096, 256, 0, 4096, (long)WS_EPROJ, 256, 0, -1, 0, 0, 1, 0},
};
__constant__ TJob g_tj_odd[NTJ_O] = {
#define OWIN_JOB(c0, n, r0) {I_OWIN, (long)4096 * 5728, 5728, 4096, c0, n, (long)WS_OWIN, 4096, r0, I_NORMG, (long)2 * 4096, 4096, 0, 0}
    {I_OWIN, (long)4096 * 5728, 5728, 4096, 1632, 4096, (long)WS_OWIN8, 4096, 0, I_NORMG, (long)2 * 4096, 4096, 0, 2},
    OWIN_JOB(0, 1024, 0), OWIN_JOB(1024, 512, 1024), OWIN_JOB(1536, 64, 1536), OWIN_JOB(1600, 32, 1600),
    {I_OWOUT, (long)4096 * 4096, 4096, 4096, 0, 4096, (long)WS_OWOUT, 4096, 0, -1, 0, 0, 0, 2},
    {I_PWGATE, (long)4096 * 4096, 4096, 4096, 0, 4096, (long)WS_OGATE, 4096, 0, I_PNORMG, (long)4096, 0, 1, 2},
    {I_PWPROJ, (long)256 * 4096, 4096, 256, 0, 4096, (long)WS_OPROJ, 256, 0, -1, 0, 0, 1, 0},
    {I_OWUQ,  (long)1024 * 4096, 4096, 1024, 0, 4096, (long)WS_OWUQ, 1024, 0,    -1, 0, 0, 0, 0},
    {I_OWUQI, (long)1024 * 2048, 2048, 1024, 0, 2048, (long)WS_OWUQ, 1024, 4096, -1, 0, 0, 0, 0},
    {I_OWUV, (long)512 * 4096, 4096, 512, 0, 4096, (long)WS_OWUV, 1024, 0, -1, 0, 0, 0, 1},
};

__device__ __forceinline__ void transpose_item(const Args& a, GAS unsigned char* ws, const TJob& jb, int L, int item, LAS float* scr, int lane) {
    const int ncb = (jb.ncols + 31) >> 5, kb = item / ncb, nb = item % ncb, k0 = 64 * kb, n0 = 32 * nb;
    const int li = jb.lsel ? L : (L >> 1);
    const GAS float* W = (const GAS float*)a.in[jb.in_id] + (size_t)li * jb.src_lstride;
    const GAS float* gain = jb.gain_id >= 0 ? (const GAS float*)a.in[jb.gain_id] + (size_t)li * jb.gain_lstride + jb.gain_off0 : nullptr;
    const int r8 = lane >> 3, c4 = lane & 7; const bool cv = (n0 + 4 * c4) < jb.ncols;
    f32x4 v[8];
    const GAS float* src = W + (size_t)(k0 + r8) * jb.ldsrc + jb.src_col0 + n0 + 4 * c4;
#pragma unroll
    for (int i = 0; i < 8; ++i) v[i] = cv ? __builtin_nontemporal_load((const GAS f32x4*)(src + (size_t)(8 * i) * jb.ldsrc)) : (f32x4){0.f, 0.f, 0.f, 0.f};
    const int c = lane & 7;
    f32x4 g0 = {1.f, 1.f, 1.f, 1.f}, g1 = g0;
    if (gain) { g0 = *(const GAS f32x4*)(gain + k0 + 8 * c); g1 = *(const GAS f32x4*)(gain + k0 + 8 * c + 4); }
#pragma unroll
    for (int i = 0; i < 8; ++i) { LAS float* d = scr + (8 * i + r8) * 33 + 4 * c4; d[0] = v[i][0]; d[1] = v[i][1]; d[2] = v[i][2]; d[3] = v[i][3]; }
    LDS_WAIT(); asm volatile("" ::: "memory");
    GAS bf16_t* WT = (GAS bf16_t*)(ws + jb.dst_off);
#pragma unroll
    for (int j = 0; j < 4; ++j) { const int n = (lane >> 3) + 8 * j; const LAS float* s = scr + (8 * c) * 33 + n;
        int drow = jb.dst_row0 + n0 + n, dk = k0 + 8 * c;
        if (jb.flags & 2) {
            u32x2 q; q.x = pack4_q8_(s[0 * 33] * g0[0] * W8_SCALE, s[1 * 33] * g0[1] * W8_SCALE, s[2 * 33] * g0[2] * W8_SCALE, s[3 * 33] * g0[3] * W8_SCALE);
            q.y = pack4_q8_(s[4 * 33] * g1[0] * W8_SCALE, s[5 * 33] * g1[1] * W8_SCALE, s[6 * 33] * g1[2] * W8_SCALE, s[7 * 33] * g1[3] * W8_SCALE);
            *(GAS u32x2*)((GAS unsigned char*)ws + jb.dst_off + (size_t)drow * jb.ldt + dk) = q; continue; }
        u32x4 o; o.x = cvtpk(s[0 * 33] * g0[0], s[1 * 33] * g0[1]); o.y = cvtpk(s[2 * 33] * g0[2], s[3 * 33] * g0[3]); o.z = cvtpk(s[4 * 33] * g1[0], s[5 * 33] * g1[1]); o.w = cvtpk(s[6 * 33] * g1[2], s[7 * 33] * g1[3]);
        if (jb.flags & 1) { const int col = n0 + n, h = col >> 7, d = col & 127; drow = (h >> 1) * 256 + (h & 1) * 128 + d; dk = (h & 1) * 512 + k0 + 8 * c; }
        *(GAS u32x4*)(WT + (size_t)drow * jb.ldt + dk) = o; }
    LDS_WAIT(); asm volatile("" ::: "memory");
}

__device__ __forceinline__ void convert_layer_weights(const Args& a, int L, LAS unsigned char* lds, int gw, int NGW, int wave) {
    const int lane = lane_id_();
    unsigned char* ws_ = a.ws; OPAQUE_S(ws_); GAS unsigned char* ws = (GAS unsigned char*)ws_;
    LAS float* scr = (LAS float*)(lds + wave * 16384);
    const bool odd = (L & 1) != 0; const int nj = odd ? NTJ_O : NTJ_E;
    int jstart = 0;
    for (int j = 0; j < nj; ++j) {
        const TJob jb = odd ? g_tj_odd[j] : g_tj_even[j];
        const int nitems = (jb.K >> 6) * ((jb.ncols + 31) >> 5);
        const int first = (gw - (jstart % NGW) + NGW) % NGW;
        for (int it = first; it < nitems; it += NGW) transpose_item(a, ws, jb, L, it, scr, lane);
        jstart += nitems;
    }
    if (!odd) {
        GAS u32x4* z = (GAS u32x4*)(ws + WS_EWIN + (size_t)12832 * 4096); const int n = 224 * 4096 / 16;
        for (int i = gw * 64 + lane; i < n; i += NGW * 64) z[i] = zero4_();
    } else {
        GAS u32x4* z2 = (GAS u32x4*)(ws + WS_OWIN + (size_t)1632 * 4096 * 2); const int n2 = 160 * 4096 * 2 / 16;
        for (int i = gw * 64 + lane; i < n2; i += NGW * 64) z2[i] = zero4_();
        GAS u32x4* z3 = (GAS u32x4*)(ws + WS_OWUV);
        for (int i = gw * 64 + lane; i < 4096 * 64; i += NGW * 64) { const int r = i >> 6, c16 = i & 63; const int zh = ((r >> 7) & 1) ^ 1; z3[(size_t)r * 128 + zh * 64 + c16] = zero4_(); }
        const GAS f32x4* s = (const GAS f32x4*)(((const GAS float*)a.in[I_OWUK]) + (size_t)(L >> 1) * 512 * 4096); GAS u32x2* d = (GAS u32x2*)(ws + WS_OWUK); const int n = 512 * 4096 / 4;
        for (int i = gw * 64 + lane; i < n; i += NGW * 64) { const f32x4 v = __builtin_nontemporal_load(s + i); d[i] = (u32x2){cvtpk(v[0], v[1]), cvtpk(v[2], v[3])}; }
    }
}

__device__ __forceinline__ void phase_convert(const Args& a, LAS unsigned char* lds, int gw, int NGW, int wave) {
    const int lane = lane_id_();
    unsigned char* ws_ = a.ws; OPAQUE_S(ws_); GAS unsigned char* ws = (GAS unsigned char*)ws_;
    {
        const GAS f32x4* s2 = (const GAS f32x4*)((const GAS float*)a.in[I_P]); GAS u32x2* d2 = (GAS u32x2*)(ws + WS_PB); const int n2 = 4 * M * 256 / 4;
        for (int i = gw * 64 + lane; i < n2; i += NGW * 64) { const f32x4 v = __builtin_nontemporal_load(s2 + i); d2[i] = (u32x2){cvtpk(v[0], v[1]), cvtpk(v[2], v[3])}; }
    }
    {
        const GAS float* x = ((const GAS float*)a.in[I_X]); GAS unsigned char* HQ = ws + WS_HQ; GAS float* asc = (GAS float*)(ws + WS_ASCALE); GAS u64* ss = (GAS u64*)(ws + WS_SUMSQ);
        for (int row = gw; row < M; row += NGW) {
            const GAS f32x4* xr = (const GAS f32x4*)(x + (size_t)row * DM); GAS unsigned* qr = (GAS unsigned*)(HQ + (size_t)row * DM);
            f32x4 v[16]; float s = 0.f, am = 0.f;
#pragma unroll
            for (int j = 0; j < 16; ++j) { v[j] = xr[lane + 64 * j]; s += (v[j][0] * v[j][0] + v[j][1] * v[j][1]) + (v[j][2] * v[j][2] + v[j][3] * v[j][3]); am = fmaxf(fmaxf(am, fmaxf(fabsf(v[j][0]), fabsf(v[j][1]))), fmaxf(fabsf(v[j][2]), fabsf(v[j][3]))); }
            s = wave_sum(s);
#pragma unroll
            for (int o = 1; o < 64; o <<= 1) am = fmaxf(am, __shfl_xor(am, o));
            am = fmaxf(am, 1e-20f); const float qs = 127.0f / am;
#pragma unroll
            for (int j = 0; j < 16; ++j) qr[lane + 64 * j] = pack4_q8_(v[j][0] * qs, v[j][1] * qs, v[j][2] * qs, v[j][3] * qs);
            if (lane == 0) { ss[row] = ss_fix(s); asc[row] = am * (1.0f / 127.0f); }
        }
    }
}

__device__ __forceinline__ void phase_quant_yin(const Args& a, int gw, int NGW) {
    const int lane = lane_id_();
    unsigned char* ws_ = a.ws; OPAQUE_S(ws_); GAS unsigned char* ws = (GAS unsigned char*)ws_;
    const GAS bf16_t* yin = (const GAS bf16_t*)(ws + WS_YIN); GAS unsigned char* yq = ws + WS_YQ; GAS float* asc = (GAS float*)(ws + WS_ASCALEY);
    for (int row = gw; row < M; row += NGW) {
        const GAS u32x4* yr = (const GAS u32x4*)(yin + (size_t)row * DM); GAS u32x2* qr = (GAS u32x2*)(yq + (size_t)row * DM);
        u32x4 w[8]; float am = 0.f;
#pragma unroll
        for (int j = 0; j < 8; ++j) { w[j] = yr[lane + 64 * j];
            am = fmaxf(am, fmaxf(fmaxf(fmaxf(fabsf(bflo(w[j].x)), fabsf(bfhi(w[j].x))), fmaxf(fabsf(bflo(w[j].y)), fabsf(bfhi(w[j].y)))), fmaxf(fmaxf(fabsf(bflo(w[j].z)), fabsf(bfhi(w[j].z))), fmaxf(fabsf(bflo(w[j].w)), fabsf(bfhi(w[j].w)))))); }
#pragma unroll
        for (int o = 1; o < 64; o <<= 1) am = fmaxf(am, __shfl_xor(am, o));
        am = fmaxf(am, 1e-20f); const float qs = 127.0f / am;
#pragma unroll
        for (int j = 0; j < 8; ++j) { u32x2 q; q.x = pack4_q8_(bflo(w[j].x) * qs, bfhi(w[j].x) * qs, bflo(w[j].y) * qs, bfhi(w[j].y) * qs); q.y = pack4_q8_(bflo(w[j].z) * qs, bfhi(w[j].z) * qs, bflo(w[j].w) * qs, bfhi(w[j].w) * qs); qr[lane + 64 * j] = q; }
        if (lane == 0) asc[row] = am * (1.0f / 127.0f);
    }
}
__device__ __forceinline__ void phase_final(const Args& a, int gw, int NGW) {
    const int lane = lane_id_();
    unsigned char* ws_ = a.ws; OPAQUE_S(ws_); GAS unsigned char* ws = (GAS unsigned char*)ws_;
    const GAS float* H = (const GAS float*)(ws + WS_H); const GAS u64* ss = (const GAS u64*)(ws + WS_SUMSQ) + 4 * M; const GAS f32x4* g = (const GAS f32x4*)((const GAS float*)a.in[I_FINALG]);
    for (int row = gw; row < M; row += NGW) {
        const float r = 1.0f / sqrtf((float)ss[row] * (1.0f / 16777216.0f) * (1.0f / 4096.0f) + EPS);
        const GAS f32x4* hr = (const GAS f32x4*)(H + (size_t)row * DM); GAS f32x4* orow = (GAS f32x4*)(a.out + (size_t)row * DM);
#pragma unroll 4
        for (int j = 0; j < 16; ++j) { const f32x4 v = hr[lane + 64 * j], gg = g[lane + 64 * j]; orow[lane + 64 * j] = v * r * gg; }
    }
}

__global__ void __launch_bounds__(512, 2) fwd(Args args) {
    extern __shared__ __attribute__((aligned(16))) unsigned char lds_raw[];
    LAS unsigned char* lds = (LAS unsigned char*)lds_raw;
    volatile LAS unsigned* MISC = (volatile LAS unsigned*)(lds + MISC_OFF);
    const int wave0 = __builtin_amdgcn_readfirstlane((int)threadIdx.x >> 6);
    if (wave0 == 0) { const int l_ = lane_id_(); MISC[l_] = (l_ == 16) ? (unsigned)gridDim.x : (l_ == 17) ? (unsigned)blockIdx.x : (l_ == 18) ? (unsigned)args.ph_lo : (l_ == 19) ? (unsigned)args.ph_hi : 0u; }
    __syncthreads();
#define KS_RD(i) ((int)__builtin_amdgcn_readfirstlane((int)*(volatile LAS unsigned*)(size_t)(opaque_vu_((unsigned)MISC_OFF) + 4u * (i))))
#define KS_G0 KS_RD(16)
#define KS_BX0 KS_RD(17)
#define KS_LO KS_RD(18)
#define KS_HI KS_RD(19)
    if (KS_HI - KS_LO > 1) (void)xcd_barrier_post((unsigned*)(args.ws + WS_CTL), MISC + 8, wave0);
#define IN(k) (KS_LO <= (k) && (k) < KS_HI)
#define PHASE_LOCALS() int wave = wave0, G = KS_G0, bx = KS_BX0; asm volatile("" : "+s"(wave), "+s"(G), "+s"(bx)); const int gw = bx * 8 + wave, NGW = G * 8; (void)gw; (void)NGW; \
        unsigned char* ws = args.ws; OPAQUE_S(ws); u64* sumsq = (u64*)(ws + WS_SUMSQ); (void)sumsq; \
        bf16_t* hb_cur = (bf16_t*)(ws + (hbswap ? WS_HBB : WS_HBA)); bf16_t* hb_oth = (bf16_t*)(ws + (hbswap ? WS_HBA : WS_HBB)); (void)hb_cur; (void)hb_oth
#undef SEAM
#define SEAM(k) do { if (IN(k) && IN((k) + 1)) { int wave = wave0; asm volatile("" : "+s"(wave)); unsigned char* _w = args.ws; OPAQUE_S(_w); XcdBarrier _b; _b.bar = (unsigned*)(_w + WS_CTL); _b.x = xb_xcc_id(); _b.st = (volatile LAS unsigned*)(lds + MISC_OFF) + 8; xcd_barrier(_b, wave); } } while (0)
    for (int L = -1; L < 4; ++L) {
        const int base = 10 * (L + 1); const bool odd = L >= 0 && (L & 1) != 0;
        const bool mixed = MK_STAGE >= (odd ? 3 : 2);
        const bool hbswap = (MK_STAGE < 3) && ((MK_STAGE == 1 && (L & 1)) || (MK_STAGE == 2 && L >= 2));
        if (IN(base + 0) && mixed && L >= 0)
#pragma unroll 1
        for (int rep_ = 0; rep_ < (((MK_DUP & (1024 | (1 << 26))) && !odd) || ((MK_DUP & 2048) && odd) ? 2 : 1); ++rep_) {
            PHASE_LOCALS();
            if (odd) {
                {
                    pg8::Gemm g{(const bf16_t*)(ws + WS_HQ), (const bf16_t*)(ws + WS_OWIN8), DM, DM, DM, 32, 16, 1, 0, 0};
                    pg8::Sched S; S.init(g, G, bx);
                    pg8::EpiBf16Q E{(bf16_t*)(ws + WS_PROJ), ON, sumsq + L * M, (const float*)(ws + WS_ASCALE), nullptr, 0};
                    pg8::gemm_phase<pg8::EpiBf16Q, true>(lds, g, S, E, wave); }
                {
                    PHASE_LOCALS();
                    pg8::Gemm g{hb_cur, (const bf16_t*)(ws + WS_OWIN), DM, DM, DM, 32, 7, 1, 0, 0};
                    pg8::Sched S; S.init(g, G, bx);
                    pg8::EpiBf16 E{(bf16_t*)(ws + WS_PROJ) + 4096, ON, 0, sumsq + L * M};
                    pg8::gemm_phase(lds, g, S, E, wave); }
            } else {
                pg8::Gemm g{(const bf16_t*)(ws + WS_HQ), (const bf16_t*)(ws + WS_EWIN), DM, DM, DM, 32, EN / 256, 1, 0, 0};
                pg8::Sched S; S.init(g, G, bx);
                pg8::EpiBf16Q E{(bf16_t*)(ws + WS_PROJ), EN, sumsq + L * M, (const float*)(ws + WS_ASCALE), (u64*)(ws + WS_KN) + (size_t)(L >> 1) * 16 * M, ((MK_DUP & (1 << 26)) && rep_ == 0) ? 1 : 0};
                pg8::gemm_phase<pg8::EpiBf16Q, true>(lds, g, S, E, wave);
            }
        }
        if (L >= 0) SEAM(base + 0);
        if (IN(base + 1)) {
            PHASE_LOCALS();
            if (mixed && !odd && L >= 0) { phase_even_attn(args, L >> 1, lds, G, bx, wave, 3); if (MK_DUP & 1) phase_even_attn(args, L >> 1, lds, G, bx, wave, 3); if (MK_DUP & 32) phase_even_attn(args, L >> 1, lds, G, bx, wave, 1); if (MK_DUP & 64) phase_even_attn(args, L >> 1, lds, G, bx, wave, 2); }
            if (mixed && odd) for (int rep_ = 0; rep_ < ((MK_DUP & 65536) ? 2 : 1); ++rep_) phase_odd_norms(args, L >> 1, gw, NGW);
            __syncthreads();
            if (L < 0) for (int rep_ = 0; rep_ < ((MK_DUP & 262144) ? 2 : 1); ++rep_) phase_convert(args, lds, gw, NGW, wave);
            if (L < 3) for (int rep = 0; rep < ((MK_DUP & 8) ? 2 : 1); ++rep) convert_layer_weights(args, L + 1, lds, gw, NGW, wave);
            __syncthreads();
        }
        SEAM(base + 1);
        if (mixed && odd) {
            if (IN(base + 2))
#pragma unroll 1
            for (int rep_ = 0; rep_ < ((MK_DUP & 4096) ? 2 : 1); ++rep_) {
                PHASE_LOCALS();
                pg8::Gemm g{(const bf16_t*)(ws + WS_CQN), (const bf16_t*)(ws + WS_OWUQ), 1024, 1024, 1024, 32, QW / 256, 1, 0, 0};
                pg8::Sched S; S.init(g, G, bx);
                pg8::EpiBf16 E{(bf16_t*)(ws + WS_QBUF), QW, 0, nullptr};
                pg8::gemm_phase(lds, g, S, E, wave);
            }
            SEAM(base + 2);
            if (IN(base + 3)) {
#pragma unroll 1
                for (int rep_ = 0; rep_ < ((MK_DUP & 8192) ? 2 : 1); ++rep_) { PHASE_LOCALS();
                  pg8::Gemm g{(const bf16_t*)(ws + WS_QBUF), (const bf16_t*)(ws + WS_OWUK), QW, 4096, 128, 32, 2, 32, 128, 128};
                  pg8::Sched S; S.init(g, G, bx);
                  pg8::EpiBf16 E{(bf16_t*)(ws + WS_QABS), 16384, 512, nullptr};
                  pg8::gemm_phase(lds, g, S, E, wave); }
                { PHASE_LOCALS(); if (MK_DUP & 128) phase_indexer(args, lds, G, bx, wave, false); phase_indexer(args, lds, G, bx, wave, true); if (MK_DUP & 2) phase_indexer(args, lds, G, bx, wave, true); }
            }
            SEAM(base + 3);
            if (IN(base + 4)) { PHASE_LOCALS(); phase_dsa(args, lds, G, bx, wave, 0); if (MK_DUP & 4) phase_dsa(args, lds, G, bx, wave, 0); }
            SEAM(base + 4);
            if (IN(base + 5))
#pragma unroll 1
            for (int rep_ = 0; rep_ < ((MK_DUP & 16384) ? 2 : 1); ++rep_) {
                PHASE_LOCALS();
                pg8::Gemm g{(const bf16_t*)(ws + WS_OLAT), (const bf16_t*)(ws + WS_OWUV), 16384, 1024, 1024, 32, 1, 16, 1024, (size_t)256 * 1024};
                pg8::Sched S; S.init(g, G, bx);
                pg8::EpiOGate E{(bf16_t*)(ws + WS_YIN), (const bf16_t*)(ws + WS_PROJ) + O_GC, ON};
                pg8::gemm_phase(lds, g, S, E, wave);
            }
            SEAM(base + 5);
        }
        const int phq = odd ? base + 6 : base + 2, ph5 = phq + 1, ph6 = ph5 + 1;
        if (IN(phq) && L >= 0) for (int rep_ = 0; rep_ < ((MK_DUP & 32768) ? 2 : 1); ++rep_) { PHASE_LOCALS(); phase_quant_yin(args, gw, NGW); }
        if (L >= 0) SEAM(phq);
        if (IN(ph5) && L >= 0) {
            if (mixed) {
                PHASE_LOCALS();
                pg8::Gemm g{(const bf16_t*)(ws + WS_YQ), (const bf16_t*)(ws + (odd ? WS_OWOUT : WS_EWOUT)), DM, DM, DM, 32, 16, 1, 0, 0};
                pg8::Sched S; S.init(g, G, bx);
                pg8::EpiResid E{L == 0 ? args.in[I_X] : (const float*)(ws + WS_H), (float*)(ws + WS_H), (signed char*)(ws + WS_HBB), (float*)(ws + WS_ASCALE1), sumsq + L * M, sumsq + (5 + L) * M, (const float*)(ws + WS_ASCALEY)};
                pg8::gemm_phase<pg8::EpiResid, true>(lds, g, S, E, wave);
            }
#pragma unroll 1
            for (int rep_ = 0; rep_ < ((MK_DUP & 131072) ? 2 : 1); ++rep_) {
                PHASE_LOCALS();
                pg8::Gemm g{(const bf16_t*)(ws + WS_PB) + (size_t)L * M * 256, (const bf16_t*)(ws + (odd ? WS_OPROJ : WS_EPROJ)), 256, 256, 256, 32, 16, 1, 0, 0};
                pg8::Sched S; S.init(g, G, bx);
                pg8::EpiBf16 E{(bf16_t*)(ws + WS_PP), DM, 0, nullptr};
                pg8::gemm_phase(lds, g, S, E, wave);
            }
        }
        if (L >= 0) SEAM(ph5);
        if (IN(ph6) && L >= 0) {
            PHASE_LOCALS();
            pg8::Gemm g{(const bf16_t*)(ws + WS_HBB), (const bf16_t*)(ws + (odd ? WS_OGATE : WS_EGATE)), DM, DM, DM, 32, 16, 1, 0, 0};
            pg8::Sched S; S.init(g, G, bx);
            pg8::EpiGate E{(float*)(ws + WS_H), (L & 1) ? (bf16_t*)nullptr : hb_cur, (const bf16_t*)(ws + WS_PP), sumsq + (mixed ? (5 + L) : L) * M, sumsq + (L + 1) * M, (L < 3) ? (signed char*)(ws + WS_HQ) : nullptr, (float*)(ws + WS_ASCALE), (const float*)(ws + WS_ASCALE1)};
            pg8::gemm_phase<pg8::EpiGate, true>(lds, g, S, E, wave);
        }
        if (L >= 0) SEAM(ph6);
    }
    if (IN(PH_FINAL)) for (int rep_ = 0; rep_ < ((MK_DUP & 524288) ? 2 : 1); ++rep_) phase_final(args, KS_BX0 * 8 + wave0, KS_G0 * 8);
#undef IN
#undef SEAM
}

extern "C" void kernel_launch(void* const* d_in, const int* in_sizes, int n_in, void* d_out, int out_size, void* d_ws, size_t ws_size, hipStream_t stream) {
    static int grid = 0;
    if (grid == 0) {
        if (n_in != 22 || out_size != M * DM || ws_size < WS_END) { fprintf(stderr, "kernel_launch: unexpected shapes (n_in %d out %d ws %zu, need %zu)\n", n_in, out_size, ws_size, (size_t)WS_END); grid = -1; return; }
        int dev = 0, cus = 0, per_cu = 0;
        if (hipGetDevice(&dev) != hipSuccess || hipDeviceGetAttribute(&cus, hipDeviceAttributeMultiprocessorCount, dev) != hipSuccess) { grid = -1; return; }
        if (hipFuncSetAttribute((const void*)fwd, hipFuncAttributeMaxDynamicSharedMemorySize, LDS_BYTES) != hipSuccess) { fprintf(stderr, "kernel_launch: hipFuncSetAttribute failed\n"); grid = -1; return; }
        if (hipOccupancyMaxActiveBlocksPerMultiprocessor(&per_cu, (const void*)fwd, 512, LDS_BYTES) != hipSuccess || per_cu < 1) { fprintf(stderr, "kernel_launch: occupancy query says %d\n", per_cu); }
        (void)hipGetLastError();
        grid = cus;
    }
    if (grid < 0) return;
    if (hipMemsetAsync((char*)d_ws + WS_CTL, 0, WS_ZERO_BYTES, stream) != hipSuccess) return;
    Args a{};
    for (int i = 0; i < 22; ++i) a.in[i] = (const float*)d_in[i];
    a.out = (float*)d_out; a.ws = (unsigned char*)d_ws;
#if MK_ONE_LAUNCH
    a.ph_lo = 0; a.ph_hi = NPH;
    hipLaunchKernelGGL(fwd, dim3(grid), dim3(512), LDS_BYTES, stream, a);
#else
    for (int ph = 0; ph < NPH; ++ph) {
        if (ph < PH_FINAL) { const int L = ph / 10 - 1, k = ph % 10; if (L < 0 && k != 1) continue; if (L >= 0 && !(L & 1) && k >= 5) continue; if (L >= 0 && (L & 1) && k >= 9) continue; }
        a.ph_lo = ph; a.ph_hi = ph + 1;
        hipLaunchKernelGGL(fwd, dim3(grid), dim3(512), LDS_BYTES, stream, a);
    }
#endif
}
```

```cpp
#include <hip/hip_runtime.h>
#include <cstdio>
#include <cstdint>

#define LAS __attribute__((address_space(3)))
#define GAS __attribute__((address_space(1)))
typedef unsigned short bf16_t;
typedef short bf16x8 __attribute__((ext_vector_type(8)));
typedef short s16x4 __attribute__((ext_vector_type(4)));
typedef short v4i16_t __attribute__((ext_vector_type(4)));
typedef float f32x2 __attribute__((ext_vector_type(2)));
typedef float f32x4 __attribute__((ext_vector_type(4)));
typedef float f32x16 __attribute__((ext_vector_type(16)));
typedef unsigned u32x2 __attribute__((ext_vector_type(2)));
typedef unsigned u32x4 __attribute__((ext_vector_type(4)));
typedef __bf16 bf16x2_t __attribute__((ext_vector_type(2)));
typedef GAS unsigned gu32;

#ifndef MK_STAGE
#define MK_STAGE 3
#endif
#ifndef MK_DUP
#define MK_DUP 0
#endif
#ifndef MK_ONE_LAUNCH
#define MK_ONE_LAUNCH 1
#endif

constexpr int M = 8192, DM = 4096, SEQ = 4096;
constexpr float EPS = 1e-6f;
constexpr float LOG2E = 1.4426950408889634f;
constexpr int EN = 13056;
constexpr int ON = 5888;
constexpr int E_QA = 0, E_KA = 2048, E_VA = 4096, E_GA = 6144, E_QB = 8192, E_GB = 10240, E_KB = 12288, E_VB = 12544, E_FA = 12800;
constexpr int O_GC = 0, O_CQ = 4096, O_CKV = 5120, O_KIDX = 5632, O_WIDX = 5696;
constexpr int QW = 6144;

constexpr size_t MiB = 1u << 20;
constexpr size_t WS_CTL = 0;
constexpr size_t WS_SUMSQ = 1 * MiB;
constexpr size_t WS_KN = 2 * MiB;
constexpr size_t WS_ZERO_BYTES = 4 * MiB;
constexpr size_t SZ_SQ = (size_t)4096 * 4096 * 2;
constexpr size_t SZ_WPROJ = (size_t)4096 * 256 * 2;
constexpr size_t WS_EWIN = 4 * MiB;
constexpr size_t WS_EWOUT = WS_EWIN + (size_t)EN * 4096 * 2;
constexpr size_t WS_EGATE = WS_EWOUT + SZ_SQ;
constexpr size_t WS_EPROJ = WS_EGATE + SZ_SQ;
constexpr size_t WS_OWIN = WS_EPROJ + SZ_WPROJ;
constexpr size_t WS_OWIN8 = WS_OWIN + (size_t)1792 * 4096 * 2;
constexpr size_t WS_OWUQ = WS_OWIN + (size_t)ON * 4096 * 2;
constexpr size_t WS_OWUK = WS_OWUQ + (size_t)QW * 1024 * 2;
constexpr size_t WS_OWUV = WS_OWUK + (size_t)512 * 4096 * 2;
constexpr size_t WS_OWOUT = WS_OWUV + (size_t)16 * 256 * 1024 * 2;
constexpr size_t WS_OGATE = WS_OWOUT + SZ_SQ;
constexpr size_t WS_OPROJ = WS_OGATE + SZ_SQ;
constexpr size_t WS_H = WS_OPROJ + SZ_WPROJ;
constexpr size_t WS_HBA = WS_H + (size_t)M * 4096 * 4;
constexpr size_t SZ_ACT = (size_t)M * 4096 * 2;
constexpr size_t WS_HBB = WS_HBA + SZ_ACT;
constexpr size_t WS_YIN = WS_HBB + SZ_ACT;
constexpr size_t WS_SCORE = WS_YIN;
constexpr size_t WS_PP = WS_YIN + SZ_ACT;
constexpr size_t WS_PB = WS_PP + SZ_ACT;
constexpr size_t WS_PROJ = WS_PB + (size_t)4 * M * 256 * 2;
constexpr size_t WS_CQN = WS_PROJ + (size_t)M * EN * 2;
constexpr size_t WS_LAT = WS_CQN + (size_t)M * 1024 * 2;
constexpr size_t WS_KIDX = WS_LAT + (size_t)M * 512 * 2;
constexpr size_t WS_WIDX = WS_KIDX + (size_t)M * 64 * 2;
constexpr size_t WS_SEL = WS_WIDX + (size_t)M * 32 * 4;
constexpr size_t WS_QBUF = WS_SEL + (size_t)M * 256 * 4;
constexpr size_t WS_QABS = WS_QBUF + (size_t)M * QW * 2;
constexpr size_t WS_OLAT = WS_QABS + (size_t)M * 16384 * 2;
constexpr size_t WS_HQ = WS_OLAT + (size_t)M * 16384 * 2;
constexpr size_t WS_ASCALE = WS_HQ + (size_t)M * 4096;
constexpr size_t WS_ASCALE1 = WS_ASCALE + (size_t)M * 4;
constexpr size_t WS_ASCALEY = WS_ASCALE1 + (size_t)M * 4;
constexpr size_t WS_YQ = WS_PROJ;
constexpr size_t WS_END = WS_ASCALEY + (size_t)M * 4;
static_assert(WS_END <= (size_t)4 * 2 * 4096 * 12816 * 4, "workspace map exceeds the guaranteed size (4 x the largest input)");

constexpr int LDS_BYTES = 155648;
constexpr int MISC_OFF = LDS_BYTES - 256;

__device__ __forceinline__ unsigned cvtpk(float lo, float hi) { f32x2 v = {lo, hi}; bf16x2_t b = __builtin_convertvector(v, bf16x2_t); return __builtin_bit_cast(unsigned, b); }
__device__ __forceinline__ float bf2f(unsigned short b) { return __uint_as_float(((unsigned)b) << 16); }
__device__ __forceinline__ float bflo(unsigned w) { return __uint_as_float(w << 16); }
__device__ __forceinline__ float bfhi(unsigned w) { return __uint_as_float(w & 0xffff0000u); }
__device__ __forceinline__ float wave_sum(float v) {
#pragma unroll
    for (int o = 1; o < 64; o <<= 1) v += __shfl_xor(v, o);
    return v;
}
__device__ __forceinline__ float xhalf_max(float m) { auto rr = __builtin_amdgcn_permlane32_swap(__float_as_uint(m), __float_as_uint(m), false, false); return fmaxf(__uint_as_float(rr[0]), __uint_as_float(rr[1])); }
__device__ __forceinline__ float xhalf_sum(float m) { auto rr = __builtin_amdgcn_permlane32_swap(__float_as_uint(m), __float_as_uint(m), false, false); return __uint_as_float(rr[0]) + __uint_as_float(rr[1]); }
__device__ __forceinline__ int lane_id_() { int l = (int)__builtin_amdgcn_mbcnt_hi(~0u, __builtin_amdgcn_mbcnt_lo(~0u, 0u)); asm volatile("" : "+v"(l)); return l; }
typedef unsigned long long u64;
__device__ __forceinline__ u64 ss_fix(float s2) { return (u64)(s2 * 16777216.0f); }
__device__ __forceinline__ float ss_rstd(u64 v) { return __builtin_amdgcn_rsqf((float)v * (1.0f / 16777216.0f) * (1.0f / 4096.0f) + EPS); }
__device__ __forceinline__ unsigned opaque_vu_(unsigned v) { asm volatile("" : "+v"(v)); return v; }
__device__ __forceinline__ u32x4 zero4_() { unsigned z = 0u; asm volatile("" : "+v"(z)); return (u32x4){z, z, z, z}; }
typedef int i32x4 __attribute__((ext_vector_type(4)));
constexpr float W8_SCALE = 1354.0f;
__device__ __forceinline__ int q8_(float v) { const int q = (int)__builtin_rintf(v); return q < -127 ? -127 : (q > 127 ? 127 : q); }
__device__ __forceinline__ unsigned pack4_q8_(float a, float b, float c, float d) { return (unsigned)(q8_(a) & 255) | ((unsigned)(q8_(b) & 255) << 8) | ((unsigned)(q8_(c) & 255) << 16) | ((unsigned)(q8_(d) & 255) << 24); }
__device__ __forceinline__ float fast_exp2(float x) { return __builtin_amdgcn_exp2f(x); }
__device__ __forceinline__ float sigmoidf_(float x) { return 1.0f / (1.0f + __expf(-x)); }
__device__ __forceinline__ float siluf_(float x) { return x / (1.0f + __expf(-x)); }
#define OPAQUE_S(p) do { unsigned long long _v = (unsigned long long)(p); unsigned _lo = (unsigned)_v, _hi = (unsigned)(_v >> 32); asm volatile("" : "+v"(_lo), "+v"(_hi)); \
    _lo = __builtin_amdgcn_readfirstlane(_lo); _hi = __builtin_amdgcn_readfirstlane(_hi); (p) = (decltype(p))(((unsigned long long)_hi << 32) | _lo); } while (0)
#define G1(T, p) ((GAS T*)(p))
#define LDS_WAIT() asm volatile("s_waitcnt lgkmcnt(0)" ::: "memory")
#define VM_WAIT() asm volatile("s_waitcnt vmcnt(0)" ::: "memory")

#define XB_TMO      128
#define XB_XCNT(j)  (256  + 64 * (j))
#define XB_XSUB(j)  (1280 + 64 * (j))
#define XB_XGEN(j)  (2304 + 64 * (j))
#define XB_TOP      3328
#define XB_TOPGEN   3392
#define XCD_BAR_WORDS 3456
#define XB_SPIN_CAP (1u << 22)
__device__ __forceinline__ unsigned xb_ld(unsigned* p)              { return __hip_atomic_load((gu32*)p, __ATOMIC_RELAXED, __HIP_MEMORY_SCOPE_AGENT); }
__device__ __forceinline__ unsigned xb_add(unsigned* p, unsigned v) { return __hip_atomic_fetch_add((gu32*)p, v, __ATOMIC_RELAXED, __HIP_MEMORY_SCOPE_AGENT); }
__device__ __forceinline__ unsigned xb_xcc_id() { return (unsigned)__builtin_amdgcn_s_getreg((3 << 11) | 20) & 0xFu; }
#define XB_SPIN(cond, bar) do { unsigned _sp = 0; while (cond) { __builtin_amdgcn_s_sleep(1); \
    if ((++_sp & 255u) == 0u) { if (xb_ld(&(bar)[XB_TMO])) break; if (_sp > XB_SPIN_CAP) { (void)xb_add(&(bar)[XB_TMO], 1u); break; } } } } while (0)
struct XcdBarrier { unsigned* bar; unsigned x; volatile LAS unsigned* st; };
__device__ __forceinline__ XcdBarrier xcd_barrier_post(unsigned* bar, volatile LAS unsigned* st, const int wave) {
    XcdBarrier b; b.bar = bar; b.x = xb_xcc_id(); b.st = st;
    if (wave == 0 && lane_id_() == 0) (void)xb_add(&bar[XB_XCNT(b.x)], 1u);
    return b;
}
__device__ __forceinline__ void xcd_barrier_complete(unsigned* bar, unsigned x, unsigned& nloc, unsigned& nx) {
    const unsigned G = gridDim.x * gridDim.y * gridDim.z;
    unsigned sum, cnt, mine, sp = 0u;
    for (;;) {
        sum = 0u; cnt = 0u; mine = 0u;
#pragma unroll 1
        for (unsigned j = 0; j < 16; ++j) { const unsigned c = xb_ld(&bar[XB_XCNT(j)]); sum += c; cnt += (c > 0u) ? 1u : 0u; mine = (j == x) ? c : mine; }
        if (sum == G) break;
        __builtin_amdgcn_s_sleep(1);
        if ((++sp & 255u) == 0u) { if (xb_ld(&bar[XB_TMO])) break; if (sp > XB_SPIN_CAP) { (void)xb_add(&bar[XB_TMO], 1u); break; } }
    }
    nloc = mine > 0u ? mine : 1u; nx = cnt > 0u ? cnt : 1u;
}
__device__ __forceinline__ void xcd_barrier(const XcdBarrier& b, const int wave) {
    asm volatile("s_waitcnt vmcnt(0)" ::: "memory");
    __syncthreads();
    if (wave == 0 && lane_id_() == 0) {
        unsigned* bar = b.bar;
        __builtin_amdgcn_s_waitcnt(0);
        unsigned nloc = b.st[0], nx = b.st[1];
        if (nloc == 0u) { xcd_barrier_complete(bar, b.x, nloc, nx); b.st[0] = nloc; b.st[1] = nx; }
        const unsigned old = xb_add(&bar[XB_XSUB(b.x)], 1u);
        const unsigned gen = old / nloc;
        if (old + 1u == (gen + 1u) * nloc) {
            __builtin_amdgcn_fence(__ATOMIC_RELEASE, "agent");
            asm volatile("s_waitcnt vmcnt(0)" ::: "memory");
            const unsigned og = xb_add(&bar[XB_TOP], 1u);
            const unsigned tg = og / nx;
            if (og + 1u == (tg + 1u) * nx) xb_add(&bar[XB_TOPGEN], 1u);
            else XB_SPIN(xb_ld(&bar[XB_TOPGEN]) == tg, bar);
            __builtin_amdgcn_fence(__ATOMIC_ACQUIRE, "agent");
            xb_add(&bar[XB_XGEN(b.x)], 1u);
            asm volatile("s_waitcnt vmcnt(0)" ::: "memory");
        } else {
            XB_SPIN(xb_ld(&bar[XB_XGEN(b.x)]) == gen, bar);
            __builtin_amdgcn_fence(__ATOMIC_ACQUIRE, "agent");
            asm volatile("s_waitcnt vmcnt(0)" ::: "memory");
        }
    }
    __syncthreads();
}

namespace pg8 {
__device__ __forceinline__ void glds16_s(const void* sbase, unsigned voff, unsigned lds_dst) {
    unsigned keep;
    asm volatile("s_mov_b32 %0, m0\n\ts_mov_b32 m0, %3\n\ts_nop 0\n\tglobal_load_lds_dwordx4 %1, %2\n\ts_mov_b32 m0, %0" : "=&s"(keep) : "v"(voff), "s"(sbase), "s"(lds_dst) : "memory");
}
constexpr int BM = 256, BK = 64, HALF = 128, HTB = HALF * BK * 2, STAGE_BYTES = 8 * HTB, NXCD = 8, WGM = 8;
__host__ __device__ __forceinline__ int lds_byte(int r, int c) { const int st = (r >> 4) * 2 + (c >> 5), rr = r & 15, cc = c & 31, ob = rr * 64 + cc * 2; return st * 1024 + (ob ^ (((ob >> 9) & 1) << 5)); }
__host__ __device__ __forceinline__ void stage_rc(int b, int& R, int& C) { const int st = b / 1024, sb = b % 1024, swz = sb ^ (((sb >> 9) & 1) << 5); R = (st >> 1) * 16 + swz / 64; C = (st & 1) * 32 + (swz % 64) / 2; }
__host__ __device__ __forceinline__ int perm32(int rho) { const int n = rho >> 4, i = rho & 15; return 8 * (i >> 2) + 4 * n + (i & 3); }

struct Unit { int pm, pn, g; };
struct Gemm { const bf16_t* A; const bf16_t* Bt; int lda, ldb, K, nM, nN, ng; size_t gsA, gsB; };

struct Sched {
    int nM, nN, nwg, total, G, c;
    __device__ void init(const Gemm& g, int G_, int c_) { nM = g.nM; nN = g.nN; nwg = nM * nN; total = nwg * g.ng; G = G_; c = c_; }
    __device__ bool next(int i, Unit& u) const {
        const long L = (long)i * G + c; if (L >= total) return false;
        u.g = (int)(L / nwg); int wgid = (int)(L % nwg);
        { const int q = nwg / NXCD, r = nwg % NXCD, xcd = wgid % NXCD, off = wgid / NXCD; wgid = (xcd < r ? xcd * (q + 1) : r * (q + 1) + (xcd - r) * q) + off; }
        const int nig = WGM * nN, gid = wgid / nig, fm = gid * WGM, gsz = (nM - fm) < WGM ? (nM - fm) : WGM;
        u.pm = fm + ((wgid % nig) % gsz); u.pn = (wgid % nig) / gsz; return true;
    }
};

template <class Epi, bool I8 = false>
__device__ __forceinline__ void gemm_phase(LAS unsigned char* lds, const Gemm g, const Sched& S, const Epi& E, const int wid) {
    const int lane = lane_id_(), tid = wid * 64 + lane;
    const int wr = wid >> 2, wc = wid & 3, fr = lane & 15, fq = lane >> 4;
    const bf16_t* gA = g.A; const bf16_t* gB = g.Bt; OPAQUE_S(gA); OPAQUE_S(gB);
    constexpr int ESZ = I8 ? 1 : 2;
    const int K = g.K, nt = K * ESZ / (BK * 2);
    unsigned voffA[2], voffB[2];
#pragma unroll
    for (int i = 0; i < 2; ++i) { int R, C; stage_rc(tid * 16 + i * 8192, R, C); const int Rb = (R & ~31) + perm32(R & 31);
        voffA[i] = (unsigned)(R * g.lda * ESZ + C * 2); voffB[i] = (unsigned)(Rb * g.ldb * ESZ + C * 2); }
    const size_t kstep = (size_t)(BK * 2);
    const size_t hstepA = (size_t)HALF * g.lda * ESZ, hstepB = (size_t)HALF * g.ldb * ESZ;
    const size_t tstepA = 2 * hstepA, tstepB = 2 * hstepB;
    const unsigned ldsbase = (unsigned)(size_t)lds + (unsigned)wid * 1024u;
    const int aoff = lds_byte(wr * 64 + fr, fq * 8), boff = lds_byte(wc * 32 + fr, fq * 8);
#define PG8_SA(b, h) (((b) * 2 + (h)) * HTB)
#define PG8_SB(b, h) ((4 + (b) * 2 + (h)) * HTB)
#define PG8_STAGE(bufoff, gbase, voff) do { _Pragma("unroll") for (int _i = 0; _i < 2; ++_i) glds16_s((const void*)(gbase), (voff)[_i], ldsbase + (unsigned)((bufoff) + _i * 8192)); } while (0)
#define PG8_LDA(dst, b, h) do { _Pragma("unroll") for (int m = 0; m < 4; ++m) _Pragma("unroll") for (int k = 0; k < 2; ++k) dst[m][k] = *(const LAS bf16x8*)(lds + PG8_SA(b, h) + aoff + m * 2048 + k * 1024); } while (0)
#define PG8_LDB(dst, b, h) do { _Pragma("unroll") for (int n = 0; n < 2; ++n) _Pragma("unroll") for (int k = 0; k < 2; ++k) dst[n][k] = *(const LAS bf16x8*)(lds + PG8_SB(b, h) + boff + n * 2048 + k * 1024); } while (0)
#define PG8_MMA(ai, bj, At, Bt) do { __builtin_amdgcn_s_setprio(1); _Pragma("unroll") for (int m = 0; m < 4; ++m) _Pragma("unroll") for (int n = 0; n < 2; ++n) _Pragma("unroll") for (int k = 0; k < 2; ++k) { \
        if constexpr (I8) acc[ai][bj][m][n] = __builtin_bit_cast(f32x4, __builtin_amdgcn_mfma_i32_16x16x64_i8(__builtin_bit_cast(i32x4, Bt[n][k]), __builtin_bit_cast(i32x4, At[m][k]), __builtin_bit_cast(i32x4, acc[ai][bj][m][n]), 0, 0, 0)); \
        else acc[ai][bj][m][n] = __builtin_amdgcn_mfma_f32_16x16x32_bf16(Bt[n][k], At[m][k], acc[ai][bj][m][n], 0, 0, 0); } __builtin_amdgcn_s_setprio(0); } while (0)
#define PG8_WAIT_V(n) asm volatile("s_waitcnt vmcnt(" #n ")" ::: "memory")
#define PG8_WAIT_L(n) asm volatile("s_waitcnt lgkmcnt(" #n ")" ::: "memory")
#define PG8_BAR __builtin_amdgcn_s_barrier()
#define PG8_SCHED __builtin_amdgcn_sched_barrier(0)
    Unit cur, nxt; int ui = 0;
    if (!S.next(0, cur)) return;
    f32x4 acc[2][2][4][2];
#pragma unroll
    for (int a = 0; a < 2; ++a)
#pragma unroll
        for (int b = 0; b < 2; ++b)
#pragma unroll
            for (int m = 0; m < 4; ++m)
#pragma unroll
                for (int n = 0; n < 2; ++n) acc[a][b][m][n] = (f32x4){0.f, 0.f, 0.f, 0.f};
    bf16x8 At[4][2], B0[2][2], B1[2][2];
    const char* cA = (const char*)(gA + (size_t)cur.g * g.gsA) + (size_t)cur.pm * tstepA; const char* cB = (const char*)(gB + (size_t)cur.g * g.gsB) + (size_t)cur.pn * tstepB;
    PG8_STAGE(PG8_SB(0, 0), cB, voffB); PG8_STAGE(PG8_SB(0, 1), cB + hstepB, voffB); PG8_STAGE(PG8_SA(0, 0), cA, voffA); PG8_STAGE(PG8_SA(0, 1), cA + hstepA, voffA);
    if (wr == 1) PG8_BAR;
    PG8_WAIT_V(2); PG8_BAR;
    PG8_STAGE(PG8_SB(1, 0), cB + kstep, voffB); PG8_STAGE(PG8_SA(1, 0), cA + kstep, voffA); PG8_STAGE(PG8_SB(1, 1), cB + hstepB + kstep, voffB);
    PG8_WAIT_V(6); PG8_BAR;
    for (;;) {
        const bool has_next = S.next(ui + 1, nxt);
        const char* nA = has_next ? (const char*)(gA + (size_t)nxt.g * g.gsA) + (size_t)nxt.pm * tstepA : cA; const char* nB = has_next ? (const char*)(gB + (size_t)nxt.g * g.gsB) + (size_t)nxt.pn * tstepB : cB;
        for (int t = 0; t < nt; t += 2) {
            const bool last = (t == nt - 2);
            const char* a1 = cA + (size_t)(t + 1) * kstep;
            const char* a2 = last ? nA : cA + (size_t)(t + 2) * kstep; const char* b2 = last ? nB : cB + (size_t)(t + 2) * kstep;
            const char* a3 = a2 + kstep; const char* b3 = b2 + kstep;
            PG8_LDB(B0, 0, 0); PG8_LDB(B1, 0, 1); PG8_SCHED; PG8_LDA(At, 0, 0); PG8_STAGE(PG8_SA(1, 1), a1 + hstepA, voffA);
            PG8_WAIT_V(8); PG8_WAIT_L(0); PG8_BAR; PG8_MMA(0, 0, At, B0); PG8_MMA(0, 1, At, B1); PG8_BAR; PG8_SCHED;
            PG8_LDA(At, 0, 1); PG8_STAGE(PG8_SB(0, 0), b2, voffB); PG8_STAGE(PG8_SB(0, 1), b2 + hstepB, voffB); PG8_STAGE(PG8_SA(0, 0), a2, voffA);
            PG8_WAIT_V(8); PG8_WAIT_L(0); PG8_BAR; PG8_MMA(1, 0, At, B0); PG8_MMA(1, 1, At, B1); PG8_BAR; PG8_SCHED;
            PG8_LDB(B0, 1, 0); PG8_LDB(B1, 1, 1); PG8_SCHED; PG8_LDA(At, 1, 0); PG8_STAGE(PG8_SA(0, 1), a2 + hstepA, voffA);
            PG8_WAIT_V(8); PG8_WAIT_L(0); PG8_BAR; PG8_MMA(0, 0, At, B0); PG8_MMA(0, 1, At, B1); PG8_BAR; PG8_SCHED;
            PG8_LDA(At, 1, 1); PG8_STAGE(PG8_SB(1, 0), b3, voffB); PG8_STAGE(PG8_SB(1, 1), b3 + hstepB, voffB); PG8_STAGE(PG8_SA(1, 0), a3, voffA);
            PG8_WAIT_V(8); PG8_WAIT_L(0); PG8_BAR; PG8_MMA(1, 0, At, B0); PG8_MMA(1, 1, At, B1); PG8_BAR; PG8_SCHED;
        }
        if (wr == 0) PG8_BAR;
        { const int l2 = lane_id_(); E(acc, cur, wid >> 2, wid & 3, l2 & 15, l2 >> 4); }
        if (!has_next) break;
#pragma unroll
        for (int a = 0; a < 2; ++a)
#pragma unroll
            for (int b = 0; b < 2; ++b)
#pragma unroll
                for (int m = 0; m < 4; ++m)
#pragma unroll
                    for (int n = 0; n < 2; ++n) acc[a][b][m][n] = (f32x4){0.f, 0.f, 0.f, 0.f};
        cur = nxt; cA = nA; cB = nB; ++ui;
        if (wr == 1) PG8_BAR;
    }
    PG8_WAIT_V(0);
    PG8_BAR;
#undef PG8_SA
#undef PG8_SB
#undef PG8_STAGE
#undef PG8_LDA
#undef PG8_LDB
#undef PG8_MMA
#undef PG8_WAIT_V
#undef PG8_WAIT_L
#undef PG8_BAR
#undef PG8_SCHED
}

struct EpiBf16 {
    bf16_t* O; int ldc; size_t gsO; const u64* ss;
    __device__ __forceinline__ void operator()(const f32x4 (&acc)[2][2][4][2], const Unit& u, int wr, int wc, int fr, int fq) const {
        const int row0 = u.pm * BM + wr * 64 + fr, col0 = u.pn * BM + wc * 32 + 8 * fq;
        bf16_t* base = O + (size_t)u.g * gsO;
        u64 sv[2][4];
        if (ss) {
#pragma unroll
            for (int ai = 0; ai < 2; ++ai)
#pragma unroll
                for (int m = 0; m < 4; ++m) sv[ai][m] = *G1(const u64, ss + row0 + ai * HALF + m * 16);
            __builtin_amdgcn_sched_barrier(0); }
#pragma unroll
        for (int ai = 0; ai < 2; ++ai)
#pragma unroll
            for (int m = 0; m < 4; ++m) { const int row = row0 + ai * HALF + m * 16; bf16_t* rowp = base + (size_t)row * ldc + col0;
                const float sc = ss ? ss_rstd(sv[ai][m]) : 1.0f;
#pragma unroll
                for (int bj = 0; bj < 2; ++bj) { const f32x4 v0 = acc[ai][bj][m][0] * sc, v1 = acc[ai][bj][m][1] * sc;
                    u32x4 w; w.x = cvtpk(v0[0], v0[1]); w.y = cvtpk(v0[2], v0[3]); w.z = cvtpk(v1[0], v1[1]); w.w = cvtpk(v1[2], v1[3]);
                    *G1(u32x4, rowp + bj * HALF) = w; } }
    }
};
struct EpiBf16Q {
    bf16_t* O; int ldc; const u64* ss; const float* ascale; u64* kn; int dry;
    __device__ __forceinline__ void operator()(const f32x4 (&acc)[2][2][4][2], const Unit& u, int wr, int wc, int fr, int fq) const {
        const int row0 = u.pm * BM + wr * 64 + fr, col0 = u.pn * BM + wc * 32 + 8 * fq;
        const bool ktile = kn != nullptr && u.pn >= 8 && u.pn < 16;
        if (dry) { float t_ = 0.f;
#pragma unroll
            for (int ai = 0; ai < 2; ++ai)
#pragma unroll
                for (int bj = 0; bj < 2; ++bj)
#pragma unroll
                    for (int m = 0; m < 4; ++m) t_ += acc[ai][bj][m][0][0] + acc[ai][bj][m][1][3];
            if (t_ == 1.2345e38f) *G1(float, (float*)O) = t_; return; }
        u64 sv[2][4]; float av[2][4];
#pragma unroll
        for (int ai = 0; ai < 2; ++ai)
#pragma unroll
            for (int m = 0; m < 4; ++m) { const int row = row0 + ai * HALF + m * 16; sv[ai][m] = *G1(const u64, ss + row); av[ai][m] = *G1(const float, ascale + row); }
        __builtin_amdgcn_sched_barrier(0);
#pragma unroll
        for (int ai = 0; ai < 2; ++ai)
#pragma unroll
            for (int m = 0; m < 4; ++m) { const int row = row0 + ai * HALF + m * 16; bf16_t* rowp = O + (size_t)row * ldc + col0;
                const float sc = ss_rstd(sv[ai][m]) * av[ai][m] * (1.0f / W8_SCALE);
#pragma unroll
                for (int bj = 0; bj < 2; ++bj) { const i32x4 i0 = __builtin_bit_cast(i32x4, acc[ai][bj][m][0]), i1 = __builtin_bit_cast(i32x4, acc[ai][bj][m][1]);
                    const float f0 = (float)i0[0] * sc, f1 = (float)i0[1] * sc, f2 = (float)i0[2] * sc, f3 = (float)i0[3] * sc, f4 = (float)i1[0] * sc, f5 = (float)i1[1] * sc, f6 = (float)i1[2] * sc, f7 = (float)i1[3] * sc;
                    u32x4 w; w.x = cvtpk(f0, f1); w.y = cvtpk(f2, f3); w.z = cvtpk(f4, f5); w.w = cvtpk(f6, f7);
                    *G1(u32x4, rowp + bj * HALF) = w;
                    if (ktile) { float s2 = (f0 * f0 + f1 * f1) + (f2 * f2 + f3 * f3) + (f4 * f4 + f5 * f5) + (f6 * f6 + f7 * f7); s2 += __shfl_xor(s2, 16); s2 += __shfl_xor(s2, 32);
                        if (fq == 0) (void)__hip_atomic_fetch_add(G1(u64, kn + (size_t)((u.pn - 8) * 2 + bj) * M + row), ss_fix(s2), __ATOMIC_RELAXED, __HIP_MEMORY_SCOPE_AGENT); } } }
    }
};
struct EpiResid {
    const bf16_t* Hin; bf16_t* H; signed char* HQ; float* ascale; const u64* ssin; u64* ssout; const float* ascale_y;
    __device__ __forceinline__ void operator()(const f32x4 (&acc)[2][2][4][2], const Unit& u, int wr, int wc, int fr, int fq) const {
        const int row0 = u.pm * BM + wr * 64 + fr, col0 = u.pn * BM + wc * 32 + 8 * fq;
#pragma unroll
        for (int ai = 0; ai < 2; ++ai) {
        u32x4 hv[2][4][2]; u64 sv[2][4]; float yv[2][4];
#pragma unroll
            for (int m = 0; m < 4; ++m) { const int row = row0 + ai * HALF + m * 16; const bf16_t* hi = Hin + (size_t)row * DM + col0;
                sv[ai][m] = *G1(const u64, ssin + row); yv[ai][m] = *G1(const float, ascale_y + row);
#pragma unroll
                for (int bj = 0; bj < 2; ++bj) hv[ai][m][bj] = *G1(const u32x4, hi + bj * HALF); }
        __builtin_amdgcn_sched_barrier(0);
#pragma unroll
            for (int m = 0; m < 4; ++m) { const int row = row0 + ai * HALF + m * 16; bf16_t* hp = H + (size_t)row * DM + col0; signed char* bp = HQ + (size_t)row * DM + col0; float s2 = 0.f;
                const float qs = 15.875f * ss_rstd(sv[ai][m]);
                if (fq == 0 && wc == 0 && u.pn == 0) *G1(float, ascale + row) = 1.0f / qs;
                const float ys = yv[ai][m] * (1.0f / W8_SCALE);
#pragma unroll
                for (int bj = 0; bj < 2; ++bj) { const i32x4 i0 = __builtin_bit_cast(i32x4, acc[ai][bj][m][0]), i1 = __builtin_bit_cast(i32x4, acc[ai][bj][m][1]); const u32x4 hw = hv[ai][m][bj];
                    const f32x4 v0 = (f32x4){bflo(hw.x), bfhi(hw.x), bflo(hw.y), bfhi(hw.y)} + (f32x4){(float)i0[0], (float)i0[1], (float)i0[2], (float)i0[3]} * ys, v1 = (f32x4){bflo(hw.z), bfhi(hw.z), bflo(hw.w), bfhi(hw.w)} + (f32x4){(float)i1[0], (float)i1[1], (float)i1[2], (float)i1[3]} * ys;
                    { u32x4 w; w.x = cvtpk(v0[0], v0[1]); w.y = cvtpk(v0[2], v0[3]); w.z = cvtpk(v1[0], v1[1]); w.w = cvtpk(v1[2], v1[3]); *G1(u32x4, hp + bj * HALF) = w; }
                    s2 += (v0[0] * v0[0] + v0[1] * v0[1]) + (v0[2] * v0[2] + v0[3] * v0[3]) + (v1[0] * v1[0] + v1[1] * v1[1]) + (v1[2] * v1[2] + v1[3] * v1[3]);
                    u32x2 q; q.x = pack4_q8_(v0[0] * qs, v0[1] * qs, v0[2] * qs, v0[3] * qs); q.y = pack4_q8_(v1[0] * qs, v1[1] * qs, v1[2] * qs, v1[3] * qs);
                    *G1(u32x2, bp + bj * HALF) = q; }
                s2 += __shfl_xor(s2, 16); s2 += __shfl_xor(s2, 32);
                if (fq == 0) (void)__hip_atomic_fetch_add(G1(u64, ssout + row), ss_fix(s2), __ATOMIC_RELAXED, __HIP_MEMORY_SCOPE_AGENT); }
        __builtin_amdgcn_sched_barrier(0);
        }
    }
};
struct EpiGate {
    bf16_t* H; const bf16_t* PP; const u64* ssin; u64* ssout; signed char* HQ; float* ascale; const float* ascale_in;
    __device__ __forceinline__ void operator()(const f32x4 (&acc)[2][2][4][2], const Unit& u, int wr, int wc, int fr, int fq) const {
        const int row0 = u.pm * BM + wr * 64 + fr, col0 = u.pn * BM + wc * 32 + 8 * fq;
#pragma unroll
        for (int ai = 0; ai < 2; ++ai) {
            u32x4 hv[4][2], pv[4][2]; u64 sv[4]; float av[4];
#pragma unroll
            for (int m = 0; m < 4; ++m) { const int row = row0 + ai * HALF + m * 16; const bf16_t* hp = H + (size_t)row * DM + col0; const bf16_t* pp = PP + (size_t)row * DM + col0;
                sv[m] = *G1(const u64, ssin + row); av[m] = *G1(const float, ascale_in + row);
#pragma unroll
                for (int bj = 0; bj < 2; ++bj) { pv[m][bj] = *G1(const u32x4, pp + bj * HALF); hv[m][bj] = *G1(const u32x4, hp + bj * HALF); } }
            __builtin_amdgcn_sched_barrier(0);
#pragma unroll
            for (int m = 0; m < 4; ++m) { const int row = row0 + ai * HALF + m * 16; bf16_t* hp = H + (size_t)row * DM + col0;
                const float sc = ss_rstd(sv[m]); float s2 = 0.f;
                const float qs = 15.875f * sc;
                const float scq = sc * av[m] * (1.0f / W8_SCALE);
                if (HQ && fq == 0 && wc == 0 && u.pn == 0) *G1(float, ascale + row) = 1.0f / qs;
#pragma unroll
                for (int bj = 0; bj < 2; ++bj) { const u32x4 pw = pv[m][bj], hw = hv[m][bj];
                    f32x4 v0 = (f32x4){bflo(hw.x), bfhi(hw.x), bflo(hw.y), bfhi(hw.y)}, v1 = (f32x4){bflo(hw.z), bfhi(hw.z), bflo(hw.w), bfhi(hw.w)};
                    const i32x4 i0 = __builtin_bit_cast(i32x4, acc[ai][bj][m][0]), i1 = __builtin_bit_cast(i32x4, acc[ai][bj][m][1]);
                    const f32x4 a0 = (f32x4){(float)i0[0], (float)i0[1], (float)i0[2], (float)i0[3]} * scq, a1 = (f32x4){(float)i1[0], (float)i1[1], (float)i1[2], (float)i1[3]} * scq;
                    v0[0] += sigmoidf_(a0[0]) * bflo(pw.x); v0[1] += sigmoidf_(a0[1]) * bfhi(pw.x); v0[2] += sigmoidf_(a0[2]) * bflo(pw.y); v0[3] += sigmoidf_(a0[3]) * bfhi(pw.y);
                    v1[0] += sigmoidf_(a1[0]) * bflo(pw.z); v1[1] += sigmoidf_(a1[1]) * bfhi(pw.z); v1[2] += sigmoidf_(a1[2]) * bflo(pw.w); v1[3] += sigmoidf_(a1[3]) * bfhi(pw.w);
                    { u32x4 w; w.x = cvtpk(v0[0], v0[1]); w.y = cvtpk(v0[2], v0[3]); w.z = cvtpk(v1[0], v1[1]); w.w = cvtpk(v1[2], v1[3]); *G1(u32x4, hp + bj * HALF) = w; }
                    s2 += (v0[0] * v0[0] + v0[1] * v0[1]) + (v0[2] * v0[2] + v0[3] * v0[3]) + (v1[0] * v1[0] + v1[1] * v1[1]) + (v1[2] * v1[2] + v1[3] * v1[3]);
                    if (HQ) { u32x2 q; q.x = pack4_q8_(v0[0] * qs, v0[1] * qs, v0[2] * qs, v0[3] * qs); q.y = pack4_q8_(v1[0] * qs, v1[1] * qs, v1[2] * qs, v1[3] * qs); *G1(u32x2, HQ + (size_t)row * DM + col0 + bj * HALF) = q; } }
                s2 += __shfl_xor(s2, 16); s2 += __shfl_xor(s2, 32);
                if (fq == 0) (void)__hip_atomic_fetch_add(G1(u64, ssout + row), ss_fix(s2), __ATOMIC_RELAXED, __HIP_MEMORY_SCOPE_AGENT); }
            __builtin_amdgcn_sched_barrier(0);
        }
    }
};
struct EpiOGate {
    bf16_t* Y; const bf16_t* GC; int ldg;
    __device__ __forceinline__ void operator()(const f32x4 (&acc)[2][2][4][2], const Unit& u, int wr, int wc, int fr, int fq) const {
        const int row0 = u.pm * BM + wr * 64 + fr, col0 = u.g * 256 + wc * 32 + 8 * fq;
        u32x4 gv[2][4][2];
#pragma unroll
        for (int ai = 0; ai < 2; ++ai)
#pragma unroll
            for (int m = 0; m < 4; ++m) { const int row = row0 + ai * HALF + m * 16; const bf16_t* gp = GC + (size_t)row * ldg + col0;
#pragma unroll
                for (int bj = 0; bj < 2; ++bj) gv[ai][m][bj] = *G1(const u32x4, gp + bj * HALF); }
        __builtin_amdgcn_sched_barrier(0);
#pragma unroll
        for (int ai = 0; ai < 2; ++ai)
#pragma unroll
            for (int m = 0; m < 4; ++m) { const int row = row0 + ai * HALF + m * 16; bf16_t* yp = Y + (size_t)row * DM + col0;
#pragma unroll
                for (int bj = 0; bj < 2; ++bj) { const u32x4 gw = gv[ai][m][bj]; const f32x4 a0 = acc[ai][bj][m][0], a1 = acc[ai][bj][m][1];
                    u32x4 w; w.x = cvtpk(a0[0] * siluf_(bflo(gw.x)), a0[1] * siluf_(bfhi(gw.x))); w.y = cvtpk(a0[2] * siluf_(bflo(gw.y)), a0[3] * siluf_(bfhi(gw.y)));
                    w.z = cvtpk(a1[0] * siluf_(bflo(gw.z)), a1[1] * siluf_(bfhi(gw.z))); w.w = cvtpk(a1[2] * siluf_(bflo(gw.w)), a1[3] * siluf_(bfhi(gw.w)));
                    *G1(u32x4, yp + bj * HALF) = w; } }
    }
};
}

struct Args { const float* in[22]; float* out; unsigned char* ws; int ph_lo, ph_hi; };
enum { I_X = 0, I_P, I_T5, I_NORMG, I_EWIN, I_EBF, I_ESINK, I_EWOUT, I_OWIN, I_OQNG, I_OKVNG, I_OWUQ, I_OWUQI, I_OLNG, I_OLNB, I_OWUK, I_OWUV, I_OWOUT, I_PWPROJ, I_PNORMG, I_PWGATE, I_FINALG };


__device__ __forceinline__ unsigned off_b(unsigned row, unsigned ch) { return 256u * row + 16u * (ch ^ (((row & 3) << 2) | ((row >> 2) & 3))); }
__device__ __forceinline__ s16x4 vtr(LAS const unsigned char* p) { return __builtin_bit_cast(s16x4, __builtin_amdgcn_ds_read_tr16_b64_v4i16((LAS v4i16_t*)p)); }
__device__ __forceinline__ bf16x8 pack8(const f32x16& s, int o) {
    u32x4 w; w.x = cvtpk(s[o + 0], s[o + 1]); w.y = cvtpk(s[o + 2], s[o + 3]); w.z = cvtpk(s[o + 4], s[o + 5]); w.w = cvtpk(s[o + 6], s[o + 7]);
    return __builtin_bit_cast(bf16x8, w);
}
template <int NSB, int NOB>
__device__ __forceinline__ void sm_step(f32x16 (&s)[NSB], float& m, float& l, f32x16 (&o)[NOB], bf16x8 (&p)[NSB][2]) {
    float mx = s[0][0];
#pragma unroll
    for (int b = 0; b < NSB; ++b)
#pragma unroll
        for (int r = 0; r < 16; ++r) mx = fmaxf(mx, s[b][r]);
    mx = xhalf_max(mx);
    if (__any(mx > m + 8.0f)) {
        const float mn = fmaxf(m, mx), alpha = fast_exp2(m - mn);
        l *= alpha; m = mn;
#pragma unroll
        for (int c = 0; c < NOB; ++c) o[c] = o[c] * alpha;
    }
    float sum = 0.f;
#pragma unroll
    for (int b = 0; b < NSB; ++b)
#pragma unroll
        for (int r = 0; r < 16; ++r) { s[b][r] = fast_exp2(s[b][r] - m); sum += s[b][r]; }
    sum = xhalf_sum(sum);
    l += sum;
#pragma unroll
    for (int b = 0; b < NSB; ++b) { p[b][0] = pack8(s[b], 0); p[b][1] = pack8(s[b], 8); }
}
__device__ __forceinline__ unsigned vt_addr(int lane, int krow0, int c, int t) {
    const unsigned h = lane >> 5, blk = (lane >> 4) & 1, q = (lane & 15) >> 2, p = lane & 3;
    return off_b(krow0 + 8 * t + 4 * h + q, 4 * c + 2 * blk + (p >> 1)) + 8 * (p & 1);
}
__device__ __forceinline__ bf16x8 vfrag(LAS const unsigned char* img, int lane, int krow0, int c) {
    const s16x4 lo = vtr(img + vt_addr(lane, krow0, c, 0)), hi = vtr(img + vt_addr(lane, krow0, c, 1));
    return (bf16x8){lo[0], lo[1], lo[2], lo[3], hi[0], hi[1], hi[2], hi[3]};
}
__device__ __forceinline__ unsigned krow_base(int lane) { const unsigned r = lane & 31, h = lane >> 5, x = ((r & 3) << 2) | ((r >> 2) & 3); return 256u * r + 16u * ((x & 14u) | (h ^ (x & 1u))); }
__device__ __forceinline__ unsigned vt_base(int lane) { const unsigned h = lane >> 5, blk = (lane >> 4) & 1, q = (lane & 15) >> 2, p = lane & 3; const unsigned low0 = (2 * blk + (p >> 1)) ^ h;
    return 256u * (4 * h + q) + 64u * q + 16u * low0 + 8u * (p & 1); }
__device__ __forceinline__ bf16x8 vfrag2(LAS const unsigned char* img, unsigned vb, int c, int imm) {
    const unsigned a0 = vb ^ (unsigned)(c << 6);
    const s16x4 lo = vtr(img + a0 + imm), hi = vtr(img + (a0 ^ 32u) + imm + 2048);
    return (bf16x8){lo[0], lo[1], lo[2], lo[3], hi[0], hi[1], hi[2], hi[3]};
}
__device__ __forceinline__ float log_sigmoid_(float x) { return x > 0.f ? -log1pf(expf(-x)) : x - log1pf(expf(x)); }

constexpr int FOX_KV = 0, FOX_CUM = 65536, FOX_SCAN = FOX_CUM + 16384, FOX_KMAX = FOX_SCAN + 64, FOX_FLAGS = FOX_SCAN + 128;
constexpr float FOX_SKIP_LOG2 = 64.0f;
template <int CTRL> __device__ __forceinline__ float dpp_(float v) { return __int_as_float(__builtin_amdgcn_update_dpp(0, __float_as_int(v), CTRL, 0xF, 0xF, true)); }
__device__ __forceinline__ float row16_sum(float s) { s += dpp_<0xB1>(s); s += dpp_<0x4E>(s); s += dpp_<0x141>(s); s += dpp_<0x140>(s); return s; }
__device__ __forceinline__ float wave_max_u(float v) {
    v = fmaxf(v, dpp_<0xB1>(v)); v = fmaxf(v, dpp_<0x4E>(v)); v = fmaxf(v, dpp_<0x141>(v)); v = fmaxf(v, dpp_<0x140>(v));
    const float a0 = __int_as_float(__builtin_amdgcn_readlane(__float_as_int(v), 0)), a1 = __int_as_float(__builtin_amdgcn_readlane(__float_as_int(v), 16));
    const float a2 = __int_as_float(__builtin_amdgcn_readlane(__float_as_int(v), 32)), a3 = __int_as_float(__builtin_amdgcn_readlane(__float_as_int(v), 48));
    return fmaxf(fmaxf(a0, a1), fmaxf(a2, a3));
}
__device__ __forceinline__ void fox_scan(const GAS bf16_t* proj, const GAS u64* kn, const GAS float* bfp, int b, int hd, LAS unsigned char* lds, int tid, int lane, int wave) {
    LAS float* cumL = (LAS float*)(lds + FOX_CUM); LAS float* scanL = (LAS float*)(lds + FOX_SCAN); LAS float* kmaxL = (LAS float*)(lds + FOX_KMAX);
    const float bias = bfp[hd]; float v[8]; float run = 0.f;
#pragma unroll
    for (int i = 0; i < 8; ++i) { const float f = bf2f(proj[(size_t)(b * SEQ + 8 * tid + i) * EN + E_FA + hd]); run += log_sigmoid_(f + bias); v[i] = run; }
    float inc = run;
#pragma unroll
    for (int o = 1; o < 64; o <<= 1) { const float t = __shfl_up(inc, o); if (lane >= o) inc += t; }
    float kq = 0.f;
    { const GAS u64* kp = kn + (size_t)hd * M + (size_t)b * SEQ + 8 * tid;
#pragma unroll
      for (int i = 0; i < 8; ++i) kq = fmaxf(kq, (float)kp[i] * (1.0f / 16777216.0f)); }
    kq = wave_max_u(kq);
    if (lane == 63) scanL[wave] = inc;
    if (lane == 0) scanL[8 + wave] = kq;
    __syncthreads();
    float wbase = 0.f, km = 0.f;
#pragma unroll
    for (int w = 0; w < 8; ++w) { const float t = scanL[w]; if (w < wave) wbase += t; km = fmaxf(km, scanL[8 + w]); }
    const float excl = wbase + inc - run;
#pragma unroll
    for (int i = 0; i < 8; ++i) cumL[8 * tid + i] = -(excl + v[i]) * LOG2E;
    if (tid == 0) kmaxL[0] = sqrtf(km) * 1.005f;
    __syncthreads();
}
__device__ __forceinline__ void fox_unit(const GAS bf16_t* proj, GAS bf16_t* yin, int b, int hd, int qb, LAS unsigned char* lds, int tid, int lane, int wave) {
    const LAS float* cumL = (const LAS float*)(lds + FOX_CUM); volatile LAS int* flags = (volatile LAS int*)(lds + FOX_FLAGS);
    const int t0 = 256 * qb, q0 = t0 + 32 * wave, qme = q0 + (lane & 31), h = lane >> 5;
    const size_t rowb = (size_t)b * SEQ;
    const float cs = 0.08838834764831845f * LOG2E;
    const unsigned kbase = krow_base(lane), vbase = vt_base(lane);
    bf16x8 qf[8];
    { const GAS bf16_t* qp = proj + (rowb + qme) * EN + E_QA + hd * 128 + 8 * h;
#pragma unroll
      for (int s = 0; s < 8; ++s) qf[s] = *(const GAS bf16x8*)(qp + 16 * s); }
    float qn2 = 0.f;
#pragma unroll
    for (int s = 0; s < 8; ++s)
#pragma unroll
        for (int e = 0; e < 8; ++e) { const float x = bf2f((unsigned short)qf[s][e]); qn2 += x * x; }
    qn2 = xhalf_sum(qn2);
    const float cbound = sqrtf(qn2) * 1.0001f * ((const LAS float*)(lds + FOX_KMAX))[0] * cs;
    f32x16 o[4];
#pragma unroll
    for (int c = 0; c < 4; ++c)
#pragma unroll
        for (int r = 0; r < 16; ++r) o[c][r] = 0.f;
    float m = -1e30f, l = 0.f;
    const int ntile = 4 * (qb + 1);
    const int r0 = tid >> 4, c0 = tid & 15;
    const GAS bf16_t* kg = proj + (rowb + r0) * EN + E_KA + hd * 128 + c0 * 8;
    const GAS bf16_t* vg = proj + (rowb + r0) * EN + E_VA + hd * 128 + c0 * 8;
    const unsigned so0 = off_b(r0, c0), so1 = off_b(r0 + 32, c0);
    u32x4 sk0, sk1, sv0, sv1;
    { const size_t adv = (size_t)64 * (ntile - 1) * EN; sk0 = *(const GAS u32x4*)(kg + adv); sk1 = *(const GAS u32x4*)(kg + adv + (size_t)32 * EN); sv0 = *(const GAS u32x4*)(vg + adv); sv1 = *(const GAS u32x4*)(vg + adv + (size_t)32 * EN); }
    __syncthreads();
    { LAS unsigned char* kb = lds + FOX_KV; *(LAS u32x4*)(kb + so0) = sk0; *(LAS u32x4*)(kb + so1) = sk1; *(LAS u32x4*)(kb + 16384 + so0) = sv0; *(LAS u32x4*)(kb + 16384 + so1) = sv1; }
    __syncthreads();
    bool done_w = false;
    for (int it = 0; it < ntile; ++it) {
        const int kt = ntile - 1 - it, cur = it & 1; const LAS unsigned char* Kt = lds + FOX_KV + cur * 32768; const LAS unsigned char* Vt = Kt + 16384;
        const bool more = kt > 0;
        if (more) { const size_t adv = (size_t)64 * (kt - 1) * EN; sk0 = *(const GAS u32x4*)(kg + adv); sk1 = *(const GAS u32x4*)(kg + adv + (size_t)32 * EN); sv0 = *(const GAS u32x4*)(vg + adv); sv1 = *(const GAS u32x4*)(vg + adv + (size_t)32 * EN); }
        const int k0 = 64 * kt;
        if (k0 <= q0 + 31 && !done_w) {
            f32x16 sc[2];
#pragma unroll
            for (int kb = 0; kb < 2; ++kb) {
#pragma unroll
                for (int r = 0; r < 16; ++r) sc[kb][r] = 0.f;
#pragma unroll
                for (int s = 0; s < 8; ++s) { const bf16x8 a = *(const LAS bf16x8*)(Kt + (kbase ^ (unsigned)(s << 5)) + 8192 * kb); sc[kb] = __builtin_amdgcn_mfma_f32_32x32x16_bf16(a, qf[s], sc[kb], 0, 0, 0); }
            }
            const bool diag = (k0 + 63 > q0);
#pragma unroll
            for (int kb = 0; kb < 2; ++kb)
#pragma unroll
                for (int g4 = 0; g4 < 4; ++g4) { const int key0 = k0 + 32 * kb + 8 * g4 + 4 * h; const f32x4 nb = *(const LAS f32x4*)(cumL + key0);
#pragma unroll
                    for (int e = 0; e < 4; ++e) { float v = sc[kb][4 * g4 + e] * cs + nb[e]; if (diag && (key0 + e > qme)) v = -1e30f; sc[kb][4 * g4 + e] = v; } }
            bf16x8 p[2][2];
            sm_step<2, 4>(sc, m, l, o, p);
#pragma unroll
            for (int c = 0; c < 4; ++c)
#pragma unroll
                for (int kb = 0; kb < 2; ++kb)
#pragma unroll
                    for (int s = 0; s < 2; ++s) { const bf16x8 a = vfrag2(Vt, vbase, c, 256 * (32 * kb + 16 * s)); o[c] = __builtin_amdgcn_mfma_f32_32x32x16_bf16(a, p[kb][s], o[c], 0, 0, 0); }
            if (more) { const float amax = wave_max_u(cbound - m); done_w = (amax + cumL[k0 - 1] < -FOX_SKIP_LOG2); }
        }
        if (lane == 0) flags[cur * 8 + wave] = done_w ? 1 : 0;
        if (more) { LAS unsigned char* kb = lds + FOX_KV + (cur ^ 1) * 32768; *(LAS u32x4*)(kb + so0) = sk0; *(LAS u32x4*)(kb + so1) = sk1; *(LAS u32x4*)(kb + 16384 + so0) = sv0; *(LAS u32x4*)(kb + 16384 + so1) = sv1; }
        __syncthreads();
        int alld = 1;
#pragma unroll
        for (int w = 0; w < 8; ++w) alld &= flags[cur * 8 + w];
        if (alld) break;
    }
    const float il = 1.0f / l;
    const GAS bf16_t* gp = proj + (rowb + qme) * EN + E_GA + hd * 128 + 4 * h; GAS bf16_t* yp = yin + (rowb + qme) * DM + hd * 128 + 4 * h;
#pragma unroll
    for (int c = 0; c < 4; ++c)
#pragma unroll
        for (int g4 = 0; g4 < 4; ++g4) { const u32x2 gw = *(const GAS u32x2*)(gp + 32 * c + 8 * g4);
            u32x2 w; w.x = cvtpk(o[c][4 * g4 + 0] * il * siluf_(bflo(gw.x)), o[c][4 * g4 + 1] * il * siluf_(bfhi(gw.x))); w.y = cvtpk(o[c][4 * g4 + 2] * il * siluf_(bflo(gw.y)), o[c][4 * g4 + 3] * il * siluf_(bfhi(gw.y)));
            *(GAS u32x2*)(yp + 32 * c + 8 * g4) = w; }
}

constexpr int SWA_K = 0, SWA_V = 65536, SWA_TB = 131072;
__device__ __forceinline__ int t5_bucket_(int rel) {
    if (rel < 16) return rel;
    if (rel >= 128) return 31;
    const int v = 16 + (int)(logf((float)rel * (1.0f / 16.0f)) / 2.0794415416798357f * 16.0f);
    return v < 31 ? v : 31;
}
__device__ __forceinline__ void swa_unit(const GAS bf16_t* proj, GAS bf16_t* yin, const GAS float* t5, const GAS float* sinks, int b, int nb, int kvh, LAS unsigned char* lds, int tid, int lane, int wave) {
    const size_t rowb = (size_t)b * SEQ; const int hq = kvh * 8 + wave, h = lane >> 5;
    __syncthreads();
#pragma unroll
    for (int i = 0; i < 4; ++i) { const int c = tid + 512 * i, row = c >> 3, ch = c & 7; const int key = 128 * (nb - 1) + row;
        u32x4 kv = zero4_(), vv = kv;
        if (key >= 0) { const GAS bf16_t* src = proj + (rowb + key) * EN + kvh * 64 + ch * 8; kv = *(const GAS u32x4*)(src + E_KB); vv = *(const GAS u32x4*)(src + E_VB); }
        *(LAS u32x4*)(lds + SWA_K + off_b(row, ch)) = kv; *(LAS u32x4*)(lds + SWA_V + off_b(row, ch)) = vv; }
    LAS float* tb = (LAS float*)(lds + SWA_TB + wave * 512);
#pragma unroll
    for (int i = 0; i < 2; ++i) { const int rel = lane + 64 * i; tb[rel] = t5[t5_bucket_(rel) * 64 + hq] * LOG2E; }
    __syncthreads();
    const float cs = 0.125f * LOG2E, sink2 = sinks[hq] * LOG2E;
    const unsigned kbase = krow_base(lane), vbase = vt_base(lane);
    for (int cg = 0; cg < 4; ++cg) {
        const int qi = 32 * cg + (lane & 31); const size_t row = rowb + 128 * nb + qi;
        bf16x8 qf[4];
        { const GAS bf16_t* qp = proj + row * EN + E_QB + hq * 64 + 8 * h;
#pragma unroll
          for (int s = 0; s < 4; ++s) qf[s] = *(const GAS bf16x8*)(qp + 16 * s); }
        f32x16 o[2];
#pragma unroll
        for (int c = 0; c < 2; ++c)
#pragma unroll
            for (int r = 0; r < 16; ++r) o[c][r] = 0.f;
        float m = sink2, l = 1.0f;
        for (int kb = cg; kb < cg + 5; ++kb) {
            f32x16 sc[1];
#pragma unroll
            for (int r = 0; r < 16; ++r) sc[0][r] = 0.f;
#pragma unroll
            for (int s = 0; s < 4; ++s) { const bf16x8 a = *(const LAS bf16x8*)(lds + SWA_K + (kbase ^ (unsigned)(s << 5)) + 8192 * kb); sc[0] = __builtin_amdgcn_mfma_f32_32x32x16_bf16(a, qf[s], sc[0], 0, 0, 0); }
#pragma unroll
            for (int r = 0; r < 16; ++r) { const int kj = 32 * kb + (r & 3) + 8 * (r >> 2) + 4 * h, rel = qi + 128 - kj;
                const bool valid = (rel >= 0) && (rel < 128) && (nb > 0 || kj >= 128);
                const float bias = tb[rel & 127];
                sc[0][r] = sc[0][r] * cs + bias + (valid ? 0.f : -1e30f); }
            bf16x8 p[1][2];
            sm_step<1, 2>(sc, m, l, o, p);
#pragma unroll
            for (int c = 0; c < 2; ++c)
#pragma unroll
                for (int s = 0; s < 2; ++s) { const bf16x8 a = vfrag2(lds + SWA_V + 8192 * kb, vbase, c, 4096 * s); o[c] = __builtin_amdgcn_mfma_f32_32x32x16_bf16(a, p[0][s], o[c], 0, 0, 0); }
        }
        const float il = 1.0f / l;
        const GAS bf16_t* gp = proj + row * EN + E_GB + hq * 64 + 4 * h; GAS bf16_t* yp = yin + row * DM + 2048 + hq * 64 + 4 * h;
#pragma unroll
        for (int c = 0; c < 2; ++c)
#pragma unroll
            for (int g4 = 0; g4 < 4; ++g4) { const u32x2 gw = *(const GAS u32x2*)(gp + 32 * c + 8 * g4);
                u32x2 w; w.x = cvtpk(o[c][4 * g4 + 0] * il * siluf_(bflo(gw.x)), o[c][4 * g4 + 1] * il * siluf_(bfhi(gw.x))); w.y = cvtpk(o[c][4 * g4 + 2] * il * siluf_(bflo(gw.y)), o[c][4 * g4 + 3] * il * siluf_(bfhi(gw.y)));
                *(GAS u32x2*)(yp + 32 * c + 8 * g4) = w; }
    }
}
__device__ __forceinline__ void phase_even_attn(const Args& a, int j, LAS unsigned char* lds, int G, int bx, const int wave, const int which) {
    const int lane = lane_id_(), tid = wave * 64 + lane;
    unsigned char* ws_ = a.ws; OPAQUE_S(ws_); GAS unsigned char* ws = (GAS unsigned char*)ws_;
    const GAS bf16_t* proj = (const GAS bf16_t*)(ws + WS_PROJ); GAS bf16_t* yin = (GAS bf16_t*)(ws + WS_YIN);
    if (which & 1) for (int u = bx; u < 256; u += G) {
        const int b = u >> 7, hd = (u >> 3) & 15, i = u & 7;
        __syncthreads();
        fox_scan(proj, (const GAS u64*)(ws + WS_KN) + (size_t)j * 16 * M, ((const GAS float*)a.in[I_EBF]) + j * 16, b, hd, lds, tid, lane, wave);
        fox_unit(proj, yin, b, hd, 15 - i, lds, tid, lane, wave);
        fox_unit(proj, yin, b, hd, i, lds, tid, lane, wave);
    }
    if (which & 2) for (int u = bx; u < 256; u += G) {
        const int b = u >> 7, nb = (u >> 2) & 31, kvh = u & 3;
        swa_unit(proj, yin, ((const GAS float*)a.in[I_T5]), ((const GAS float*)a.in[I_ESINK]) + j * 32, b, nb, kvh, lds, tid, lane, wave);
    }
    __syncthreads();
}

#define BAR_LDS() asm volatile("s_waitcnt lgkmcnt(0)\n\ts_barrier" ::: "memory")
__device__ __forceinline__ void phase_odd_norms(const Args& a, int j, int gw, int NGW) {
    const int lane = lane_id_();
    unsigned char* ws_ = a.ws; OPAQUE_S(ws_); GAS unsigned char* ws = (GAS unsigned char*)ws_;
    const GAS bf16_t* proj = (const GAS bf16_t*)(ws + WS_PROJ); GAS bf16_t* cqn = (GAS bf16_t*)(ws + WS_CQN); GAS bf16_t* lat = (GAS bf16_t*)(ws + WS_LAT); GAS bf16_t* kidx = (GAS bf16_t*)(ws + WS_KIDX); GAS float* widx = (GAS float*)(ws + WS_WIDX);
    const GAS float* qg = ((const GAS float*)a.in[I_OQNG]) + j * 1024; const GAS float* kvg = ((const GAS float*)a.in[I_OKVNG]) + j * 512; const GAS float* lng = ((const GAS float*)a.in[I_OLNG]) + j * 64; const GAS float* lnb = ((const GAS float*)a.in[I_OLNB]) + j * 64;
    for (int row = gw; row < M; row += NGW) {
        const GAS bf16_t* pr = proj + (size_t)row * ON;
        {
            const u32x4 w0 = *(const GAS u32x4*)(pr + O_CQ + lane * 8), w1 = *(const GAS u32x4*)(pr + O_CQ + 512 + lane * 8);
            float v[16] = {bflo(w0.x), bfhi(w0.x), bflo(w0.y), bfhi(w0.y), bflo(w0.z), bfhi(w0.z), bflo(w0.w), bfhi(w0.w), bflo(w1.x), bfhi(w1.x), bflo(w1.y), bfhi(w1.y), bflo(w1.z), bfhi(w1.z), bflo(w1.w), bfhi(w1.w)};
            float ss = 0.f;
#pragma unroll
            for (int i = 0; i < 16; ++i) ss += v[i] * v[i];
            ss = wave_sum(ss); const float r = 1.0f / sqrtf(ss * (1.0f / 1024.0f) + EPS);
            const f32x4 g0 = *(const GAS f32x4*)(qg + lane * 8), g1 = *(const GAS f32x4*)(qg + lane * 8 + 4), g2 = *(const GAS f32x4*)(qg + 512 + lane * 8), g3 = *(const GAS f32x4*)(qg + 512 + lane * 8 + 4);
            u32x4 o0, o1;
            o0.x = cvtpk(v[0] * r * g0[0], v[1] * r * g0[1]); o0.y = cvtpk(v[2] * r * g0[2], v[3] * r * g0[3]); o0.z = cvtpk(v[4] * r * g1[0], v[5] * r * g1[1]); o0.w = cvtpk(v[6] * r * g1[2], v[7] * r * g1[3]);
            o1.x = cvtpk(v[8] * r * g2[0], v[9] * r * g2[1]); o1.y = cvtpk(v[10] * r * g2[2], v[11] * r * g2[3]); o1.z = cvtpk(v[12] * r * g3[0], v[13] * r * g3[1]); o1.w = cvtpk(v[14] * r * g3[2], v[15] * r * g3[3]);
            *(GAS u32x4*)(cqn + (size_t)row * 1024 + lane * 8) = o0; *(GAS u32x4*)(cqn + (size_t)row * 1024 + 512 + lane * 8) = o1;
        }
        {
            const u32x4 w0 = *(const GAS u32x4*)(pr + O_CKV + lane * 8);
            float v[8] = {bflo(w0.x), bfhi(w0.x), bflo(w0.y), bfhi(w0.y), bflo(w0.z), bfhi(w0.z), bflo(w0.w), bfhi(w0.w)};
            float ss = 0.f;
#pragma unroll
            for (int i = 0; i < 8; ++i) ss += v[i] * v[i];
            ss = wave_sum(ss); const float r = 1.0f / sqrtf(ss * (1.0f / 512.0f) + EPS);
            const f32x4 g0 = *(const GAS f32x4*)(kvg + lane * 8), g1 = *(const GAS f32x4*)(kvg + lane * 8 + 4);
            u32x4 o0; o0.x = cvtpk(v[0] * r * g0[0], v[1] * r * g0[1]); o0.y = cvtpk(v[2] * r * g0[2], v[3] * r * g0[3]); o0.z = cvtpk(v[4] * r * g1[0], v[5] * r * g1[1]); o0.w = cvtpk(v[6] * r * g1[2], v[7] * r * g1[3]);
            *(GAS u32x4*)(lat + (size_t)row * 512 + lane * 8) = o0;
        }
        {
            const float x = bf2f(pr[O_KIDX + lane]); const float mu = wave_sum(x) * (1.0f / 64.0f); const float xc = x - mu; const float var = wave_sum(xc * xc) * (1.0f / 64.0f);
            const float y = xc * (1.0f / sqrtf(var + EPS)) * lng[lane] + lnb[lane];
            kidx[(size_t)row * 64 + lane] = (bf16_t)(cvtpk(y, 0.f) & 0xffffu);
        }
        if (lane < 32) widx[(size_t)row * 32 + lane] = bf2f(pr[O_WIDX + lane]) * 0.022097086912079608f;
    }
}

__device__ __forceinline__ unsigned sortable_(float f) { const unsigned u = __float_as_uint(f); return (u & 0x80000000u) ? ~u : (u | 0x80000000u); }
__device__ __forceinline__ int wave_isum(int v) {
#pragma unroll
    for (int o = 1; o < 64; o <<= 1) v += __shfl_xor(v, o);
    return v;
}
__device__ __forceinline__ void topk_row(const GAS float* srow, GAS int* sel, int t, int lane) {
    const int nvalid = t + 1;
    if (nvalid <= 256) {
#pragma unroll
        for (int i = 0; i < 4; ++i) sel[64 * i + lane] = (64 * i + lane < nvalid) ? 64 * i + lane : 0;
        return;
    }
    unsigned key[64];
    const int ngrp = (nvalid + 511) >> 9;
#pragma unroll
    for (int g = 0; g < 8; ++g) {
        if (g < ngrp) {
#pragma unroll
            for (int i = 8 * g; i < 8 * g + 8; ++i) { const int e = 64 * i + lane; const float v = srow[e]; key[i] = (e < nvalid) ? sortable_(v) : 0u; }
        } else {
#pragma unroll
            for (int i = 8 * g; i < 8 * g + 8; ++i) key[i] = 0u;
        }
    }
    unsigned T = 0u;
#pragma unroll 1
    for (int bit = 31; bit >= 0; --bit) {
        const unsigned cand = T | (1u << bit); int cnt = 0;
#pragma unroll
        for (int g = 0; g < 8; ++g) {
            if (g < ngrp) {
#pragma unroll
                for (int i = 0; i < 8; ++i) cnt += __builtin_popcountll(__ballot(key[8 * g + i] >= cand));
            }
            __builtin_amdgcn_sched_barrier(0);
        }
        if (cnt >= 256) T = cand;
        if (cnt == 256) break;
    }
    int cgt = 0;
#pragma unroll
    for (int g = 0; g < 8; ++g) {
        if (g < ngrp) {
#pragma unroll
            for (int i = 0; i < 8; ++i) cgt += __builtin_popcountll(__ballot(key[8 * g + i] > T));
        }
        __builtin_amdgcn_sched_barrier(0);
    }
    const int need = 256 - cgt; int pos = 0, eqseen = 0;
#pragma unroll
    for (int g = 0; g < 8; ++g) {
        if (g < ngrp) {
#pragma unroll
            for (int i = 8 * g; i < 8 * g + 8; ++i) {
                const bool gt = key[i] > T, eq = key[i] == T;
                const unsigned long long meq = __ballot(eq);
                const int rank = eqseen + (int)__builtin_amdgcn_mbcnt_hi((unsigned)(meq >> 32), __builtin_amdgcn_mbcnt_lo((unsigned)meq, 0u));
                const bool take = gt || (eq && rank < need);
                const unsigned long long mt = __ballot(take);
                const int p = pos + (int)__builtin_amdgcn_mbcnt_hi((unsigned)(mt >> 32), __builtin_amdgcn_mbcnt_lo((unsigned)mt, 0u));
                if (take && p < 256) sel[p] = 64 * i + lane;
                pos += __builtin_popcountll(mt); eqseen += __builtin_popcountll(meq);
            }
        }
    }
}
__device__ __forceinline__ void phase_indexer(const Args& a, LAS unsigned char* lds, int G, int bx, const int wave, const bool do_topk) {
    unsigned char* ws_ = a.ws; OPAQUE_S(ws_); GAS unsigned char* ws = (GAS unsigned char*)ws_;
    const GAS bf16_t* qbuf = (const GAS bf16_t*)(ws + WS_QBUF); const GAS bf16_t* kidx = (const GAS bf16_t*)(ws + WS_KIDX); const GAS float* widx = (const GAS float*)(ws + WS_WIDX);
    GAS float* score = (GAS float*)(ws + WS_SCORE) + (size_t)bx * 16 * 4096; GAS int* sel = (GAS int*)(ws + WS_SEL);
    for (int u = bx; u < 256; u += G) {
        const int b = u >> 7, i0 = u & 127;
        for (int half = 0; half < 2; ++half) {
            const int lane = lane_id_(), tid = wave * 64 + lane, h = lane >> 5;
            const unsigned key = lane & 31, x = (key >> 1) & 7;
            const unsigned bbase = 128u * key + 16u * ((x & 6u) | ((unsigned)h ^ (x & 1u)));
            const int qg = half ? 255 - i0 : i0;
            const int tq = 16 * qg + 2 * wave; const size_t rowb = (size_t)b * SEQ;
            bf16x8 qa[2][4]; f32x4 wv[2][4];
#pragma unroll
            for (int q = 0; q < 2; ++q) { const GAS bf16_t* qp = qbuf + (rowb + tq + q) * QW + 4096 + (lane & 31) * 64 + 8 * h; const GAS float* wp = widx + (rowb + tq + q) * 32 + 4 * h;
#pragma unroll
                for (int s = 0; s < 4; ++s) qa[q][s] = *(const GAS bf16x8*)(qp + 16 * s);
#pragma unroll
                for (int g4 = 0; g4 < 4; ++g4) wv[q][g4] = *(const GAS f32x4*)(wp + 8 * g4); }
            const int kmax = 16 * qg + 15, ntile = kmax / 256 + 1;
            const GAS bf16_t* kg = kidx + rowb * 64 + tid * 8;
            u32x4 st[4];
#pragma unroll
            for (int i = 0; i < 4; ++i) st[i] = *(const GAS u32x4*)(kg + i * 4096);
            __syncthreads();
#pragma unroll
            for (int i = 0; i < 4; ++i) { const int c = tid + 512 * i, row = c >> 3, ch = c & 7; *(LAS u32x4*)(lds + row * 128 + ((ch ^ ((row >> 1) & 7)) << 4)) = st[i]; }
            __syncthreads();
            for (int kt = 0; kt < ntile; ++kt) {
                const int cur = kt & 1; const bool more = kt + 1 < ntile;
                if (more) {
#pragma unroll
                    for (int i = 0; i < 4; ++i) st[i] = *(const GAS u32x4*)(kg + (size_t)(kt + 1) * 16384 + i * 4096); }
                const LAS unsigned char* Kt = lds + cur * 32768;
                const int nkb = (kmax - 256 * kt) / 32 + 1 < 8 ? (kmax - 256 * kt) / 32 + 1 : 8;
#define IDX_LOAD(B, kb_) do { _Pragma("unroll") for (int s_ = 0; s_ < 4; ++s_) B[s_] = *(const LAS bf16x8*)(Kt + (bbase ^ (unsigned)(s_ << 5)) + 4096 * (kb_)); } while (0)
#define IDX_BLOCK(B, kb_) do { f32x16 acc0, acc1; \
                    _Pragma("unroll") for (int r = 0; r < 16; ++r) { acc0[r] = 0.f; acc1[r] = 0.f; } \
                    _Pragma("unroll") for (int s_ = 0; s_ < 4; ++s_) acc0 = __builtin_amdgcn_mfma_f32_32x32x16_bf16(qa[0][s_], B[s_], acc0, 0, 0, 0); \
                    _Pragma("unroll") for (int s_ = 0; s_ < 4; ++s_) acc1 = __builtin_amdgcn_mfma_f32_32x32x16_bf16(qa[1][s_], B[s_], acc1, 0, 0, 0); \
                    float sc0 = 0.f, sc1 = 0.f; \
                    _Pragma("unroll") for (int r = 0; r < 16; ++r) sc0 += wv[0][r >> 2][r & 3] * fmaxf(acc0[r], 0.f); \
                    _Pragma("unroll") for (int r = 0; r < 16; ++r) sc1 += wv[1][r >> 2][r & 3] * fmaxf(acc1[r], 0.f); \
                    sc0 = xhalf_sum(sc0); sc1 = xhalf_sum(sc1); \
                    if (lane < 32) { score[(size_t)(2 * wave) * 4096 + 256 * kt + 32 * (kb_) + lane] = sc0; score[(size_t)(2 * wave + 1) * 4096 + 256 * kt + 32 * (kb_) + lane] = sc1; } } while (0)
                { bf16x8 fa[4], fb[4];
                  IDX_LOAD(fa, 0);
                  for (int kb = 0; kb < nkb; kb += 2) {
                      if (kb + 1 < nkb) IDX_LOAD(fb, kb + 1);
                      IDX_BLOCK(fa, kb);
                      if (kb + 1 < nkb) { if (kb + 2 < nkb) IDX_LOAD(fa, kb + 2); IDX_BLOCK(fb, kb + 1); }
                  } }
#undef IDX_LOAD
#undef IDX_BLOCK
                if (more) {
#pragma unroll
                    for (int i = 0; i < 4; ++i) { const int c = tid + 512 * i, row = c >> 3, ch = c & 7; *(LAS u32x4*)(lds + (cur ^ 1) * 32768 + row * 128 + ((ch ^ ((row >> 1) & 7)) << 4)) = st[i]; } }
                __syncthreads();
            }
            VM_WAIT();
            __builtin_amdgcn_fence(__ATOMIC_ACQUIRE, "agent");
            VM_WAIT();
            if (do_topk) { const int lane2 = lane_id_();
#pragma unroll 1
              for (int q = 0; q < 2; ++q) topk_row(score + (size_t)(2 * wave + q) * 4096, sel + (rowb + tq + q) * 256, tq + q, lane2); }
        }
    }
    __syncthreads();
}

constexpr int DSA_LAT = 0, DSA_XCH = 65536, DSA_TAB = 131072, DSA_T5 = 143360, DSA_TCNT = 147456;
__device__ __forceinline__ void phase_dsa(const Args& a, LAS unsigned char* lds, int G, int bx, const int wave, const int mode) {
    (void)mode;
    const int lane = lane_id_(), tid = wave * 64 + lane, h = lane >> 5, team = wave >> 2, wq = wave & 3, ttid = tid & 255;
    unsigned char* ws_ = a.ws; OPAQUE_S(ws_); GAS unsigned char* ws = (GAS unsigned char*)ws_;
    const GAS bf16_t* qabs = (const GAS bf16_t*)(ws + WS_QABS); const GAS bf16_t* lat = (const GAS bf16_t*)(ws + WS_LAT); const GAS int* sel = (const GAS int*)(ws + WS_SEL); GAS bf16_t* olat = (GAS bf16_t*)(ws + WS_OLAT);
    LAS float* t5c = (LAS float*)(lds + DSA_T5);
    volatile LAS unsigned* tcnt = (volatile LAS unsigned*)(lds + DSA_TCNT + team * 64);
    __syncthreads();
    for (int i = tid; i < 1024; i += 512) t5c[i] = ((const GAS float*)a.in[I_T5])[(i >> 5) * 64 + 32 + (i & 31)] * LOG2E;
    if (tid < 32) ((volatile LAS unsigned*)(lds + DSA_TCNT))[tid] = 0u;
    __syncthreads();
    LAS unsigned char* latw = lds + DSA_LAT + wave * 8192; LAS unsigned char* xch = lds + DSA_XCH + team * 32768;
    LAS unsigned char* tabs = lds + DSA_TAB + team * 6144;
#define TAB_SEL(p) ((LAS int*)(tabs + (p) * 3072))
#define TAB_BKT(p) ((LAS int*)(tabs + (p) * 3072 + 1024))
#define TAB_MADD(p) ((LAS float*)(tabs + (p) * 3072 + 2048))
    const unsigned kbase = krow_base(lane), vbase = vt_base(lane);
    const float cs = 0.08838834764831845f * LOG2E;
    unsigned tepoch = 0u;
#define TEAM_BAR() do { asm volatile("s_waitcnt lgkmcnt(0)" ::: "memory"); ++tepoch; if (lane == 0) __hip_atomic_fetch_add((LAS unsigned*)tcnt, 1u, __ATOMIC_RELAXED, __HIP_MEMORY_SCOPE_WORKGROUP); \
        while (__builtin_amdgcn_readfirstlane((int)*tcnt) < (int)(4u * tepoch)) __builtin_amdgcn_s_sleep(1); asm volatile("" ::: "memory"); } while (0)
    const int gr = lane >> 4, gc = lane & 15;
    const unsigned wbase = 256u * gr + 16u * (gc ^ (gr << 2));
#define DSA_TABLES(p, qq, idxv) do { const int t_ = (qq) & 4095, ns_ = t_ + 1 < 256 ? t_ + 1 : 256; const bool valid_ = ttid < ns_; const int id_ = valid_ ? (idxv) : 0; \
        TAB_SEL(p)[ttid] = id_; TAB_BKT(p)[ttid] = 128 * t5_bucket_(valid_ ? t_ - id_ : 0); TAB_MADD(p)[ttid] = valid_ ? 0.f : -1e30f; } while (0)
#define DSA_SELLOAD(qq) ((ttid < ((((qq) & 4095) + 1 < 256) ? ((qq) & 4095) + 1 : 256)) ? sel[(size_t)(qq) * 256 + ttid] : 0)
#define DSA_QLOAD(qq) do { const GAS bf16_t* qp_ = qabs + (size_t)(qq) * 16384 + (lane & 31) * 512 + 128 * wq + 8 * h; _Pragma("unroll") for (int s_ = 0; s_ < 8; ++s_) qf[s_] = *(const GAS bf16x8*)(qp_ + 16 * s_); } while (0)
#define DSA_GATHER(ST, lr, tab, cc) do { _Pragma("unroll") for (int i = 0; i < 8; ++i) ST[i] = *(const GAS u32x4*)((lr) + (size_t)(tab)[32 * (cc) + gr + 4 * i] * 512); } while (0)
    int qp = bx, par = 0;
    bf16x8 qf[8]; u32x4 stA[8], stB[8];
    int nxt_idx = 0;
    { const int q0 = 2 * qp + team;
      DSA_TABLES(0, q0, sel[(size_t)q0 * 256 + ttid]);
      if (qp + G < 4096) nxt_idx = DSA_SELLOAD(q0 + 2 * G);
      DSA_QLOAD(q0);
      TEAM_BAR();
      const GAS bf16_t* lr0 = lat + (size_t)(q0 >> 12) * SEQ * 512 + 128 * wq + gc * 8;
      DSA_GATHER(stA, lr0, TAB_SEL(0), 0); DSA_GATHER(stB, lr0, TAB_SEL(0), 1); }
    for (; qp < 4096; qp += G, par ^= 1) {
        const int q = 2 * qp + team, b = q >> 12;
        const bool has_next = qp + G < 4096; const int qn = q + 2 * G;
        const LAS int* selP = TAB_SEL(par); const LAS int* bktP = TAB_BKT(par); const LAS float* maddP = TAB_MADD(par); const LAS int* selN = TAB_SEL(par ^ 1);
        const GAS bf16_t* lrow = lat + (size_t)b * SEQ * 512 + 128 * wq + gc * 8;
        const GAS bf16_t* lrowN = lat + (size_t)(qn >> 12) * SEQ * 512 + 128 * wq + gc * 8;
        f32x16 o[4];
#pragma unroll
        for (int c = 0; c < 4; ++c)
#pragma unroll
            for (int r = 0; r < 16; ++r) o[c][r] = 0.f;
        float m = -1e30f, l = 0.f;
#define DSA_CHUNK(ST, c) do { \
            _Pragma("unroll") for (int i = 0; i < 8; ++i) *(LAS u32x4*)(latw + (wbase ^ (unsigned)((i & 3) << 4)) + 1024 * i) = ST[i];        \
            if ((c) + 2 < 8) DSA_GATHER(ST, lrow, selP, (c) + 2); else if (has_next) DSA_GATHER(ST, lrowN, selN, (c) + 2 - 8);        \
            f32x16 sc[1]; \
            _Pragma("unroll") for (int r = 0; r < 16; ++r) sc[0][r] = 0.f; \
            _Pragma("unroll") for (int s_ = 0; s_ < 8; ++s_) { const bf16x8 af = *(const LAS bf16x8*)(latw + (kbase ^ (unsigned)(s_ << 5))); sc[0] = __builtin_amdgcn_mfma_f32_32x32x16_bf16(af, qf[s_], sc[0], 0, 0, 0); } \
            if ((c) == 7 && has_next) DSA_QLOAD(qn);            \
            LAS unsigned char* xc = xch + ((c) & 1) * 8192; \
            _Pragma("unroll") for (int g8 = 0; g8 < 2; ++g8) *(LAS bf16x8*)(xc + wq * 2048 + (g8 * 64 + lane) * 16) = pack8(sc[0], 8 * g8);        \
            TEAM_BAR();                                        \
            _Pragma("unroll") for (int g4 = 0; g4 < 4; ++g4) { \
                f32x4 v = {0.f, 0.f, 0.f, 0.f}; \
                _Pragma("unroll") for (int w = 0; w < 4; ++w) { const u32x2 pw = *(const LAS u32x2*)(xc + w * 2048 + ((g4 >> 1) * 64 + lane) * 16 + (g4 & 1) * 8); v = v + (f32x4){bflo(pw.x), bfhi(pw.x), bflo(pw.y), bfhi(pw.y)}; } \
                const int j0 = 32 * (c) + 8 * g4 + 4 * h; \
                const u32x4 bk4 = *(const LAS u32x4*)(bktP + j0); const f32x4 md4 = *(const LAS f32x4*)(maddP + j0); \
                _Pragma("unroll") for (int e = 0; e < 4; ++e) { const float bias = *(const LAS float*)((const LAS unsigned char*)t5c + bk4[e] + 4 * (lane & 31)); sc[0][4 * g4 + e] = v[e] * cs + bias + md4[e]; } \
            } \
            bf16x8 p[1][2]; \
            sm_step<1, 4>(sc, m, l, o, p); \
            _Pragma("unroll") for (int cc = 0; cc < 4; ++cc) \
                _Pragma("unroll") for (int s_ = 0; s_ < 2; ++s_) { const bf16x8 af = vfrag2(latw, vbase, cc, 4096 * s_); o[cc] = __builtin_amdgcn_mfma_f32_32x32x16_bf16(af, p[0][s_], o[cc], 0, 0, 0); } \
            if ((c) == 3 && has_next) { DSA_TABLES(par ^ 1, qn, nxt_idx);        \
                if (qp + 2 * G < 4096) nxt_idx = DSA_SELLOAD(qn + 2 * G); } \
        } while (0)
        for (int c2 = 0; c2 < 8; c2 += 2) { DSA_CHUNK(stA, c2); DSA_CHUNK(stB, c2 + 1); }
#undef DSA_CHUNK
        const float il = 1.0f / l;
        GAS bf16_t* op = olat + (size_t)q * 16384 + (lane & 31) * 512 + 128 * wq + 4 * h;
#pragma unroll
        for (int cc = 0; cc < 4; ++cc)
#pragma unroll
            for (int g4 = 0; g4 < 4; ++g4) { u32x2 w; w.x = cvtpk(o[cc][4 * g4] * il, o[cc][4 * g4 + 1] * il); w.y = cvtpk(o[cc][4 * g4 + 2] * il, o[cc][4 * g4 + 3] * il); *(GAS u32x2*)(op + 32 * cc + 8 * g4) = w; }
    }
    __syncthreads();
#undef TEAM_BAR
#undef TAB_SEL
#undef TAB_BKT
#undef TAB_MADD
#undef DSA_TABLES
#undef DSA_SELLOAD
#undef DSA_QLOAD
#undef DSA_GATHER
}

constexpr int PH_FINAL = 50, NPH = PH_FINAL + 1;

struct TJob { int in_id; long src_lstride; int ldsrc, K, src_col0, ncols; long dst_off  ; int ldt, dst_row0, gain_id; long gain_lstride, gain_off0; int lsel, flags; };
constexpr int NTJ_E = 12, NTJ_O = 11;
__constant__ TJob g_tj_even[NTJ_E] = {
#define EWIN_JOB(c0, n, r0) {I_EWIN, (long)4096 * 12816, 12816, 4096, c0, n, (long)WS_EWIN, 4096, r0, I_NORMG, (long)2 * 4096, 0, 0, 2}
    EWIN_JOB(0, 2048, E_QA), EWIN_JOB(2048, 2048, E_KA), EWIN_JOB(4096, 2048, E_VA), EWIN_JOB(6160, 2048, E_GA), EWIN_JOB(8208, 2048, E_QB),
    EWIN_JOB(10768, 2048, E_GB), EWIN_JOB(10256, 256, E_KB), EWIN_JOB(10512, 256, E_VB), EWIN_JOB(6144, 16, E_FA),
    {I_EWOUT, (long)4096 * 4096, 4096, 4096, 0, 4096, (long)WS_EWOUT, 4096, 0, -1, 0, 0, 0, 2},
    {I_PWGATE, (long)4096 * 4096, 4096, 4096, 0, 4096, (long)WS_EGATE, 4096, 0, I_PNORMG, (long)4096, 0, 1, 2},
    {I_PWPROJ, (long)256 * 4096, 4096, 256, 0, 4096, (long)WS_EPROJ, 256, 0, -1, 0, 0, 1, 0},
};
__constant__ TJob g_tj_odd[NTJ_O] = {
#define OWIN_JOB(c0, n, r0) {I_OWIN, (long)4096 * 5728, 5728, 4096, c0, n, (long)WS_OWIN, 4096, r0, I_NORMG, (long)2 * 4096, 4096, 0, 0}
    {I_OWIN, (long)4096 * 5728, 5728, 4096, 1632, 4096, (long)WS_OWIN8, 4096, 0, I_NORMG, (long)2 * 4096, 4096, 0, 2},
    OWIN_JOB(0, 1024, 0), OWIN_JOB(1024, 512, 1024), OWIN_JOB(1536, 64, 1536), OWIN_JOB(1600, 32, 1600),
    {I_OWOUT, (long)4096 * 4096, 4096, 4096, 0, 4096, (long)WS_OWOUT, 4096, 0, -1, 0, 0, 0, 2},
    {I_PWGATE, (long)4096 * 4096, 4096, 4096, 0, 4096, (long)WS_OGATE, 4096, 0, I_PNORMG, (long)4096, 0, 1, 2},
    {I_PWPROJ, (long)256 * 4096, 4096, 256, 0, 4096, (long)WS_OPROJ, 256, 0, -1, 0, 0, 1, 0},
    {I_OWUQ,  (long)1024 * 4096, 4096, 1024, 0, 4096, (long)WS_OWUQ, 1024, 0,    -1, 0, 0, 0, 0},
    {I_OWUQI, (long)1024 * 2048, 2048, 1024, 0, 2048, (long)WS_OWUQ, 1024, 4096, -1, 0, 0, 0, 0},
    {I_OWUV, (long)512 * 4096, 4096, 512, 0, 4096, (long)WS_OWUV, 1024, 0, -1, 0, 0, 0, 1},
};

__device__ __forceinline__ void transpose_item(const Args& a, GAS unsigned char* ws, const TJob& jb, int L, int item, LAS float* scr, int lane) {
    const int ncb = (jb.ncols + 31) >> 5, kb = item / ncb, nb = item % ncb, k0 = 64 * kb, n0 = 32 * nb;
    const int li = jb.lsel ? L : (L >> 1);
    const GAS float* W = (const GAS float*)a.in[jb.in_id] + (size_t)li * jb.src_lstride;
    const GAS float* gain = jb.gain_id >= 0 ? (const GAS float*)a.in[jb.gain_id] + (size_t)li * jb.gain_lstride + jb.gain_off0 : nullptr;
    const int r8 = lane >> 3, c4 = lane & 7; const bool cv = (n0 + 4 * c4) < jb.ncols;
    f32x4 v[8];
    const GAS float* src = W + (size_t)(k0 + r8) * jb.ldsrc + jb.src_col0 + n0 + 4 * c4;
#pragma unroll
    for (int i = 0; i < 8; ++i) v[i] = cv ? __builtin_nontemporal_load((const GAS f32x4*)(src + (size_t)(8 * i) * jb.ldsrc)) : (f32x4){0.f, 0.f, 0.f, 0.f};
    const int c = lane & 7;
    f32x4 g0 = {1.f, 1.f, 1.f, 1.f}, g1 = g0;
    if (gain) { g0 = *(const GAS f32x4*)(gain + k0 + 8 * c); g1 = *(const GAS f32x4*)(gain + k0 + 8 * c + 4); }
#pragma unroll
    for (int i = 0; i < 8; ++i) { LAS float* d = scr + (8 * i + r8) * 33 + 4 * c4; d[0] = v[i][0]; d[1] = v[i][1]; d[2] = v[i][2]; d[3] = v[i][3]; }
    LDS_WAIT(); asm volatile("" ::: "memory");
    GAS bf16_t* WT = (GAS bf16_t*)(ws + jb.dst_off);
#pragma unroll
    for (int j = 0; j < 4; ++j) { const int n = (lane >> 3) + 8 * j; const LAS float* s = scr + (8 * c) * 33 + n;
        int drow = jb.dst_row0 + n0 + n, dk = k0 + 8 * c;
        if (jb.flags & 2) {
            u32x2 q; q.x = pack4_q8_(s[0 * 33] * g0[0] * W8_SCALE, s[1 * 33] * g0[1] * W8_SCALE, s[2 * 33] * g0[2] * W8_SCALE, s[3 * 33] * g0[3] * W8_SCALE);
            q.y = pack4_q8_(s[4 * 33] * g1[0] * W8_SCALE, s[5 * 33] * g1[1] * W8_SCALE, s[6 * 33] * g1[2] * W8_SCALE, s[7 * 33] * g1[3] * W8_SCALE);
            *(GAS u32x2*)((GAS unsigned char*)ws + jb.dst_off + (size_t)drow * jb.ldt + dk) = q; continue; }
        u32x4 o; o.x = cvtpk(s[0 * 33] * g0[0], s[1 * 33] * g0[1]); o.y = cvtpk(s[2 * 33] * g0[2], s[3 * 33] * g0[3]); o.z = cvtpk(s[4 * 33] * g1[0], s[5 * 33] * g1[1]); o.w = cvtpk(s[6 * 33] * g1[2], s[7 * 33] * g1[3]);
        if (jb.flags & 1) { const int col = n0 + n, h = col >> 7, d = col & 127; drow = (h >> 1) * 256 + (h & 1) * 128 + d; dk = (h & 1) * 512 + k0 + 8 * c; }
        *(GAS u32x4*)(WT + (size_t)drow * jb.ldt + dk) = o; }
    LDS_WAIT(); asm volatile("" ::: "memory");
}

__device__ __forceinline__ void convert_layer_weights(const Args& a, int L, LAS unsigned char* lds, int gw, int NGW, int wave) {
    const int lane = lane_id_();
    unsigned char* ws_ = a.ws; OPAQUE_S(ws_); GAS unsigned char* ws = (GAS unsigned char*)ws_;
    LAS float* scr = (LAS float*)(lds + wave * 16384);
    const bool odd = (L & 1) != 0; const int nj = odd ? NTJ_O : NTJ_E;
    int jstart = 0;
    for (int j = 0; j < nj; ++j) {
        const TJob jb = odd ? g_tj_odd[j] : g_tj_even[j];
        const int nitems = (jb.K >> 6) * ((jb.ncols + 31) >> 5);
        const int first = (gw - (jstart % NGW) + NGW) % NGW;
        for (int it = first; it < nitems; it += NGW) transpose_item(a, ws, jb, L, it, scr, lane);
        jstart += nitems;
    }
    if (!odd) {
        GAS u32x4* z = (GAS u32x4*)(ws + WS_EWIN + (size_t)12832 * 4096); const int n = 224 * 4096 / 16;
        for (int i = gw * 64 + lane; i < n; i += NGW * 64) z[i] = zero4_();
    } else {
        GAS u32x4* z2 = (GAS u32x4*)(ws + WS_OWIN + (size_t)1632 * 4096 * 2); const int n2 = 160 * 4096 * 2 / 16;
        for (int i = gw * 64 + lane; i < n2; i += NGW * 64) z2[i] = zero4_();
        GAS u32x4* z3 = (GAS u32x4*)(ws + WS_OWUV);
        for (int i = gw * 64 + lane; i < 4096 * 64; i += NGW * 64) { const int r = i >> 6, c16 = i & 63; const int zh = ((r >> 7) & 1) ^ 1; z3[(size_t)r * 128 + zh * 64 + c16] = zero4_(); }
        const GAS f32x4* s = (const GAS f32x4*)(((const GAS float*)a.in[I_OWUK]) + (size_t)(L >> 1) * 512 * 4096); GAS u32x2* d = (GAS u32x2*)(ws + WS_OWUK); const int n = 512 * 4096 / 4;
        for (int i = gw * 64 + lane; i < n; i += NGW * 64) { const f32x4 v = __builtin_nontemporal_load(s + i); d[i] = (u32x2){cvtpk(v[0], v[1]), cvtpk(v[2], v[3])}; }
    }
}

__device__ __forceinline__ void phase_convert(const Args& a, LAS unsigned char* lds, int gw, int NGW, int wave) {
    const int lane = lane_id_();
    unsigned char* ws_ = a.ws; OPAQUE_S(ws_); GAS unsigned char* ws = (GAS unsigned char*)ws_;
    {
        const GAS f32x4* s2 = (const GAS f32x4*)((const GAS float*)a.in[I_P]); GAS u32x2* d2 = (GAS u32x2*)(ws + WS_PB); const int n2 = 4 * M * 256 / 4;
        for (int i = gw * 64 + lane; i < n2; i += NGW * 64) { const f32x4 v = __builtin_nontemporal_load(s2 + i); d2[i] = (u32x2){cvtpk(v[0], v[1]), cvtpk(v[2], v[3])}; }
    }
    {
        const GAS float* x = ((const GAS float*)a.in[I_X]); GAS unsigned char* HQ = ws + WS_HQ; GAS float* asc = (GAS float*)(ws + WS_ASCALE); GAS u64* ss = (GAS u64*)(ws + WS_SUMSQ);
        for (int row = gw; row < M; row += NGW) {
            const GAS f32x4* xr = (const GAS f32x4*)(x + (size_t)row * DM); GAS unsigned* qr = (GAS unsigned*)(HQ + (size_t)row * DM); GAS u32x2* hr = (GAS u32x2*)(ws + WS_H + (size_t)row * DM * 2);
            f32x4 v[16]; float s = 0.f, am = 0.f;
#pragma unroll
            for (int j = 0; j < 16; ++j) { v[j] = xr[lane + 64 * j]; s += (v[j][0] * v[j][0] + v[j][1] * v[j][1]) + (v[j][2] * v[j][2] + v[j][3] * v[j][3]); am = fmaxf(fmaxf(am, fmaxf(fabsf(v[j][0]), fabsf(v[j][1]))), fmaxf(fabsf(v[j][2]), fabsf(v[j][3]))); }
            s = wave_sum(s);
#pragma unroll
            for (int o = 1; o < 64; o <<= 1) am = fmaxf(am, __shfl_xor(am, o));
            am = fmaxf(am, 1e-20f); const float qs = 127.0f / am;
#pragma unroll
            for (int j = 0; j < 16; ++j) { qr[lane + 64 * j] = pack4_q8_(v[j][0] * qs, v[j][1] * qs, v[j][2] * qs, v[j][3] * qs); hr[lane + 64 * j] = (u32x2){cvtpk(v[j][0], v[j][1]), cvtpk(v[j][2], v[j][3])}; }
            if (lane == 0) { ss[row] = ss_fix(s); asc[row] = am * (1.0f / 127.0f); }
        }
    }
}

__device__ __forceinline__ void phase_quant_yin(const Args& a, int gw, int NGW) {
    const int lane = lane_id_();
    unsigned char* ws_ = a.ws; OPAQUE_S(ws_); GAS unsigned char* ws = (GAS unsigned char*)ws_;
    const GAS bf16_t* yin = (const GAS bf16_t*)(ws + WS_YIN); GAS unsigned char* yq = ws + WS_YQ; GAS float* asc = (GAS float*)(ws + WS_ASCALEY);
    for (int row = gw; row < M; row += NGW) {
        const GAS u32x4* yr = (const GAS u32x4*)(yin + (size_t)row * DM); GAS u32x2* qr = (GAS u32x2*)(yq + (size_t)row * DM);
        u32x4 w[8]; float am = 0.f;
#pragma unroll
        for (int j = 0; j < 8; ++j) { w[j] = yr[lane + 64 * j];
            am = fmaxf(am, fmaxf(fmaxf(fmaxf(fabsf(bflo(w[j].x)), fabsf(bfhi(w[j].x))), fmaxf(fabsf(bflo(w[j].y)), fabsf(bfhi(w[j].y)))), fmaxf(fmaxf(fabsf(bflo(w[j].z)), fabsf(bfhi(w[j].z))), fmaxf(fabsf(bflo(w[j].w)), fabsf(bfhi(w[j].w)))))); }
#pragma unroll
        for (int o = 1; o < 64; o <<= 1) am = fmaxf(am, __shfl_xor(am, o));
        am = fmaxf(am, 1e-20f); const float qs = 127.0f / am;
#pragma unroll
        for (int j = 0; j < 8; ++j) { u32x2 q; q.x = pack4_q8_(bflo(w[j].x) * qs, bfhi(w[j].x) * qs, bflo(w[j].y) * qs, bfhi(w[j].y) * qs); q.y = pack4_q8_(bflo(w[j].z) * qs, bfhi(w[j].z) * qs, bflo(w[j].w) * qs, bfhi(w[j].w) * qs); qr[lane + 64 * j] = q; }
        if (lane == 0) asc[row] = am * (1.0f / 127.0f);
    }
}
__device__ __forceinline__ void phase_final(const Args& a, int gw, int NGW) {
    const int lane = lane_id_();
    unsigned char* ws_ = a.ws; OPAQUE_S(ws_); GAS unsigned char* ws = (GAS unsigned char*)ws_;
    const GAS bf16_t* H = (const GAS bf16_t*)(ws + WS_H); const GAS u64* ss = (const GAS u64*)(ws + WS_SUMSQ) + 4 * M; const GAS f32x4* g = (const GAS f32x4*)((const GAS float*)a.in[I_FINALG]);
    for (int row = gw; row < M; row += NGW) {
        const float r = 1.0f / sqrtf((float)ss[row] * (1.0f / 16777216.0f) * (1.0f / 4096.0f) + EPS);
        const GAS u32x2* hr = (const GAS u32x2*)(H + (size_t)row * DM); GAS f32x4* orow = (GAS f32x4*)(a.out + (size_t)row * DM);
#pragma unroll 4
        for (int j = 0; j < 16; ++j) { const u32x2 hw = hr[lane + 64 * j]; const f32x4 v = (f32x4){bflo(hw.x), bfhi(hw.x), bflo(hw.y), bfhi(hw.y)}, gg = g[lane + 64 * j]; orow[lane + 64 * j] = v * r * gg; }
    }
}

__global__ void __launch_bounds__(512, 2) fwd(Args args) {
    extern __shared__ __attribute__((aligned(16))) unsigned char lds_raw[];
    LAS unsigned char* lds = (LAS unsigned char*)lds_raw;
    volatile LAS unsigned* MISC = (volatile LAS unsigned*)(lds + MISC_OFF);
    const int wave0 = __builtin_amdgcn_readfirstlane((int)threadIdx.x >> 6);
    if (wave0 == 0) { const int l_ = lane_id_(); MISC[l_] = (l_ == 16) ? (unsigned)gridDim.x : (l_ == 17) ? (unsigned)blockIdx.x : (l_ == 18) ? (unsigned)args.ph_lo : (l_ == 19) ? (unsigned)args.ph_hi : 0u; }
    __syncthreads();
#define KS_RD(i) ((int)__builtin_amdgcn_readfirstlane((int)*(volatile LAS unsigned*)(size_t)(opaque_vu_((unsigned)MISC_OFF) + 4u * (i))))
#define KS_G0 KS_RD(16)
#define KS_BX0 KS_RD(17)
#define KS_LO KS_RD(18)
#define KS_HI KS_RD(19)
    if (KS_HI - KS_LO > 1) (void)xcd_barrier_post((unsigned*)(args.ws + WS_CTL), MISC + 8, wave0);
#define IN(k) (KS_LO <= (k) && (k) < KS_HI)
#define PHASE_LOCALS() int wave = wave0, G = KS_G0, bx = KS_BX0; asm volatile("" : "+s"(wave), "+s"(G), "+s"(bx)); const int gw = bx * 8 + wave, NGW = G * 8; (void)gw; (void)NGW; \
        unsigned char* ws = args.ws; OPAQUE_S(ws); u64* sumsq = (u64*)(ws + WS_SUMSQ); (void)sumsq; \
        bf16_t* hb_cur = (bf16_t*)(ws + (hbswap ? WS_HBB : WS_HBA)); bf16_t* hb_oth = (bf16_t*)(ws + (hbswap ? WS_HBA : WS_HBB)); (void)hb_cur; (void)hb_oth
#undef SEAM
#define SEAM(k) do { if (IN(k) && IN((k) + 1)) { int wave = wave0; asm volatile("" : "+s"(wave)); unsigned char* _w = args.ws; OPAQUE_S(_w); XcdBarrier _b; _b.bar = (unsigned*)(_w + WS_CTL); _b.x = xb_xcc_id(); _b.st = (volatile LAS unsigned*)(lds + MISC_OFF) + 8; xcd_barrier(_b, wave); } } while (0)
    for (int L = -1; L < 4; ++L) {
        const int base = 10 * (L + 1); const bool odd = L >= 0 && (L & 1) != 0;
        const bool mixed = MK_STAGE >= (odd ? 3 : 2);
        const bool hbswap = (MK_STAGE < 3) && ((MK_STAGE == 1 && (L & 1)) || (MK_STAGE == 2 && L >= 2));
        if (IN(base + 0) && mixed && L >= 0)
#pragma unroll 1
        for (int rep_ = 0; rep_ < (((MK_DUP & (1024 | (1 << 26))) && !odd) || ((MK_DUP & 2048) && odd) ? 2 : 1); ++rep_) {
            PHASE_LOCALS();
            if (odd) {
                {
                    pg8::Gemm g{(const bf16_t*)(ws + WS_HQ), (const bf16_t*)(ws + WS_OWIN8), DM, DM, DM, 32, 16, 1, 0, 0};
                    pg8::Sched S; S.init(g, G, bx);
                    pg8::EpiBf16Q E{(bf16_t*)(ws + WS_PROJ), ON, sumsq + L * M, (const float*)(ws + WS_ASCALE), nullptr, 0};
                    pg8::gemm_phase<pg8::EpiBf16Q, true>(lds, g, S, E, wave); }
                {
                    PHASE_LOCALS();
                    pg8::Gemm g{(const bf16_t*)(ws + WS_H), (const bf16_t*)(ws + WS_OWIN), DM, DM, DM, 32, 7, 1, 0, 0};
                    pg8::Sched S; S.init(g, G, bx);
                    pg8::EpiBf16 E{(bf16_t*)(ws + WS_PROJ) + 4096, ON, 0, sumsq + L * M};
                    pg8::gemm_phase(lds, g, S, E, wave); }
            } else {
                pg8::Gemm g{(const bf16_t*)(ws + WS_HQ), (const bf16_t*)(ws + WS_EWIN), DM, DM, DM, 32, EN / 256, 1, 0, 0};
                pg8::Sched S; S.init(g, G, bx);
                pg8::EpiBf16Q E{(bf16_t*)(ws + WS_PROJ), EN, sumsq + L * M, (const float*)(ws + WS_ASCALE), (u64*)(ws + WS_KN) + (size_t)(L >> 1) * 16 * M, ((MK_DUP & (1 << 26)) && rep_ == 0) ? 1 : 0};
                pg8::gemm_phase<pg8::EpiBf16Q, true>(lds, g, S, E, wave);
            }
        }
        if (L >= 0) SEAM(base + 0);
        if (IN(base + 1)) {
            PHASE_LOCALS();
            if (mixed && !odd && L >= 0) { phase_even_attn(args, L >> 1, lds, G, bx, wave, 3); if (MK_DUP & 1) phase_even_attn(args, L >> 1, lds, G, bx, wave, 3); if (MK_DUP & 32) phase_even_attn(args, L >> 1, lds, G, bx, wave, 1); if (MK_DUP & 64) phase_even_attn(args, L >> 1, lds, G, bx, wave, 2); }
            if (mixed && odd) for (int rep_ = 0; rep_ < ((MK_DUP & 65536) ? 2 : 1); ++rep_) phase_odd_norms(args, L >> 1, gw, NGW);
            __syncthreads();
            if (L < 0) for (int rep_ = 0; rep_ < ((MK_DUP & 262144) ? 2 : 1); ++rep_) phase_convert(args, lds, gw, NGW, wave);
            if (L < 3) for (int rep = 0; rep < ((MK_DUP & 8) ? 2 : 1); ++rep) convert_layer_weights(args, L + 1, lds, gw, NGW, wave);
            __syncthreads();
        }
        SEAM(base + 1);
        if (mixed && odd) {
            if (IN(base + 2))
#pragma unroll 1
            for (int rep_ = 0; rep_ < ((MK_DUP & 4096) ? 2 : 1); ++rep_) {
                PHASE_LOCALS();
                pg8::Gemm g{(const bf16_t*)(ws + WS_CQN), (const bf16_t*)(ws + WS_OWUQ), 1024, 1024, 1024, 32, QW / 256, 1, 0, 0};
                pg8::Sched S; S.init(g, G, bx);
                pg8::EpiBf16 E{(bf16_t*)(ws + WS_QBUF), QW, 0, nullptr};
                pg8::gemm_phase(lds, g, S, E, wave);
            }
            SEAM(base + 2);
            if (IN(base + 3)) {
#pragma unroll 1
                for (int rep_ = 0; rep_ < ((MK_DUP & 8192) ? 2 : 1); ++rep_) { PHASE_LOCALS();
                  pg8::Gemm g{(const bf16_t*)(ws + WS_QBUF), (const bf16_t*)(ws + WS_OWUK), QW, 4096, 128, 32, 2, 32, 128, 128};
                  pg8::Sched S; S.init(g, G, bx);
                  pg8::EpiBf16 E{(bf16_t*)(ws + WS_QABS), 16384, 512, nullptr};
                  pg8::gemm_phase(lds, g, S, E, wave); }
                { PHASE_LOCALS(); if (MK_DUP & 128) phase_indexer(args, lds, G, bx, wave, false); phase_indexer(args, lds, G, bx, wave, true); if (MK_DUP & 2) phase_indexer(args, lds, G, bx, wave, true); }
            }
            SEAM(base + 3);
            if (IN(base + 4)) { PHASE_LOCALS(); phase_dsa(args, lds, G, bx, wave, 0); if (MK_DUP & 4) phase_dsa(args, lds, G, bx, wave, 0); }
            SEAM(base + 4);
            if (IN(base + 5))
#pragma unroll 1
            for (int rep_ = 0; rep_ < ((MK_DUP & 16384) ? 2 : 1); ++rep_) {
                PHASE_LOCALS();
                pg8::Gemm g{(const bf16_t*)(ws + WS_OLAT), (const bf16_t*)(ws + WS_OWUV), 16384, 1024, 1024, 32, 1, 16, 1024, (size_t)256 * 1024};
                pg8::Sched S; S.init(g, G, bx);
                pg8::EpiOGate E{(bf16_t*)(ws + WS_YIN), (const bf16_t*)(ws + WS_PROJ) + O_GC, ON};
                pg8::gemm_phase(lds, g, S, E, wave);
            }
            SEAM(base + 5);
        }
        const int phq = odd ? base + 6 : base + 2, ph5 = phq + 1, ph6 = ph5 + 1;
        if (IN(phq) && L >= 0) for (int rep_ = 0; rep_ < ((MK_DUP & 32768) ? 2 : 1); ++rep_) { PHASE_LOCALS(); phase_quant_yin(args, gw, NGW); }
        if (L >= 0) SEAM(phq);
        if (IN(ph5) && L >= 0) {
            if (mixed) {
                PHASE_LOCALS();
                pg8::Gemm g{(const bf16_t*)(ws + WS_YQ), (const bf16_t*)(ws + (odd ? WS_OWOUT : WS_EWOUT)), DM, DM, DM, 32, 16, 1, 0, 0};
                pg8::Sched S; S.init(g, G, bx);
                pg8::EpiResid E{(const bf16_t*)(ws + WS_H), (bf16_t*)(ws + WS_H), (signed char*)(ws + WS_HBB), (float*)(ws + WS_ASCALE1), sumsq + L * M, sumsq + (5 + L) * M, (const float*)(ws + WS_ASCALEY)};
                pg8::gemm_phase<pg8::EpiResid, true>(lds, g, S, E, wave);
            }
#pragma unroll 1
            for (int rep_ = 0; rep_ < ((MK_DUP & 131072) ? 2 : 1); ++rep_) {
                PHASE_LOCALS();
                pg8::Gemm g{(const bf16_t*)(ws + WS_PB) + (size_t)L * M * 256, (const bf16_t*)(ws + (odd ? WS_OPROJ : WS_EPROJ)), 256, 256, 256, 32, 16, 1, 0, 0};
                pg8::Sched S; S.init(g, G, bx);
                pg8::EpiBf16 E{(bf16_t*)(ws + WS_PP), DM, 0, nullptr};
                pg8::gemm_phase(lds, g, S, E, wave);
            }
        }
        if (L >= 0) SEAM(ph5);
        if (IN(ph6) && L >= 0) {
            PHASE_LOCALS();
            pg8::Gemm g{(const bf16_t*)(ws + WS_HBB), (const bf16_t*)(ws + (odd ? WS_OGATE : WS_EGATE)), DM, DM, DM, 32, 16, 1, 0, 0};
            pg8::Sched S; S.init(g, G, bx);
            pg8::EpiGate E{(bf16_t*)(ws + WS_H), (const bf16_t*)(ws + WS_PP), sumsq + (mixed ? (5 + L) : L) * M, sumsq + (L + 1) * M, (L < 3) ? (signed char*)(ws + WS_HQ) : nullptr, (float*)(ws + WS_ASCALE), (const float*)(ws + WS_ASCALE1)};
            pg8::gemm_phase<pg8::EpiGate, true>(lds, g, S, E, wave);
        }
        if (L >= 0) SEAM(ph6);
    }
    if (IN(PH_FINAL)) for (int rep_ = 0; rep_ < ((MK_DUP & 524288) ? 2 : 1); ++rep_) phase_final(args, KS_BX0 * 8 + wave0, KS_G0 * 8);
#undef IN
#undef SEAM
}

extern "C" void kernel_launch(void* const* d_in, const int* in_sizes, int n_in, void* d_out, int out_size, void* d_ws, size_t ws_size, hipStream_t stream) {
    static int grid = 0;
    if (grid == 0) {
        if (n_in != 22 || out_size != M * DM || ws_size < WS_END) { fprintf(stderr, "kernel_launch: unexpected shapes (n_in %d out %d ws %zu, need %zu)\n", n_in, out_size, ws_size, (size_t)WS_END); grid = -1; return; }
        int dev = 0, cus = 0, per_cu = 0;
        if (hipGetDevice(&dev) != hipSuccess || hipDeviceGetAttribute(&cus, hipDeviceAttributeMultiprocessorCount, dev) != hipSuccess) { grid = -1; return; }
        if (hipFuncSetAttribute((const void*)fwd, hipFuncAttributeMaxDynamicSharedMemorySize, LDS_BYTES) != hipSuccess) { fprintf(stderr, "kernel_launch: hipFuncSetAttribute failed\n"); grid = -1; return; }
        if (hipOccupancyMaxActiveBlocksPerMultiprocessor(&per_cu, (const void*)fwd, 512, LDS_BYTES) != hipSuccess || per_cu < 1) { fprintf(stderr, "kernel_launch: occupancy query says %d\n", per_cu); }
        (void)hipGetLastError();
        grid = cus;
    }
    if (grid < 0) return;
    if (hipMemsetAsync((char*)d_ws + WS_CTL, 0, WS_ZERO_BYTES, stream) != hipSuccess) return;
    Args a{};
    for (int i = 0; i < 22; ++i) a.in[i] = (const float*)d_in[i];
    a.out = (float*)d_out; a.ws = (unsigned char*)d_ws;
#if MK_ONE_LAUNCH
    a.ph_lo = 0; a.ph_hi = NPH;
    hipLaunchKernelGGL(fwd, dim3(grid), dim3(512), LDS_BYTES, stream, a);
#else
    for (int ph = 0; ph < NPH; ++ph) {
        if (ph < PH_FINAL) { const int L = ph / 10 - 1, k = ph % 10; if (L < 0 && k != 1) continue; if (L >= 0 && !(L & 1) && k >= 5) continue; if (L >= 0 && (L & 1) && k >= 9) continue; }
        a.ph_lo = ph; a.ph_hi = ph + 1;
        hipLaunchKernelGGL(fwd, dim3(grid), dim3(512), LDS_BYTES, stream, a);
    }
#endif
}
```

```cpp
#include <hip/hip_runtime.h>
#include <cstdio>
#include <cstdint>

#define LAS __attribute__((address_space(3)))
#define GAS __attribute__((address_space(1)))
typedef unsigned short bf16_t;
typedef short bf16x8 __attribute__((ext_vector_type(8)));
typedef short s16x4 __attribute__((ext_vector_type(4)));
typedef short v4i16_t __attribute__((ext_vector_type(4)));
typedef float f32x2 __attribute__((ext_vector_type(2)));
typedef float f32x4 __attribute__((ext_vector_type(4)));
typedef float f32x16 __attribute__((ext_vector_type(16)));
typedef unsigned u32x2 __attribute__((ext_vector_type(2)));
typedef unsigned u32x4 __attribute__((ext_vector_type(4)));
typedef __bf16 bf16x2_t __attribute__((ext_vector_type(2)));
typedef GAS unsigned gu32;

#ifndef MK_STAGE
#define MK_STAGE 3
#endif
#ifndef MK_DUP
#define MK_DUP 0
#endif
#ifndef MK_ONE_LAUNCH
#define MK_ONE_LAUNCH 1
#endif

constexpr int M = 8192, DM = 4096, SEQ = 4096;
constexpr float EPS = 1e-6f;
constexpr float LOG2E = 1.4426950408889634f;
constexpr int EN = 13056;
constexpr int ON = 5888;
constexpr int E_QA = 0, E_KA = 2048, E_VA = 4096, E_GA = 6144, E_QB = 8192, E_GB = 10240, E_KB = 12288, E_VB = 12544, E_FA = 12800;
constexpr int O_GC = 0, O_CQ = 4096, O_CKV = 5120, O_KIDX = 5632, O_WIDX = 5696;
constexpr int QW = 6144;

constexpr size_t MiB = 1u << 20;
constexpr size_t WS_CTL = 0;
constexpr size_t WS_SUMSQ = 1 * MiB;
constexpr size_t WS_KN = 2 * MiB;
constexpr size_t WS_ZERO_BYTES = 4 * MiB;
constexpr size_t SZ_SQ = (size_t)4096 * 4096 * 2;
constexpr size_t SZ_WPROJ = (size_t)4096 * 256 * 2;
constexpr size_t WS_EWIN = 4 * MiB;
constexpr size_t WS_EWOUT = WS_EWIN + (size_t)EN * 4096 * 2;
constexpr size_t WS_EGATE = WS_EWOUT + SZ_SQ;
constexpr size_t WS_EPROJ = WS_EGATE + SZ_SQ;
constexpr size_t WS_OWIN = WS_EPROJ + SZ_WPROJ;
constexpr size_t WS_OWIN8 = WS_OWIN + (size_t)1792 * 4096 * 2;
constexpr size_t WS_OWUQ = WS_OWIN + (size_t)ON * 4096 * 2;
constexpr size_t WS_OWUK = WS_OWUQ + (size_t)QW * 1024 * 2;
constexpr size_t WS_OWUV = WS_OWUK + (size_t)512 * 4096 * 2;
constexpr size_t WS_OWOUT = WS_OWUV + (size_t)16 * 256 * 1024 * 2;
constexpr size_t WS_OGATE = WS_OWOUT + SZ_SQ;
constexpr size_t WS_OPROJ = WS_OGATE + SZ_SQ;
constexpr size_t WS_H = WS_OPROJ + SZ_WPROJ;
constexpr size_t WS_HBA = WS_H + (size_t)M * 4096 * 4;
constexpr size_t SZ_ACT = (size_t)M * 4096 * 2;
constexpr size_t WS_HBB = WS_HBA + SZ_ACT;
constexpr size_t WS_YIN = WS_HBB + SZ_ACT;
constexpr size_t WS_SCORE = WS_YIN;
constexpr size_t WS_PP = WS_YIN + SZ_ACT;
constexpr size_t WS_PB = WS_PP + SZ_ACT;
constexpr size_t WS_PROJ = WS_PB + (size_t)4 * M * 256 * 2;
constexpr size_t WS_CQN = WS_PROJ + (size_t)M * EN * 2;
constexpr size_t WS_LAT = WS_CQN + (size_t)M * 1024 * 2;
constexpr size_t WS_KIDX = WS_LAT + (size_t)M * 512 * 2;
constexpr size_t WS_WIDX = WS_KIDX + (size_t)M * 64 * 2;
constexpr size_t WS_SEL = WS_WIDX + (size_t)M * 32 * 4;
constexpr size_t WS_QBUF = WS_SEL + (size_t)M * 256 * 4;
constexpr size_t WS_QABS = WS_QBUF + (size_t)M * QW * 2;
constexpr size_t WS_OLAT = WS_QABS + (size_t)M * 16384 * 2;
constexpr size_t WS_HQ = WS_OLAT + (size_t)M * 16384 * 2;
constexpr size_t WS_ASCALE = WS_HQ + (size_t)M * 4096;
constexpr size_t WS_ASCALE1 = WS_ASCALE + (size_t)M * 4;
constexpr size_t WS_ASCALEY = WS_ASCALE1 + (size_t)M * 4;
constexpr size_t WS_YQ = WS_PROJ;
constexpr size_t WS_END = WS_ASCALEY + (size_t)M * 4;
static_assert(WS_END <= (size_t)4 * 2 * 4096 * 12816 * 4, "workspace map exceeds the guaranteed size (4 x the largest input)");

constexpr int LDS_BYTES = 155648;
constexpr int MISC_OFF = LDS_BYTES - 256;

__device__ __forceinline__ unsigned cvtpk(float lo, float hi) { f32x2 v = {lo, hi}; bf16x2_t b = __builtin_convertvector(v, bf16x2_t); return __builtin_bit_cast(unsigned, b); }
__device__ __forceinline__ float bf2f(unsigned short b) { return __uint_as_float(((unsigned)b) << 16); }
__device__ __forceinline__ float bflo(unsigned w) { return __uint_as_float(w << 16); }
__device__ __forceinline__ float bfhi(unsigned w) { return __uint_as_float(w & 0xffff0000u); }
__device__ __forceinline__ float wave_sum(float v) {
#pragma unroll
    for (int o = 1; o < 64; o <<= 1) v += __shfl_xor(v, o);
    return v;
}
__device__ __forceinline__ float xhalf_max(float m) { auto rr = __builtin_amdgcn_permlane32_swap(__float_as_uint(m), __float_as_uint(m), false, false); return fmaxf(__uint_as_float(rr[0]), __uint_as_float(rr[1])); }
__device__ __forceinline__ float xhalf_sum(float m) { auto rr = __builtin_amdgcn_permlane32_swap(__float_as_uint(m), __float_as_uint(m), false, false); return __uint_as_float(rr[0]) + __uint_as_float(rr[1]); }
__device__ __forceinline__ int lane_id_() { int l = (int)__builtin_amdgcn_mbcnt_hi(~0u, __builtin_amdgcn_mbcnt_lo(~0u, 0u)); asm volatile("" : "+v"(l)); return l; }
typedef unsigned long long u64;
__device__ __forceinline__ u64 ss_fix(float s2) { return (u64)(s2 * 16777216.0f); }
__device__ __forceinline__ float ss_rstd(u64 v) { return __builtin_amdgcn_rsqf((float)v * (1.0f / 16777216.0f) * (1.0f / 4096.0f) + EPS); }
__device__ __forceinline__ unsigned opaque_vu_(unsigned v) { asm volatile("" : "+v"(v)); return v; }
__device__ __forceinline__ u32x4 zero4_() { unsigned z = 0u; asm volatile("" : "+v"(z)); return (u32x4){z, z, z, z}; }
typedef int i32x4 __attribute__((ext_vector_type(4)));
constexpr float W8_SCALE = 1354.0f;
__device__ __forceinline__ int q8_(float v) { const int q = (int)__builtin_rintf(v); return q < -127 ? -127 : (q > 127 ? 127 : q); }
__device__ __forceinline__ unsigned pack4_q8_(float a, float b, float c, float d) { return (unsigned)(q8_(a) & 255) | ((unsigned)(q8_(b) & 255) << 8) | ((unsigned)(q8_(c) & 255) << 16) | ((unsigned)(q8_(d) & 255) << 24); }
__device__ __forceinline__ float fast_exp2(float x) { return __builtin_amdgcn_exp2f(x); }
__device__ __forceinline__ float sigmoidf_(float x) { return 1.0f / (1.0f + __expf(-x)); }
__device__ __forceinline__ float siluf_(float x) { return x / (1.0f + __expf(-x)); }
#define OPAQUE_S(p) do { unsigned long long _v = (unsigned long long)(p); unsigned _lo = (unsigned)_v, _hi = (unsigned)(_v >> 32); asm volatile("" : "+v"(_lo), "+v"(_hi)); \
    _lo = __builtin_amdgcn_readfirstlane(_lo); _hi = __builtin_amdgcn_readfirstlane(_hi); (p) = (decltype(p))(((unsigned long long)_hi << 32) | _lo); } while (0)
#define G1(T, p) ((GAS T*)(p))
#define LDS_WAIT() asm volatile("s_waitcnt lgkmcnt(0)" ::: "memory")
#define VM_WAIT() asm volatile("s_waitcnt vmcnt(0)" ::: "memory")

#define XB_TMO      128
#define XB_XCNT(j)  (256  + 64 * (j))
#define XB_XSUB(j)  (1280 + 64 * (j))
#define XB_XGEN(j)  (2304 + 64 * (j))
#define XB_TOP      3328
#define XB_TOPGEN   3392
#define XCD_BAR_WORDS 3456
#define XB_SPIN_CAP (1u << 22)
__device__ __forceinline__ unsigned xb_ld(unsigned* p)              { return __hip_atomic_load((gu32*)p, __ATOMIC_RELAXED, __HIP_MEMORY_SCOPE_AGENT); }
__device__ __forceinline__ unsigned xb_add(unsigned* p, unsigned v) { return __hip_atomic_fetch_add((gu32*)p, v, __ATOMIC_RELAXED, __HIP_MEMORY_SCOPE_AGENT); }
__device__ __forceinline__ unsigned xb_xcc_id() { return (unsigned)__builtin_amdgcn_s_getreg((3 << 11) | 20) & 0xFu; }
#define XB_SPIN(cond, bar) do { unsigned _sp = 0; while (cond) { __builtin_amdgcn_s_sleep(1); \
    if ((++_sp & 255u) == 0u) { if (xb_ld(&(bar)[XB_TMO])) break; if (_sp > XB_SPIN_CAP) { (void)xb_add(&(bar)[XB_TMO], 1u); break; } } } } while (0)
struct XcdBarrier { unsigned* bar; unsigned x; volatile LAS unsigned* st; };
__device__ __forceinline__ XcdBarrier xcd_barrier_post(unsigned* bar, volatile LAS unsigned* st, const int wave) {
    XcdBarrier b; b.bar = bar; b.x = xb_xcc_id(); b.st = st;
    if (wave == 0 && lane_id_() == 0) (void)xb_add(&bar[XB_XCNT(b.x)], 1u);
    return b;
}
__device__ __forceinline__ void xcd_barrier_complete(unsigned* bar, unsigned x, unsigned& nloc, unsigned& nx) {
    const unsigned G = gridDim.x * gridDim.y * gridDim.z;
    unsigned sum, cnt, mine, sp = 0u;
    for (;;) {
        sum = 0u; cnt = 0u; mine = 0u;
#pragma unroll 1
        for (unsigned j = 0; j < 16; ++j) { const unsigned c = xb_ld(&bar[XB_XCNT(j)]); sum += c; cnt += (c > 0u) ? 1u : 0u; mine = (j == x) ? c : mine; }
        if (sum == G) break;
        __builtin_amdgcn_s_sleep(1);
        if ((++sp & 255u) == 0u) { if (xb_ld(&bar[XB_TMO])) break; if (sp > XB_SPIN_CAP) { (void)xb_add(&bar[XB_TMO], 1u); break; } }
    }
    nloc = mine > 0u ? mine : 1u; nx = cnt > 0u ? cnt : 1u;
}
__device__ __forceinline__ void xcd_barrier(const XcdBarrier& b, const int wave) {
    asm volatile("s_waitcnt vmcnt(0)" ::: "memory");
    __syncthreads();
    if (wave == 0 && lane_id_() == 0) {
        unsigned* bar = b.bar;
        __builtin_amdgcn_s_waitcnt(0);
        unsigned nloc = b.st[0], nx = b.st[1];
        if (nloc == 0u) { xcd_barrier_complete(bar, b.x, nloc, nx); b.st[0] = nloc; b.st[1] = nx; }
        const unsigned old = xb_add(&bar[XB_XSUB(b.x)], 1u);
        const unsigned gen = old / nloc;
        if (old + 1u == (gen + 1u) * nloc) {
            __builtin_amdgcn_fence(__ATOMIC_RELEASE, "agent");
            asm volatile("s_waitcnt vmcnt(0)" ::: "memory");
            const unsigned og = xb_add(&bar[XB_TOP], 1u);
            const unsigned tg = og / nx;
            if (og + 1u == (tg + 1u) * nx) xb_add(&bar[XB_TOPGEN], 1u);
            else XB_SPIN(xb_ld(&bar[XB_TOPGEN]) == tg, bar);
            __builtin_amdgcn_fence(__ATOMIC_ACQUIRE, "agent");
            xb_add(&bar[XB_XGEN(b.x)], 1u);
            asm volatile("s_waitcnt vmcnt(0)" ::: "memory");
        } else {
            XB_SPIN(xb_ld(&bar[XB_XGEN(b.x)]) == gen, bar);
            __builtin_amdgcn_fence(__ATOMIC_ACQUIRE, "agent");
            asm volatile("s_waitcnt vmcnt(0)" ::: "memory");
        }
    }
    __syncthreads();
}

namespace pg8 {
__device__ __forceinline__ void glds16_s(const void* sbase, unsigned voff, unsigned lds_dst) {
    unsigned keep;
    asm volatile("s_mov_b32 %0, m0\n\ts_mov_b32 m0, %3\n\ts_nop 0\n\tglobal_load_lds_dwordx4 %1, %2\n\ts_mov_b32 m0, %0" : "=&s"(keep) : "v"(voff), "s"(sbase), "s"(lds_dst) : "memory");
}
constexpr int BM = 256, BK = 64, HALF = 128, HTB = HALF * BK * 2, STAGE_BYTES = 8 * HTB, NXCD = 8, WGM = 8;
__host__ __device__ __forceinline__ int lds_byte(int r, int c) { const int st = (r >> 4) * 2 + (c >> 5), rr = r & 15, cc = c & 31, ob = rr * 64 + cc * 2; return st * 1024 + (ob ^ (((ob >> 9) & 1) << 5)); }
__host__ __device__ __forceinline__ void stage_rc(int b, int& R, int& C) { const int st = b / 1024, sb = b % 1024, swz = sb ^ (((sb >> 9) & 1) << 5); R = (st >> 1) * 16 + swz / 64; C = (st & 1) * 32 + (swz % 64) / 2; }
__host__ __device__ __forceinline__ int perm32(int rho) { const int n = rho >> 4, i = rho & 15; return 8 * (i >> 2) + 4 * n + (i & 3); }

struct Unit { int pm, pn, g; };
struct Gemm { const bf16_t* A; const bf16_t* Bt; int lda, ldb, K, nM, nN, ng; size_t gsA, gsB; };

struct Sched {
    int nM, nN, nwg, total, G, c;
    __device__ void init(const Gemm& g, int G_, int c_) { nM = g.nM; nN = g.nN; nwg = nM * nN; total = nwg * g.ng; G = G_; c = c_; }
    __device__ bool next(int i, Unit& u) const {
        const long L = (long)i * G + c; if (L >= total) return false;
        u.g = (int)(L / nwg); int wgid = (int)(L % nwg);
        { const int q = nwg / NXCD, r = nwg % NXCD, xcd = wgid % NXCD, off = wgid / NXCD; wgid = (xcd < r ? xcd * (q + 1) : r * (q + 1) + (xcd - r) * q) + off; }
        const int nig = WGM * nN, gid = wgid / nig, fm = gid * WGM, gsz = (nM - fm) < WGM ? (nM - fm) : WGM;
        u.pm = fm + ((wgid % nig) % gsz); u.pn = (wgid % nig) / gsz; return true;
    }
};

template <class Epi, bool I8 = false>
__device__ __forceinline__ void gemm_phase(LAS unsigned char* lds, const Gemm g, const Sched& S, const Epi& E, const int wid) {
    const int lane = lane_id_(), tid = wid * 64 + lane;
    const int wr = wid >> 2, wc = wid & 3, fr = lane & 15, fq = lane >> 4;
    const bf16_t* gA = g.A; const bf16_t* gB = g.Bt; OPAQUE_S(gA); OPAQUE_S(gB);
    constexpr int ESZ = I8 ? 1 : 2;
    const int K = g.K, nt = K * ESZ / (BK * 2);
    unsigned voffA[2], voffB[2];
#pragma unroll
    for (int i = 0; i < 2; ++i) { int R, C; stage_rc(tid * 16 + i * 8192, R, C); const int Rb = (R & ~31) + perm32(R & 31);
        voffA[i] = (unsigned)(R * g.lda * ESZ + C * 2); voffB[i] = (unsigned)(Rb * g.ldb * ESZ + C * 2); }
    const size_t kstep = (size_t)(BK * 2);
    const size_t hstepA = (size_t)HALF * g.lda * ESZ, hstepB = (size_t)HALF * g.ldb * ESZ;
    const size_t tstepA = 2 * hstepA, tstepB = 2 * hstepB;
    const unsigned ldsbase = (unsigned)(size_t)lds + (unsigned)wid * 1024u;
    const int aoff = lds_byte(wr * 64 + fr, fq * 8), boff = lds_byte(wc * 32 + fr, fq * 8);
#define PG8_SA(b, h) (((b) * 2 + (h)) * HTB)
#define PG8_SB(b, h) ((4 + (b) * 2 + (h)) * HTB)
#define PG8_STAGE(bufoff, gbase, voff) do { _Pragma("unroll") for (int _i = 0; _i < 2; ++_i) glds16_s((const void*)(gbase), (voff)[_i], ldsbase + (unsigned)((bufoff) + _i * 8192)); } while (0)
#define PG8_LDA(dst, b, h) do { _Pragma("unroll") for (int m = 0; m < 4; ++m) _Pragma("unroll") for (int k = 0; k < 2; ++k) dst[m][k] = *(const LAS bf16x8*)(lds + PG8_SA(b, h) + aoff + m * 2048 + k * 1024); } while (0)
#define PG8_LDB(dst, b, h) do { _Pragma("unroll") for (int n = 0; n < 2; ++n) _Pragma("unroll") for (int k = 0; k < 2; ++k) dst[n][k] = *(const LAS bf16x8*)(lds + PG8_SB(b, h) + boff + n * 2048 + k * 1024); } while (0)
#define PG8_MMA(ai, bj, At, Bt) do { __builtin_amdgcn_s_setprio(1); _Pragma("unroll") for (int m = 0; m < 4; ++m) _Pragma("unroll") for (int n = 0; n < 2; ++n) _Pragma("unroll") for (int k = 0; k < 2; ++k) { \
        if constexpr (I8) acc[ai][bj][m][n] = __builtin_bit_cast(f32x4, __builtin_amdgcn_mfma_i32_16x16x64_i8(__builtin_bit_cast(i32x4, Bt[n][k]), __builtin_bit_cast(i32x4, At[m][k]), __builtin_bit_cast(i32x4, acc[ai][bj][m][n]), 0, 0, 0)); \
        else acc[ai][bj][m][n] = __builtin_amdgcn_mfma_f32_16x16x32_bf16(Bt[n][k], At[m][k], acc[ai][bj][m][n], 0, 0, 0); } __builtin_amdgcn_s_setprio(0); } while (0)
#define PG8_WAIT_V(n) asm volatile("s_waitcnt vmcnt(" #n ")" ::: "memory")
#define PG8_WAIT_L(n) asm volatile("s_waitcnt lgkmcnt(" #n ")" ::: "memory")
#define PG8_BAR __builtin_amdgcn_s_barrier()
#define PG8_SCHED __builtin_amdgcn_sched_barrier(0)
    Unit cur, nxt; int ui = 0;
    if (!S.next(0, cur)) return;
    f32x4 acc[2][2][4][2];
#pragma unroll
    for (int a = 0; a < 2; ++a)
#pragma unroll
        for (int b = 0; b < 2; ++b)
#pragma unroll
            for (int m = 0; m < 4; ++m)
#pragma unroll
                for (int n = 0; n < 2; ++n) acc[a][b][m][n] = (f32x4){0.f, 0.f, 0.f, 0.f};
    bf16x8 At[4][2], B0[2][2], B1[2][2];
    const char* cA = (const char*)(gA + (size_t)cur.g * g.gsA) + (size_t)cur.pm * tstepA; const char* cB = (const char*)(gB + (size_t)cur.g * g.gsB) + (size_t)cur.pn * tstepB;
    PG8_STAGE(PG8_SB(0, 0), cB, voffB); PG8_STAGE(PG8_SB(0, 1), cB + hstepB, voffB); PG8_STAGE(PG8_SA(0, 0), cA, voffA); PG8_STAGE(PG8_SA(0, 1), cA + hstepA, voffA);
    if (wr == 1) PG8_BAR;
    PG8_WAIT_V(2); PG8_BAR;
    PG8_STAGE(PG8_SB(1, 0), cB + kstep, voffB); PG8_STAGE(PG8_SA(1, 0), cA + kstep, voffA); PG8_STAGE(PG8_SB(1, 1), cB + hstepB + kstep, voffB);
    PG8_WAIT_V(6); PG8_BAR;
    for (;;) {
        const bool has_next = S.next(ui + 1, nxt);
        const char* nA = has_next ? (const char*)(gA + (size_t)nxt.g * g.gsA) + (size_t)nxt.pm * tstepA : cA; const char* nB = has_next ? (const char*)(gB + (size_t)nxt.g * g.gsB) + (size_t)nxt.pn * tstepB : cB;
        for (int t = 0; t < nt; t += 2) {
            const bool last = (t == nt - 2);
            const char* a1 = cA + (size_t)(t + 1) * kstep;
            const char* a2 = last ? nA : cA + (size_t)(t + 2) * kstep; const char* b2 = last ? nB : cB + (size_t)(t + 2) * kstep;
            const char* a3 = a2 + kstep; const char* b3 = b2 + kstep;
            PG8_LDB(B0, 0, 0); PG8_LDB(B1, 0, 1); PG8_SCHED; PG8_LDA(At, 0, 0); PG8_STAGE(PG8_SA(1, 1), a1 + hstepA, voffA);
            PG8_WAIT_V(8); PG8_WAIT_L(0); PG8_BAR; PG8_MMA(0, 0, At, B0); PG8_MMA(0, 1, At, B1); PG8_BAR; PG8_SCHED;
            PG8_LDA(At, 0, 1); PG8_STAGE(PG8_SB(0, 0), b2, voffB); PG8_STAGE(PG8_SB(0, 1), b2 + hstepB, voffB); PG8_STAGE(PG8_SA(0, 0), a2, voffA);
            PG8_WAIT_V(8); PG8_WAIT_L(0); PG8_BAR; PG8_MMA(1, 0, At, B0); PG8_MMA(1, 1, At, B1); PG8_BAR; PG8_SCHED;
            PG8_LDB(B0, 1, 0); PG8_LDB(B1, 1, 1); PG8_SCHED; PG8_LDA(At, 1, 0); PG8_STAGE(PG8_SA(0, 1), a2 + hstepA, voffA);
            PG8_WAIT_V(8); PG8_WAIT_L(0); PG8_BAR; PG8_MMA(0, 0, At, B0); PG8_MMA(0, 1, At, B1); PG8_BAR; PG8_SCHED;
            PG8_LDA(At, 1, 1); PG8_STAGE(PG8_SB(1, 0), b3, voffB); PG8_STAGE(PG8_SB(1, 1), b3 + hstepB, voffB); PG8_STAGE(PG8_SA(1, 0), a3, voffA);
            PG8_WAIT_V(8); PG8_WAIT_L(0); PG8_BAR; PG8_MMA(1, 0, At, B0); PG8_MMA(1, 1, At, B1); PG8_BAR; PG8_SCHED;
        }
        if (wr == 0) PG8_BAR;
        { const int l2 = lane_id_(); E(acc, cur, wid >> 2, wid & 3, l2 & 15, l2 >> 4); }
        if (!has_next) break;
#pragma unroll
        for (int a = 0; a < 2; ++a)
#pragma unroll
            for (int b = 0; b < 2; ++b)
#pragma unroll
                for (int m = 0; m < 4; ++m)
#pragma unroll
                    for (int n = 0; n < 2; ++n) acc[a][b][m][n] = (f32x4){0.f, 0.f, 0.f, 0.f};
        cur = nxt; cA = nA; cB = nB; ++ui;
        if (wr == 1) PG8_BAR;
    }
    PG8_WAIT_V(0);
    PG8_BAR;
#undef PG8_SA
#undef PG8_SB
#undef PG8_STAGE
#undef PG8_LDA
#undef PG8_LDB
#undef PG8_MMA
#undef PG8_WAIT_V
#undef PG8_WAIT_L
#undef PG8_BAR
#undef PG8_SCHED
}

struct EpiBf16 {
    bf16_t* O; int ldc; size_t gsO; const u64* ss;
    __device__ __forceinline__ void operator()(const f32x4 (&acc)[2][2][4][2], const Unit& u, int wr, int wc, int fr, int fq) const {
        const int row0 = u.pm * BM + wr * 64 + fr, col0 = u.pn * BM + wc * 32 + 8 * fq;
        bf16_t* base = O + (size_t)u.g * gsO;
        u64 sv[2][4];
        if (ss) {
#pragma unroll
            for (int ai = 0; ai < 2; ++ai)
#pragma unroll
                for (int m = 0; m < 4; ++m) sv[ai][m] = *G1(const u64, ss + row0 + ai * HALF + m * 16);
            __builtin_amdgcn_sched_barrier(0); }
#pragma unroll
        for (int ai = 0; ai < 2; ++ai)
#pragma unroll
            for (int m = 0; m < 4; ++m) { const int row = row0 + ai * HALF + m * 16; bf16_t* rowp = base + (size_t)row * ldc + col0;
                const float sc = ss ? ss_rstd(sv[ai][m]) : 1.0f;
#pragma unroll
                for (int bj = 0; bj < 2; ++bj) { const f32x4 v0 = acc[ai][bj][m][0] * sc, v1 = acc[ai][bj][m][1] * sc;
                    u32x4 w; w.x = cvtpk(v0[0], v0[1]); w.y = cvtpk(v0[2], v0[3]); w.z = cvtpk(v1[0], v1[1]); w.w = cvtpk(v1[2], v1[3]);
                    *G1(u32x4, rowp + bj * HALF) = w; } }
    }
};
struct EpiBf16Q {
    bf16_t* O; int ldc; const u64* ss; const float* ascale; u64* kn; int dry;
    __device__ __forceinline__ void operator()(const f32x4 (&acc)[2][2][4][2], const Unit& u, int wr, int wc, int fr, int fq) const {
        const int row0 = u.pm * BM + wr * 64 + fr, col0 = u.pn * BM + wc * 32 + 8 * fq;
        const bool ktile = kn != nullptr && u.pn >= 8 && u.pn < 16;
        if (dry) { float t_ = 0.f;
#pragma unroll
            for (int ai = 0; ai < 2; ++ai)
#pragma unroll
                for (int bj = 0; bj < 2; ++bj)
#pragma unroll
                    for (int m = 0; m < 4; ++m) t_ += acc[ai][bj][m][0][0] + acc[ai][bj][m][1][3];
            if (t_ == 1.2345e38f) *G1(float, (float*)O) = t_; return; }
        u64 sv[2][4]; float av[2][4];
#pragma unroll
        for (int ai = 0; ai < 2; ++ai)
#pragma unroll
            for (int m = 0; m < 4; ++m) { const int row = row0 + ai * HALF + m * 16; sv[ai][m] = *G1(const u64, ss + row); av[ai][m] = *G1(const float, ascale + row); }
        __builtin_amdgcn_sched_barrier(0);
#pragma unroll
        for (int ai = 0; ai < 2; ++ai)
#pragma unroll
            for (int m = 0; m < 4; ++m) { const int row = row0 + ai * HALF + m * 16; bf16_t* rowp = O + (size_t)row * ldc + col0;
                const float sc = ss_rstd(sv[ai][m]) * av[ai][m] * (1.0f / W8_SCALE);
#pragma unroll
                for (int bj = 0; bj < 2; ++bj) { const i32x4 i0 = __builtin_bit_cast(i32x4, acc[ai][bj][m][0]), i1 = __builtin_bit_cast(i32x4, acc[ai][bj][m][1]);
                    const float f0 = (float)i0[0] * sc, f1 = (float)i0[1] * sc, f2 = (float)i0[2] * sc, f3 = (float)i0[3] * sc, f4 = (float)i1[0] * sc, f5 = (float)i1[1] * sc, f6 = (float)i1[2] * sc, f7 = (float)i1[3] * sc;
                    u32x4 w; w.x = cvtpk(f0, f1); w.y = cvtpk(f2, f3); w.z = cvtpk(f4, f5); w.w = cvtpk(f6, f7);
                    *G1(u32x4, rowp + bj * HALF) = w;
                    if (ktile) { float s2 = (f0 * f0 + f1 * f1) + (f2 * f2 + f3 * f3) + (f4 * f4 + f5 * f5) + (f6 * f6 + f7 * f7); s2 += __shfl_xor(s2, 16); s2 += __shfl_xor(s2, 32);
                        if (fq == 0) (void)__hip_atomic_fetch_add(G1(u64, kn + (size_t)((u.pn - 8) * 2 + bj) * M + row), ss_fix(s2), __ATOMIC_RELAXED, __HIP_MEMORY_SCOPE_AGENT); } } }
    }
};
struct EpiResid {
    const bf16_t* Hin; bf16_t* H; signed char* HQ; float* ascale; const u64* ssin; u64* ssout; const float* ascale_y;
    __device__ __forceinline__ void operator()(const f32x4 (&acc)[2][2][4][2], const Unit& u, int wr, int wc, int fr, int fq) const {
        const int row0 = u.pm * BM + wr * 64 + fr, col0 = u.pn * BM + wc * 32 + 8 * fq;
#pragma unroll
        for (int ai = 0; ai < 2; ++ai) {
        u32x4 hv[2][4][2]; u64 sv[2][4]; float yv[2][4];
#pragma unroll
            for (int m = 0; m < 4; ++m) { const int row = row0 + ai * HALF + m * 16; const bf16_t* hi = Hin + (size_t)row * DM + col0;
                sv[ai][m] = *G1(const u64, ssin + row); yv[ai][m] = *G1(const float, ascale_y + row);
#pragma unroll
                for (int bj = 0; bj < 2; ++bj) hv[ai][m][bj] = *G1(const u32x4, hi + bj * HALF); }
        __builtin_amdgcn_sched_barrier(0);
#pragma unroll
            for (int m = 0; m < 4; ++m) { const int row = row0 + ai * HALF + m * 16; bf16_t* hp = H + (size_t)row * DM + col0; signed char* bp = HQ + (size_t)row * DM + col0; float s2 = 0.f;
                const float qs = 15.875f * ss_rstd(sv[ai][m]);
                if (fq == 0 && wc == 0 && u.pn == 0) *G1(float, ascale + row) = 1.0f / qs;
                const float ys = yv[ai][m] * (1.0f / W8_SCALE);
#pragma unroll
                for (int bj = 0; bj < 2; ++bj) { const i32x4 i0 = __builtin_bit_cast(i32x4, acc[ai][bj][m][0]), i1 = __builtin_bit_cast(i32x4, acc[ai][bj][m][1]); const u32x4 hw = hv[ai][m][bj];
                    const f32x4 v0 = (f32x4){bflo(hw.x), bfhi(hw.x), bflo(hw.y), bfhi(hw.y)} + (f32x4){(float)i0[0], (float)i0[1], (float)i0[2], (float)i0[3]} * ys, v1 = (f32x4){bflo(hw.z), bfhi(hw.z), bflo(hw.w), bfhi(hw.w)} + (f32x4){(float)i1[0], (float)i1[1], (float)i1[2], (float)i1[3]} * ys;
                    { u32x4 w; w.x = cvtpk(v0[0], v0[1]); w.y = cvtpk(v0[2], v0[3]); w.z = cvtpk(v1[0], v1[1]); w.w = cvtpk(v1[2], v1[3]); *G1(u32x4, hp + bj * HALF) = w; }
                    s2 += (v0[0] * v0[0] + v0[1] * v0[1]) + (v0[2] * v0[2] + v0[3] * v0[3]) + (v1[0] * v1[0] + v1[1] * v1[1]) + (v1[2] * v1[2] + v1[3] * v1[3]);
                    u32x2 q; q.x = pack4_q8_(v0[0] * qs, v0[1] * qs, v0[2] * qs, v0[3] * qs); q.y = pack4_q8_(v1[0] * qs, v1[1] * qs, v1[2] * qs, v1[3] * qs);
                    *G1(u32x2, bp + bj * HALF) = q; }
                s2 += __shfl_xor(s2, 16); s2 += __shfl_xor(s2, 32);
                if (fq == 0) (void)__hip_atomic_fetch_add(G1(u64, ssout + row), ss_fix(s2), __ATOMIC_RELAXED, __HIP_MEMORY_SCOPE_AGENT); }
        __builtin_amdgcn_sched_barrier(0);
        }
    }
};
struct EpiGate {
    bf16_t* H; const bf16_t* PP; const u64* ssin; u64* ssout; signed char* HQ; float* ascale; const float* ascale_in;
    __device__ __forceinline__ void operator()(const f32x4 (&acc)[2][2][4][2], const Unit& u, int wr, int wc, int fr, int fq) const {
        const int row0 = u.pm * BM + wr * 64 + fr, col0 = u.pn * BM + wc * 32 + 8 * fq;
#pragma unroll
        for (int ai = 0; ai < 2; ++ai) {
            u32x4 hv[4][2], pv[4][2]; u64 sv[4]; float av[4];
#pragma unroll
            for (int m = 0; m < 4; ++m) { const int row = row0 + ai * HALF + m * 16; const bf16_t* hp = H + (size_t)row * DM + col0; const bf16_t* pp = PP + (size_t)row * DM + col0;
                sv[m] = *G1(const u64, ssin + row); av[m] = *G1(const float, ascale_in + row);
#pragma unroll
                for (int bj = 0; bj < 2; ++bj) { pv[m][bj] = *G1(const u32x4, pp + bj * HALF); hv[m][bj] = *G1(const u32x4, hp + bj * HALF); } }
            __builtin_amdgcn_sched_barrier(0);
#pragma unroll
            for (int m = 0; m < 4; ++m) { const int row = row0 + ai * HALF + m * 16; bf16_t* hp = H + (size_t)row * DM + col0;
                const float sc = ss_rstd(sv[m]); float s2 = 0.f;
                const float qs = 15.875f * sc;
                const float scq = sc * av[m] * (1.0f / W8_SCALE);
                if (HQ && fq == 0 && wc == 0 && u.pn == 0) *G1(float, ascale + row) = 1.0f / qs;
#pragma unroll
                for (int bj = 0; bj < 2; ++bj) { const u32x4 pw = pv[m][bj], hw = hv[m][bj];
                    f32x4 v0 = (f32x4){bflo(hw.x), bfhi(hw.x), bflo(hw.y), bfhi(hw.y)}, v1 = (f32x4){bflo(hw.z), bfhi(hw.z), bflo(hw.w), bfhi(hw.w)};
                    const i32x4 i0 = __builtin_bit_cast(i32x4, acc[ai][bj][m][0]), i1 = __builtin_bit_cast(i32x4, acc[ai][bj][m][1]);
                    const f32x4 a0 = (f32x4){(float)i0[0], (float)i0[1], (float)i0[2], (float)i0[3]} * scq, a1 = (f32x4){(float)i1[0], (float)i1[1], (float)i1[2], (float)i1[3]} * scq;
                    v0[0] += sigmoidf_(a0[0]) * bflo(pw.x); v0[1] += sigmoidf_(a0[1]) * bfhi(pw.x); v0[2] += sigmoidf_(a0[2]) * bflo(pw.y); v0[3] += sigmoidf_(a0[3]) * bfhi(pw.y);
                    v1[0] += sigmoidf_(a1[0]) * bflo(pw.z); v1[1] += sigmoidf_(a1[1]) * bfhi(pw.z); v1[2] += sigmoidf_(a1[2]) * bflo(pw.w); v1[3] += sigmoidf_(a1[3]) * bfhi(pw.w);
                    { u32x4 w; w.x = cvtpk(v0[0], v0[1]); w.y = cvtpk(v0[2], v0[3]); w.z = cvtpk(v1[0], v1[1]); w.w = cvtpk(v1[2], v1[3]); *G1(u32x4, hp + bj * HALF) = w; }
                    s2 += (v0[0] * v0[0] + v0[1] * v0[1]) + (v0[2] * v0[2] + v0[3] * v0[3]) + (v1[0] * v1[0] + v1[1] * v1[1]) + (v1[2] * v1[2] + v1[3] * v1[3]);
                    if (HQ) { u32x2 q; q.x = pack4_q8_(v0[0] * qs, v0[1] * qs, v0[2] * qs, v0[3] * qs); q.y = pack4_q8_(v1[0] * qs, v1[1] * qs, v1[2] * qs, v1[3] * qs); *G1(u32x2, HQ + (size_t)row * DM + col0 + bj * HALF) = q; } }
                s2 += __shfl_xor(s2, 16); s2 += __shfl_xor(s2, 32);
                if (fq == 0) (void)__hip_atomic_fetch_add(G1(u64, ssout + row), ss_fix(s2), __ATOMIC_RELAXED, __HIP_MEMORY_SCOPE_AGENT); }
            __builtin_amdgcn_sched_barrier(0);
        }
    }
};
struct EpiOGate {
    bf16_t* Y; const bf16_t* GC; int ldg;
    __device__ __forceinline__ void operator()(const f32x4 (&acc)[2][2][4][2], const Unit& u, int wr, int wc, int fr, int fq) const {
        const int row0 = u.pm * BM + wr * 64 + fr, col0 = u.g * 256 + wc * 32 + 8 * fq;
        u32x4 gv[2][4][2];
#pragma unroll
        for (int ai = 0; ai < 2; ++ai)
#pragma unroll
            for (int m = 0; m < 4; ++m) { const int row = row0 + ai * HALF + m * 16; const bf16_t* gp = GC + (size_t)row * ldg + col0;
#pragma unroll
                for (int bj = 0; bj < 2; ++bj) gv[ai][m][bj] = *G1(const u32x4, gp + bj * HALF); }
        __builtin_amdgcn_sched_barrier(0);
#pragma unroll
        for (int ai = 0; ai < 2; ++ai)
#pragma unroll
            for (int m = 0; m < 4; ++m) { const int row = row0 + ai * HALF + m * 16; bf16_t* yp = Y + (size_t)row * DM + col0;
#pragma unroll
                for (int bj = 0; bj < 2; ++bj) { const u32x4 gw = gv[ai][m][bj]; const f32x4 a0 = acc[ai][bj][m][0], a1 = acc[ai][bj][m][1];
                    u32x4 w; w.x = cvtpk(a0[0] * siluf_(bflo(gw.x)), a0[1] * siluf_(bfhi(gw.x))); w.y = cvtpk(a0[2] * siluf_(bflo(gw.y)), a0[3] * siluf_(bfhi(gw.y)));
                    w.z = cvtpk(a1[0] * siluf_(bflo(gw.z)), a1[1] * siluf_(bfhi(gw.z))); w.w = cvtpk(a1[2] * siluf_(bflo(gw.w)), a1[3] * siluf_(bfhi(gw.w)));
                    *G1(u32x4, yp + bj * HALF) = w; } }
    }
};
}

struct Args { const float* in[22]; float* out; unsigned char* ws; int ph_lo, ph_hi; };
enum { I_X = 0, I_P, I_T5, I_NORMG, I_EWIN, I_EBF, I_ESINK, I_EWOUT, I_OWIN, I_OQNG, I_OKVNG, I_OWUQ, I_OWUQI, I_OLNG, I_OLNB, I_OWUK, I_OWUV, I_OWOUT, I_PWPROJ, I_PNORMG, I_PWGATE, I_FINALG };


__device__ __forceinline__ unsigned off_b(unsigned row, unsigned ch) { return 256u * row + 16u * (ch ^ (((row & 3) << 2) | ((row >> 2) & 3))); }
__device__ __forceinline__ s16x4 vtr(LAS const unsigned char* p) { return __builtin_bit_cast(s16x4, __builtin_amdgcn_ds_read_tr16_b64_v4i16((LAS v4i16_t*)p)); }
__device__ __forceinline__ bf16x8 pack8(const f32x16& s, int o) {
    u32x4 w; w.x = cvtpk(s[o + 0], s[o + 1]); w.y = cvtpk(s[o + 2], s[o + 3]); w.z = cvtpk(s[o + 4], s[o + 5]); w.w = cvtpk(s[o + 6], s[o + 7]);
    return __builtin_bit_cast(bf16x8, w);
}
template <int NSB, int NOB>
__device__ __forceinline__ void sm_step(f32x16 (&s)[NSB], float& m, float& l, f32x16 (&o)[NOB], bf16x8 (&p)[NSB][2]) {
    float mx = s[0][0];
#pragma unroll
    for (int b = 0; b < NSB; ++b)
#pragma unroll
        for (int r = 0; r < 16; ++r) mx = fmaxf(mx, s[b][r]);
    mx = xhalf_max(mx);
    if (__any(mx > m + 8.0f)) {
        const float mn = fmaxf(m, mx), alpha = fast_exp2(m - mn);
        l *= alpha; m = mn;
#pragma unroll
        for (int c = 0; c < NOB; ++c) o[c] = o[c] * alpha;
    }
    float sum = 0.f;
#pragma unroll
    for (int b = 0; b < NSB; ++b)
#pragma unroll
        for (int r = 0; r < 16; ++r) { s[b][r] = fast_exp2(s[b][r] - m); sum += s[b][r]; }
    sum = xhalf_sum(sum);
    l += sum;
#pragma unroll
    for (int b = 0; b < NSB; ++b) { p[b][0] = pack8(s[b], 0); p[b][1] = pack8(s[b], 8); }
}
__device__ __forceinline__ unsigned vt_addr(int lane, int krow0, int c, int t) {
    const unsigned h = lane >> 5, blk = (lane >> 4) & 1, q = (lane & 15) >> 2, p = lane & 3;
    return off_b(krow0 + 8 * t + 4 * h + q, 4 * c + 2 * blk + (p >> 1)) + 8 * (p & 1);
}
__device__ __forceinline__ bf16x8 vfrag(LAS const unsigned char* img, int lane, int krow0, int c) {
    const s16x4 lo = vtr(img + vt_addr(lane, krow0, c, 0)), hi = vtr(img + vt_addr(lane, krow0, c, 1));
    return (bf16x8){lo[0], lo[1], lo[2], lo[3], hi[0], hi[1], hi[2], hi[3]};
}
__device__ __forceinline__ unsigned krow_base(int lane) { const unsigned r = lane & 31, h = lane >> 5, x = ((r & 3) << 2) | ((r >> 2) & 3); return 256u * r + 16u * ((x & 14u) | (h ^ (x & 1u))); }
__device__ __forceinline__ unsigned vt_base(int lane) { const unsigned h = lane >> 5, blk = (lane >> 4) & 1, q = (lane & 15) >> 2, p = lane & 3; const unsigned low0 = (2 * blk + (p >> 1)) ^ h;
    return 256u * (4 * h + q) + 64u * q + 16u * low0 + 8u * (p & 1); }
__device__ __forceinline__ bf16x8 vfrag2(LAS const unsigned char* img, unsigned vb, int c, int imm) {
    const unsigned a0 = vb ^ (unsigned)(c << 6);
    const s16x4 lo = vtr(img + a0 + imm), hi = vtr(img + (a0 ^ 32u) + imm + 2048);
    return (bf16x8){lo[0], lo[1], lo[2], lo[3], hi[0], hi[1], hi[2], hi[3]};
}
__device__ __forceinline__ float log_sigmoid_(float x) { return x > 0.f ? -log1pf(expf(-x)) : x - log1pf(expf(x)); }

constexpr int FOX_KV = 0, FOX_CUM = 65536, FOX_SCAN = FOX_CUM + 16384, FOX_KMAX = FOX_SCAN + 64, FOX_FLAGS = FOX_SCAN + 128;
constexpr float FOX_SKIP_LOG2 = 64.0f;
template <int CTRL> __device__ __forceinline__ float dpp_(float v) { return __int_as_float(__builtin_amdgcn_update_dpp(0, __float_as_int(v), CTRL, 0xF, 0xF, true)); }
__device__ __forceinline__ float row16_sum(float s) { s += dpp_<0xB1>(s); s += dpp_<0x4E>(s); s += dpp_<0x141>(s); s += dpp_<0x140>(s); return s; }
__device__ __forceinline__ float wave_max_u(float v) {
    v = fmaxf(v, dpp_<0xB1>(v)); v = fmaxf(v, dpp_<0x4E>(v)); v = fmaxf(v, dpp_<0x141>(v)); v = fmaxf(v, dpp_<0x140>(v));
    const float a0 = __int_as_float(__builtin_amdgcn_readlane(__float_as_int(v), 0)), a1 = __int_as_float(__builtin_amdgcn_readlane(__float_as_int(v), 16));
    const float a2 = __int_as_float(__builtin_amdgcn_readlane(__float_as_int(v), 32)), a3 = __int_as_float(__builtin_amdgcn_readlane(__float_as_int(v), 48));
    return fmaxf(fmaxf(a0, a1), fmaxf(a2, a3));
}
__device__ __forceinline__ void fox_scan(const GAS bf16_t* proj, const GAS u64* kn, const GAS float* bfp, int b, int hd, LAS unsigned char* lds, int tid, int lane, int wave) {
    LAS float* cumL = (LAS float*)(lds + FOX_CUM); LAS float* scanL = (LAS float*)(lds + FOX_SCAN); LAS float* kmaxL = (LAS float*)(lds + FOX_KMAX);
    const float bias = bfp[hd]; float v[8]; float run = 0.f;
#pragma unroll
    for (int i = 0; i < 8; ++i) { const float f = bf2f(proj[(size_t)(b * SEQ + 8 * tid + i) * EN + E_FA + hd]); run += log_sigmoid_(f + bias); v[i] = run; }
    float inc = run;
#pragma unroll
    for (int o = 1; o < 64; o <<= 1) { const float t = __shfl_up(inc, o); if (lane >= o) inc += t; }
    float kq = 0.f;
    { const GAS u64* kp = kn + (size_t)hd * M + (size_t)b * SEQ + 8 * tid;
#pragma unroll
      for (int i = 0; i < 8; ++i) kq = fmaxf(kq, (float)kp[i] * (1.0f / 16777216.0f)); }
    kq = wave_max_u(kq);
    if (lane == 63) scanL[wave] = inc;
    if (lane == 0) scanL[8 + wave] = kq;
    __syncthreads();
    float wbase = 0.f, km = 0.f;
#pragma unroll
    for (int w = 0; w < 8; ++w) { const float t = scanL[w]; if (w < wave) wbase += t; km = fmaxf(km, scanL[8 + w]); }
    const float excl = wbase + inc - run;
#pragma unroll
    for (int i = 0; i < 8; ++i) cumL[8 * tid + i] = -(excl + v[i]) * LOG2E;
    if (tid == 0) kmaxL[0] = sqrtf(km) * 1.005f;
    __syncthreads();
}
__device__ __forceinline__ void fox_unit(const GAS bf16_t* proj, GAS bf16_t* yin, int b, int hd, int qb, LAS unsigned char* lds, int tid, int lane, int wave) {
    const LAS float* cumL = (const LAS float*)(lds + FOX_CUM); volatile LAS int* flags = (volatile LAS int*)(lds + FOX_FLAGS);
    const int t0 = 256 * qb, q0 = t0 + 32 * wave, qme = q0 + (lane & 31), h = lane >> 5;
    const size_t rowb = (size_t)b * SEQ;
    const float cs = 0.08838834764831845f * LOG2E;
    const unsigned kbase = krow_base(lane), vbase = vt_base(lane);
    bf16x8 qf[8];
    { const GAS bf16_t* qp = proj + (rowb + qme) * EN + E_QA + hd * 128 + 8 * h;
#pragma unroll
      for (int s = 0; s < 8; ++s) qf[s] = *(const GAS bf16x8*)(qp + 16 * s); }
    float qn2 = 0.f;
#pragma unroll
    for (int s = 0; s < 8; ++s)
#pragma unroll
        for (int e = 0; e < 8; ++e) { const float x = bf2f((unsigned short)qf[s][e]); qn2 += x * x; }
    qn2 = xhalf_sum(qn2);
    const float cbound = sqrtf(qn2) * 1.0001f * ((const LAS float*)(lds + FOX_KMAX))[0] * cs;
    f32x16 o[4];
#pragma unroll
    for (int c = 0; c < 4; ++c)
#pragma unroll
        for (int r = 0; r < 16; ++r) o[c][r] = 0.f;
    float m = -1e30f, l = 0.f;
    const int ntile = 4 * (qb + 1);
    const int r0 = tid >> 4, c0 = tid & 15;
    const GAS bf16_t* kg = proj + (rowb + r0) * EN + E_KA + hd * 128 + c0 * 8;
    const GAS bf16_t* vg = proj + (rowb + r0) * EN + E_VA + hd * 128 + c0 * 8;
    const unsigned so0 = off_b(r0, c0), so1 = off_b(r0 + 32, c0);
    u32x4 sk0, sk1, sv0, sv1;
    { const size_t adv = (size_t)64 * (ntile - 1) * EN; sk0 = *(const GAS u32x4*)(kg + adv); sk1 = *(const GAS u32x4*)(kg + adv + (size_t)32 * EN); sv0 = *(const GAS u32x4*)(vg + adv); sv1 = *(const GAS u32x4*)(vg + adv + (size_t)32 * EN); }
    __syncthreads();
    { LAS unsigned char* kb = lds + FOX_KV; *(LAS u32x4*)(kb + so0) = sk0; *(LAS u32x4*)(kb + so1) = sk1; *(LAS u32x4*)(kb + 16384 + so0) = sv0; *(LAS u32x4*)(kb + 16384 + so1) = sv1; }
    __syncthreads();
    bool done_w = false;
    for (int it = 0; it < ntile; ++it) {
        const int kt = ntile - 1 - it, cur = it & 1; const LAS unsigned char* Kt = lds + FOX_KV + cur * 32768; const LAS unsigned char* Vt = Kt + 16384;
        const bool more = kt > 0;
        if (more) { const size_t adv = (size_t)64 * (kt - 1) * EN; sk0 = *(const GAS u32x4*)(kg + adv); sk1 = *(const GAS u32x4*)(kg + adv + (size_t)32 * EN); sv0 = *(const GAS u32x4*)(vg + adv); sv1 = *(const GAS u32x4*)(vg + adv + (size_t)32 * EN); }
        const int k0 = 64 * kt;
        if (k0 <= q0 + 31 && !done_w) {
            f32x16 sc[2];
#pragma unroll
            for (int kb = 0; kb < 2; ++kb) {
#pragma unroll
                for (int r = 0; r < 16; ++r) sc[kb][r] = 0.f;
#pragma unroll
                for (int s = 0; s < 8; ++s) { const bf16x8 a = *(const LAS bf16x8*)(Kt + (kbase ^ (unsigned)(s << 5)) + 8192 * kb); sc[kb] = __builtin_amdgcn_mfma_f32_32x32x16_bf16(a, qf[s], sc[kb], 0, 0, 0); }
            }
            const bool diag = (k0 + 63 > q0);
#pragma unroll
            for (int kb = 0; kb < 2; ++kb)
#pragma unroll
                for (int g4 = 0; g4 < 4; ++g4) { const int key0 = k0 + 32 * kb + 8 * g4 + 4 * h; const f32x4 nb = *(const LAS f32x4*)(cumL + key0);
#pragma unroll
                    for (int e = 0; e < 4; ++e) { float v = sc[kb][4 * g4 + e] * cs + nb[e]; if (diag && (key0 + e > qme)) v = -1e30f; sc[kb][4 * g4 + e] = v; } }
            bf16x8 p[2][2];
            sm_step<2, 4>(sc, m, l, o, p);
#pragma unroll
            for (int c = 0; c < 4; ++c)
#pragma unroll
                for (int kb = 0; kb < 2; ++kb)
#pragma unroll
                    for (int s = 0; s < 2; ++s) { const bf16x8 a = vfrag2(Vt, vbase, c, 256 * (32 * kb + 16 * s)); o[c] = __builtin_amdgcn_mfma_f32_32x32x16_bf16(a, p[kb][s], o[c], 0, 0, 0); }
            if (more) { const float amax = wave_max_u(cbound - m); done_w = (amax + cumL[k0 - 1] < -FOX_SKIP_LOG2); }
        }
        if (lane == 0) flags[cur * 8 + wave] = done_w ? 1 : 0;
        if (more) { LAS unsigned char* kb = lds + FOX_KV + (cur ^ 1) * 32768; *(LAS u32x4*)(kb + so0) = sk0; *(LAS u32x4*)(kb + so1) = sk1; *(LAS u32x4*)(kb + 16384 + so0) = sv0; *(LAS u32x4*)(kb + 16384 + so1) = sv1; }
        __syncthreads();
        int alld = 1;
#pragma unroll
        for (int w = 0; w < 8; ++w) alld &= flags[cur * 8 + w];
        if (alld) break;
    }
    const float il = 1.0f / l;
    const GAS bf16_t* gp = proj + (rowb + qme) * EN + E_GA + hd * 128 + 4 * h; GAS bf16_t* yp = yin + (rowb + qme) * DM + hd * 128 + 4 * h;
#pragma unroll
    for (int c = 0; c < 4; ++c)
#pragma unroll
        for (int g4 = 0; g4 < 4; ++g4) { const u32x2 gw = *(const GAS u32x2*)(gp + 32 * c + 8 * g4);
            u32x2 w; w.x = cvtpk(o[c][4 * g4 + 0] * il * siluf_(bflo(gw.x)), o[c][4 * g4 + 1] * il * siluf_(bfhi(gw.x))); w.y = cvtpk(o[c][4 * g4 + 2] * il * siluf_(bflo(gw.y)), o[c][4 * g4 + 3] * il * siluf_(bfhi(gw.y)));
            *(GAS u32x2*)(yp + 32 * c + 8 * g4) = w; }
}

constexpr int SWA_K = 0, SWA_V = 65536, SWA_TB = 131072;
__device__ __forceinline__ int t5_bucket_(int rel) {
    if (rel < 16) return rel;
    if (rel >= 128) return 31;
    const int v = 16 + (int)(logf((float)rel * (1.0f / 16.0f)) / 2.0794415416798357f * 16.0f);
    return v < 31 ? v : 31;
}
__device__ __forceinline__ void swa_unit(const GAS bf16_t* proj, GAS bf16_t* yin, const GAS float* t5, const GAS float* sinks, int b, int nb, int kvh, LAS unsigned char* lds, int tid, int lane, int wave) {
    const size_t rowb = (size_t)b * SEQ; const int hq = kvh * 8 + wave, h = lane >> 5;
    __syncthreads();
#pragma unroll
    for (int i = 0; i < 4; ++i) { const int c = tid + 512 * i, row = c >> 3, ch = c & 7; const int key = 128 * (nb - 1) + row;
        u32x4 kv = zero4_(), vv = kv;
        if (key >= 0) { const GAS bf16_t* src = proj + (rowb + key) * EN + kvh * 64 + ch * 8; kv = *(const GAS u32x4*)(src + E_KB); vv = *(const GAS u32x4*)(src + E_VB); }
        *(LAS u32x4*)(lds + SWA_K + off_b(row, ch)) = kv; *(LAS u32x4*)(lds + SWA_V + off_b(row, ch)) = vv; }
    LAS float* tb = (LAS float*)(lds + SWA_TB + wave * 512);
#pragma unroll
    for (int i = 0; i < 2; ++i) { const int rel = lane + 64 * i; tb[rel] = t5[t5_bucket_(rel) * 64 + hq] * LOG2E; }
    __syncthreads();
    const float cs = 0.125f * LOG2E, sink2 = sinks[hq] * LOG2E;
    const unsigned kbase = krow_base(lane), vbase = vt_base(lane);
    for (int cg = 0; cg < 4; ++cg) {
        const int qi = 32 * cg + (lane & 31); const size_t row = rowb + 128 * nb + qi;
        bf16x8 qf[4];
        { const GAS bf16_t* qp = proj + row * EN + E_QB + hq * 64 + 8 * h;
#pragma unroll
          for (int s = 0; s < 4; ++s) qf[s] = *(const GAS bf16x8*)(qp + 16 * s); }
        f32x16 o[2];
#pragma unroll
        for (int c = 0; c < 2; ++c)
#pragma unroll
            for (int r = 0; r < 16; ++r) o[c][r] = 0.f;
        float m = sink2, l = 1.0f;
        for (int kb = cg; kb < cg + 5; ++kb) {
            f32x16 sc[1];
#pragma unroll
            for (int r = 0; r < 16; ++r) sc[0][r] = 0.f;
#pragma unroll
            for (int s = 0; s < 4; ++s) { const bf16x8 a = *(const LAS bf16x8*)(lds + SWA_K + (kbase ^ (unsigned)(s << 5)) + 8192 * kb); sc[0] = __builtin_amdgcn_mfma_f32_32x32x16_bf16(a, qf[s], sc[0], 0, 0, 0); }
#pragma unroll
            for (int r = 0; r < 16; ++r) { const int kj = 32 * kb + (r & 3) + 8 * (r >> 2) + 4 * h, rel = qi + 128 - kj;
                const bool valid = (rel >= 0) && (rel < 128) && (nb > 0 || kj >= 128);
                const float bias = tb[rel & 127];
                sc[0][r] = sc[0][r] * cs + bias + (valid ? 0.f : -1e30f); }
            bf16x8 p[1][2];
            sm_step<1, 2>(sc, m, l, o, p);
#pragma unroll
            for (int c = 0; c < 2; ++c)
#pragma unroll
                for (int s = 0; s < 2; ++s) { const bf16x8 a = vfrag2(lds + SWA_V + 8192 * kb, vbase, c, 4096 * s); o[c] = __builtin_amdgcn_mfma_f32_32x32x16_bf16(a, p[0][s], o[c], 0, 0, 0); }
        }
        const float il = 1.0f / l;
        const GAS bf16_t* gp = proj + row * EN + E_GB + hq * 64 + 4 * h; GAS bf16_t* yp = yin + row * DM + 2048 + hq * 64 + 4 * h;
#pragma unroll
        for (int c = 0; c < 2; ++c)
#pragma unroll
            for (int g4 = 0; g4 < 4; ++g4) { const u32x2 gw = *(const GAS u32x2*)(gp + 32 * c + 8 * g4);
                u32x2 w; w.x = cvtpk(o[c][4 * g4 + 0] * il * siluf_(bflo(gw.x)), o[c][4 * g4 + 1] * il * siluf_(bfhi(gw.x))); w.y = cvtpk(o[c][4 * g4 + 2] * il * siluf_(bflo(gw.y)), o[c][4 * g4 + 3] * il * siluf_(bfhi(gw.y)));
                *(GAS u32x2*)(yp + 32 * c + 8 * g4) = w; }
    }
}
__device__ __forceinline__ void phase_even_attn(const Args& a, int j, LAS unsigned char* lds, int G, int bx, const int wave, const int which) {
    const int lane = lane_id_(), tid = wave * 64 + lane;
    unsigned char* ws_ = a.ws; OPAQUE_S(ws_); GAS unsigned char* ws = (GAS unsigned char*)ws_;
    const GAS bf16_t* proj = (const GAS bf16_t*)(ws + WS_PROJ); GAS bf16_t* yin = (GAS bf16_t*)(ws + WS_YIN);
    if (which & 1) for (int u = bx; u < 256; u += G) {
        const int b = u >> 7, hd = (u >> 3) & 15, i = u & 7;
        __syncthreads();
        fox_scan(proj, (const GAS u64*)(ws + WS_KN) + (size_t)j * 16 * M, ((const GAS float*)a.in[I_EBF]) + j * 16, b, hd, lds, tid, lane, wave);
        fox_unit(proj, yin, b, hd, 15 - i, lds, tid, lane, wave);
        fox_unit(proj, yin, b, hd, i, lds, tid, lane, wave);
    }
    if (which & 2) for (int u = bx; u < 256; u += G) {
        const int b = u >> 7, nb = (u >> 2) & 31, kvh = u & 3;
        swa_unit(proj, yin, ((const GAS float*)a.in[I_T5]), ((const GAS float*)a.in[I_ESINK]) + j * 32, b, nb, kvh, lds, tid, lane, wave);
    }
    __syncthreads();
}

#define BAR_LDS() asm volatile("s_waitcnt lgkmcnt(0)\n\ts_barrier" ::: "memory")
__device__ __forceinline__ void phase_odd_norms(const Args& a, int j, int gw, int NGW) {
    const int lane = lane_id_();
    unsigned char* ws_ = a.ws; OPAQUE_S(ws_); GAS unsigned char* ws = (GAS unsigned char*)ws_;
    const GAS bf16_t* proj = (const GAS bf16_t*)(ws + WS_PROJ); GAS bf16_t* cqn = (GAS bf16_t*)(ws + WS_CQN); GAS bf16_t* lat = (GAS bf16_t*)(ws + WS_LAT); GAS bf16_t* kidx = (GAS bf16_t*)(ws + WS_KIDX); GAS float* widx = (GAS float*)(ws + WS_WIDX);
    const GAS float* qg = ((const GAS float*)a.in[I_OQNG]) + j * 1024; const GAS float* kvg = ((const GAS float*)a.in[I_OKVNG]) + j * 512; const GAS float* lng = ((const GAS float*)a.in[I_OLNG]) + j * 64; const GAS float* lnb = ((const GAS float*)a.in[I_OLNB]) + j * 64;
    for (int row = gw; row < M; row += NGW) {
        const GAS bf16_t* pr = proj + (size_t)row * ON;
        {
            const u32x4 w0 = *(const GAS u32x4*)(pr + O_CQ + lane * 8), w1 = *(const GAS u32x4*)(pr + O_CQ + 512 + lane * 8);
            float v[16] = {bflo(w0.x), bfhi(w0.x), bflo(w0.y), bfhi(w0.y), bflo(w0.z), bfhi(w0.z), bflo(w0.w), bfhi(w0.w), bflo(w1.x), bfhi(w1.x), bflo(w1.y), bfhi(w1.y), bflo(w1.z), bfhi(w1.z), bflo(w1.w), bfhi(w1.w)};
            float ss = 0.f;
#pragma unroll
            for (int i = 0; i < 16; ++i) ss += v[i] * v[i];
            ss = wave_sum(ss); const float r = 1.0f / sqrtf(ss * (1.0f / 1024.0f) + EPS);
            const f32x4 g0 = *(const GAS f32x4*)(qg + lane * 8), g1 = *(const GAS f32x4*)(qg + lane * 8 + 4), g2 = *(const GAS f32x4*)(qg + 512 + lane * 8), g3 = *(const GAS f32x4*)(qg + 512 + lane * 8 + 4);
            u32x4 o0, o1;
            o0.x = cvtpk(v[0] * r * g0[0], v[1] * r * g0[1]); o0.y = cvtpk(v[2] * r * g0[2], v[3] * r * g0[3]); o0.z = cvtpk(v[4] * r * g1[0], v[5] * r * g1[1]); o0.w = cvtpk(v[6] * r * g1[2], v[7] * r * g1[3]);
            o1.x = cvtpk(v[8] * r * g2[0], v[9] * r * g2[1]); o1.y = cvtpk(v[10] * r * g2[2], v[11] * r * g2[3]); o1.z = cvtpk(v[12] * r * g3[0], v[13] * r * g3[1]); o1.w = cvtpk(v[14] * r * g3[2], v[15] * r * g3[3]);
            *(GAS u32x4*)(cqn + (size_t)row * 1024 + lane * 8) = o0; *(GAS u32x4*)(cqn + (size_t)row * 1024 + 512 + lane * 8) = o1;
        }
        {
            const u32x4 w0 = *(const GAS u32x4*)(pr + O_CKV + lane * 8);
            float v[8] = {bflo(w0.x), bfhi(w0.x), bflo(w0.y), bfhi(w0.y), bflo(w0.z), bfhi(w0.z), bflo(w0.w), bfhi(w0.w)};
            float ss = 0.f;
#pragma unroll
            for (int i = 0; i < 8; ++i) ss += v[i] * v[i];
            ss = wave_sum(ss); const float r = 1.0f / sqrtf(ss * (1.0f / 512.0f) + EPS);
            const f32x4 g0 = *(const GAS f32x4*)(kvg + lane * 8), g1 = *(const GAS f32x4*)(kvg + lane * 8 + 4);
            u32x4 o0; o0.x = cvtpk(v[0] * r * g0[0], v[1] * r * g0[1]); o0.y = cvtpk(v[2] * r * g0[2], v[3] * r * g0[3]); o0.z = cvtpk(v[4] * r * g1[0], v[5] * r * g1[1]); o0.w = cvtpk(v[6] * r * g1[2], v[7] * r * g1[3]);
            *(GAS u32x4*)(lat + (size_t)row * 512 + lane * 8) = o0;
        }
        {
            const float x = bf2f(pr[O_KIDX + lane]); const float mu = wave_sum(x) * (1.0f / 64.0f); const float xc = x - mu; const float var = wave_sum(xc * xc) * (1.0f / 64.0f);
            const float y = xc * (1.0f / sqrtf(var + EPS)) * lng[lane] + lnb[lane];
            kidx[(size_t)row * 64 + lane] = (bf16_t)(cvtpk(y, 0.f) & 0xffffu);
        }
        if (lane < 32) widx[(size_t)row * 32 + lane] = bf2f(pr[O_WIDX + lane]) * 0.022097086912079608f;
    }
}

__device__ __forceinline__ unsigned sortable_(float f) { const unsigned u = __float_as_uint(f); return (u & 0x80000000u) ? ~u : (u | 0x80000000u); }
__device__ __forceinline__ int wave_isum(int v) {
#pragma unroll
    for (int o = 1; o < 64; o <<= 1) v += __shfl_xor(v, o);
    return v;
}
__device__ __forceinline__ void topk_row(const GAS float* srow, GAS int* sel, int t, int lane) {
    const int nvalid = t + 1;
    if (nvalid <= 256) {
#pragma unroll
        for (int i = 0; i < 4; ++i) sel[64 * i + lane] = (64 * i + lane < nvalid) ? 64 * i + lane : 0;
        return;
    }
    unsigned key[64];
    const int ngrp = (nvalid + 511) >> 9;
#pragma unroll
    for (int g = 0; g < 8; ++g) {
        if (g < ngrp) {
#pragma unroll
            for (int i = 8 * g; i < 8 * g + 8; ++i) { const int e = 64 * i + lane; const float v = srow[e]; key[i] = (e < nvalid) ? sortable_(v) : 0u; }
        } else {
#pragma unroll
            for (int i = 8 * g; i < 8 * g + 8; ++i) key[i] = 0u;
        }
    }
    unsigned T = 0u;
#pragma unroll 1
    for (int bit = 31; bit >= 0; --bit) {
        const unsigned cand = T | (1u << bit); int cnt = 0;
#pragma unroll
        for (int g = 0; g < 8; ++g) {
            if (g < ngrp) {
#pragma unroll
                for (int i = 0; i < 8; ++i) cnt += __builtin_popcountll(__ballot(key[8 * g + i] >= cand));
            }
            __builtin_amdgcn_sched_barrier(0);
        }
        if (cnt >= 256) T = cand;
        if (cnt == 256) break;
    }
    int cgt = 0;
#pragma unroll
    for (int g = 0; g < 8; ++g) {
        if (g < ngrp) {
#pragma unroll
            for (int i = 0; i < 8; ++i) cgt += __builtin_popcountll(__ballot(key[8 * g + i] > T));
        }
        __builtin_amdgcn_sched_barrier(0);
    }
    const int need = 256 - cgt; int pos = 0, eqseen = 0;
#pragma unroll
    for (int g = 0; g < 8; ++g) {
        if (g < ngrp) {
#pragma unroll
            for (int i = 8 * g; i < 8 * g + 8; ++i) {
                const bool gt = key[i] > T, eq = key[i] == T;
                const unsigned long long meq = __ballot(eq);
                const int rank = eqseen + (int)__builtin_amdgcn_mbcnt_hi((unsigned)(meq >> 32), __builtin_amdgcn_mbcnt_lo((unsigned)meq, 0u));
                const bool take = gt || (eq && rank < need);
                const unsigned long long mt = __ballot(take);
                const int p = pos + (int)__builtin_amdgcn_mbcnt_hi((unsigned)(mt >> 32), __builtin_amdgcn_mbcnt_lo((unsigned)mt, 0u));
                if (take && p < 256) sel[p] = 64 * i + lane;
                pos += __builtin_popcountll(mt); eqseen += __builtin_popcountll(meq);
            }
        }
    }
}
__device__ __forceinline__ void phase_indexer(const Args& a, LAS unsigned char* lds, int G, int bx, const int wave, const bool do_topk) {
    unsigned char* ws_ = a.ws; OPAQUE_S(ws_); GAS unsigned char* ws = (GAS unsigned char*)ws_;
    const GAS bf16_t* qbuf = (const GAS bf16_t*)(ws + WS_QBUF); const GAS bf16_t* kidx = (const GAS bf16_t*)(ws + WS_KIDX); const GAS float* widx = (const GAS float*)(ws + WS_WIDX);
    GAS float* score = (GAS float*)(ws + WS_SCORE) + (size_t)bx * 16 * 4096; GAS int* sel = (GAS int*)(ws + WS_SEL);
    for (int u = bx; u < 256; u += G) {
        const int b = u >> 7, i0 = u & 127;
        for (int half = 0; half < 2; ++half) {
            const int lane = lane_id_(), tid = wave * 64 + lane, h = lane >> 5;
            const unsigned key = lane & 31, x = (key >> 1) & 7;
            const unsigned bbase = 128u * key + 16u * ((x & 6u) | ((unsigned)h ^ (x & 1u)));
            const int qg = half ? 255 - i0 : i0;
            const int tq = 16 * qg + 2 * wave; const size_t rowb = (size_t)b * SEQ;
            bf16x8 qa[2][4]; f32x4 wv[2][4];
#pragma unroll
            for (int q = 0; q < 2; ++q) { const GAS bf16_t* qp = qbuf + (rowb + tq + q) * QW + 4096 + (lane & 31) * 64 + 8 * h; const GAS float* wp = widx + (rowb + tq + q) * 32 + 4 * h;
#pragma unroll
                for (int s = 0; s < 4; ++s) qa[q][s] = *(const GAS bf16x8*)(qp + 16 * s);
#pragma unroll
                for (int g4 = 0; g4 < 4; ++g4) wv[q][g4] = *(const GAS f32x4*)(wp + 8 * g4); }
            const int kmax = 16 * qg + 15, ntile = kmax / 256 + 1;
            const GAS bf16_t* kg = kidx + rowb * 64 + tid * 8;
            u32x4 st[4];
#pragma unroll
            for (int i = 0; i < 4; ++i) st[i] = *(const GAS u32x4*)(kg + i * 4096);
            __syncthreads();
#pragma unroll
            for (int i = 0; i < 4; ++i) { const int c = tid + 512 * i, row = c >> 3, ch = c & 7; *(LAS u32x4*)(lds + row * 128 + ((ch ^ ((row >> 1) & 7)) << 4)) = st[i]; }
            __syncthreads();
            for (int kt = 0; kt < ntile; ++kt) {
                const int cur = kt & 1; const bool more = kt + 1 < ntile;
                if (more) {
#pragma unroll
                    for (int i = 0; i < 4; ++i) st[i] = *(const GAS u32x4*)(kg + (size_t)(kt + 1) * 16384 + i * 4096); }
                const LAS unsigned char* Kt = lds + cur * 32768;
                const int nkb = (kmax - 256 * kt) / 32 + 1 < 8 ? (kmax - 256 * kt) / 32 + 1 : 8;
#define IDX_LOAD(B, kb_) do { _Pragma("unroll") for (int s_ = 0; s_ < 4; ++s_) B[s_] = *(const LAS bf16x8*)(Kt + (bbase ^ (unsigned)(s_ << 5)) + 4096 * (kb_)); } while (0)
#define IDX_BLOCK(B, kb_) do { f32x16 acc0, acc1; \
                    _Pragma("unroll") for (int r = 0; r < 16; ++r) { acc0[r] = 0.f; acc1[r] = 0.f; } \
                    _Pragma("unroll") for (int s_ = 0; s_ < 4; ++s_) acc0 = __builtin_amdgcn_mfma_f32_32x32x16_bf16(qa[0][s_], B[s_], acc0, 0, 0, 0); \
                    _Pragma("unroll") for (int s_ = 0; s_ < 4; ++s_) acc1 = __builtin_amdgcn_mfma_f32_32x32x16_bf16(qa[1][s_], B[s_], acc1, 0, 0, 0); \
                    float sc0 = 0.f, sc1 = 0.f; \
                    _Pragma("unroll") for (int r = 0; r < 16; ++r) sc0 += wv[0][r >> 2][r & 3] * fmaxf(acc0[r], 0.f); \
                    _Pragma("unroll") for (int r = 0; r < 16; ++r) sc1 += wv[1][r >> 2][r & 3] * fmaxf(acc1[r], 0.f); \
                    sc0 = xhalf_sum(sc0); sc1 = xhalf_sum(sc1); \
                    if (lane < 32) { score[(size_t)(2 * wave) * 4096 + 256 * kt + 32 * (kb_) + lane] = sc0; score[(size_t)(2 * wave + 1) * 4096 + 256 * kt + 32 * (kb_) + lane] = sc1; } } while (0)
                { bf16x8 fa[4], fb[4];
                  IDX_LOAD(fa, 0);
                  for (int kb = 0; kb < nkb; kb += 2) {
                      if (kb + 1 < nkb) IDX_LOAD(fb, kb + 1);
                      IDX_BLOCK(fa, kb);
                      if (kb + 1 < nkb) { if (kb + 2 < nkb) IDX_LOAD(fa, kb + 2); IDX_BLOCK(fb, kb + 1); }
                  } }
#undef IDX_LOAD
#undef IDX_BLOCK
                if (more) {
#pragma unroll
                    for (int i = 0; i < 4; ++i) { const int c = tid + 512 * i, row = c >> 3, ch = c & 7; *(LAS u32x4*)(lds + (cur ^ 1) * 32768 + row * 128 + ((ch ^ ((row >> 1) & 7)) << 4)) = st[i]; } }
                __syncthreads();
            }
            VM_WAIT();
            __builtin_amdgcn_fence(__ATOMIC_ACQUIRE, "agent");
            VM_WAIT();
            if (do_topk) { const int lane2 = lane_id_();
#pragma unroll 1
              for (int q = 0; q < 2; ++q) topk_row(score + (size_t)(2 * wave + q) * 4096, sel + (rowb + tq + q) * 256, tq + q, lane2); }
        }
    }
    __syncthreads();
}

constexpr int DSA_LAT = 0, DSA_XCH = 65536, DSA_TAB = 131072, DSA_T5 = 143360, DSA_TCNT = 147456, DSA_MASKROW = 4352;
__device__ __forceinline__ void phase_dsa(const Args& a, LAS unsigned char* lds, int G, int bx, const int wave, const int mode) {
    (void)mode;
    const int lane = lane_id_(), tid = wave * 64 + lane, h = lane >> 5, team = wave >> 2, wq = wave & 3, ttid = tid & 255;
    unsigned char* ws_ = a.ws; OPAQUE_S(ws_); GAS unsigned char* ws = (GAS unsigned char*)ws_;
    const GAS bf16_t* qabs = (const GAS bf16_t*)(ws + WS_QABS); const GAS bf16_t* lat = (const GAS bf16_t*)(ws + WS_LAT); const GAS int* sel = (const GAS int*)(ws + WS_SEL); GAS bf16_t* olat = (GAS bf16_t*)(ws + WS_OLAT);
    LAS float* t5c = (LAS float*)(lds + DSA_T5);
    volatile LAS unsigned* tcnt = (volatile LAS unsigned*)(lds + DSA_TCNT + team * 64);
    __syncthreads();
    for (int i = tid; i < 1024; i += 512) t5c[i] = ((const GAS float*)a.in[I_T5])[(i >> 5) * 64 + 32 + (i & 31)] * LOG2E;
    if (tid < 32) ((volatile LAS unsigned*)(lds + DSA_TCNT))[tid] = 0u;
    if (tid >= 64 && tid < 96) ((LAS float*)((LAS unsigned char*)t5c + DSA_MASKROW))[tid - 64] = -1e30f;
    __syncthreads();
    LAS unsigned char* latw = lds + DSA_LAT + wave * 8192; LAS unsigned char* xch = lds + DSA_XCH + team * 32768;
    LAS unsigned char* pbuf = xch + 16384; LAS unsigned char* mbuf = xch + 18432; LAS unsigned char* lbuf = xch + 18944;
    const unsigned qoff = (unsigned)(((wq >> 1) * 64 + lane) * 16 + (wq & 1) * 8);
    LAS unsigned char* tabs = lds + DSA_TAB + team * 6144;
#define TAB_SEL(p) ((LAS int*)(tabs + (p) * 3072))
#define TAB_BKT(p) ((LAS int*)(tabs + (p) * 3072 + 1024))
    const unsigned kbase = krow_base(lane), vbase = vt_base(lane);
    const float cs = 0.08838834764831845f * LOG2E;
    unsigned tepoch = 0u;
#define TEAM_BAR() do { asm volatile("s_waitcnt lgkmcnt(0)" ::: "memory"); ++tepoch; if (lane == 0) __hip_atomic_fetch_add((LAS unsigned*)tcnt, 1u, __ATOMIC_RELAXED, __HIP_MEMORY_SCOPE_WORKGROUP); \
        while (__builtin_amdgcn_readfirstlane((int)*tcnt) < (int)(4u * tepoch)) __builtin_amdgcn_s_sleep(1); asm volatile("" ::: "memory"); } while (0)
    const int gr = lane >> 4, gc = lane & 15;
    const unsigned wbase = 256u * gr + 16u * (gc ^ (gr << 2));
#define DSA_TABLES(p, qq, idxv) do { const int t_ = (qq) & 4095, ns_ = t_ + 1 < 256 ? t_ + 1 : 256; const bool valid_ = ttid < ns_; const int id_ = valid_ ? (idxv) : 0; \
        TAB_SEL(p)[ttid] = id_; TAB_BKT(p)[ttid] = valid_ ? 128 * t5_bucket_(t_ - id_) : DSA_MASKROW; } while (0)
#define DSA_SELLOAD(qq) ((ttid < ((((qq) & 4095) + 1 < 256) ? ((qq) & 4095) + 1 : 256)) ? sel[(size_t)(qq) * 256 + ttid] : 0)
#define DSA_QLOAD(qq) do { const GAS bf16_t* qp_ = qabs + (size_t)(qq) * 16384 + (lane & 31) * 512 + 128 * wq + 8 * h; _Pragma("unroll") for (int s_ = 0; s_ < 8; ++s_) qf[s_] = *(const GAS bf16x8*)(qp_ + 16 * s_); } while (0)
#define DSA_GATHER(ST, lr, tab, cc) do { _Pragma("unroll") for (int i = 0; i < 8; ++i) ST[i] = *(const GAS u32x4*)((lr) + (size_t)(tab)[32 * (cc) + gr + 4 * i] * 512); } while (0)
    int qp = bx, par = 0;
    bf16x8 qf[8]; u32x4 stA[8], stB[8];
    int nxt_idx = 0;
    { const int q0 = 2 * qp + team;
      DSA_TABLES(0, q0, sel[(size_t)q0 * 256 + ttid]);
      if (qp + G < 4096) nxt_idx = DSA_SELLOAD(q0 + 2 * G);
      DSA_QLOAD(q0);
      TEAM_BAR();
      const GAS bf16_t* lr0 = lat + (size_t)(q0 >> 12) * SEQ * 512 + 128 * wq + gc * 8;
      DSA_GATHER(stA, lr0, TAB_SEL(0), 0); DSA_GATHER(stB, lr0, TAB_SEL(0), 1); }
    for (; qp < 4096; qp += G, par ^= 1) {
        const int q = 2 * qp + team, b = q >> 12;
        const bool has_next = qp + G < 4096; const int qn = q + 2 * G;
        const LAS int* selP = TAB_SEL(par); const LAS int* bktP = TAB_BKT(par); const LAS int* selN = TAB_SEL(par ^ 1);
        const GAS bf16_t* lrow = lat + (size_t)b * SEQ * 512 + 128 * wq + gc * 8;
        const GAS bf16_t* lrowN = lat + (size_t)(qn >> 12) * SEQ * 512 + 128 * wq + gc * 8;
        f32x16 o[4];
#pragma unroll
        for (int c = 0; c < 4; ++c)
#pragma unroll
            for (int r = 0; r < 16; ++r) o[c][r] = 0.f;
        float m = -1e30f, l = 0.f;
#define DSA_CHUNK(ST, c) do { \
            _Pragma("unroll") for (int i = 0; i < 8; ++i) *(LAS u32x4*)(latw + (wbase ^ (unsigned)((i & 3) << 4)) + 1024 * i) = ST[i];        \
            if ((c) + 2 < 8) DSA_GATHER(ST, lrow, selP, (c) + 2); else if (has_next) DSA_GATHER(ST, lrowN, selN, (c) + 2 - 8);        \
            f32x16 sc[1]; \
            _Pragma("unroll") for (int r = 0; r < 16; ++r) sc[0][r] = 0.f; \
            _Pragma("unroll") for (int s_ = 0; s_ < 8; ++s_) { const bf16x8 af = *(const LAS bf16x8*)(latw + (kbase ^ (unsigned)(s_ << 5))); sc[0] = __builtin_amdgcn_mfma_f32_32x32x16_bf16(af, qf[s_], sc[0], 0, 0, 0); } \
            if ((c) == 7 && has_next) DSA_QLOAD(qn);            \
            LAS unsigned char* xc = xch + ((c) & 1) * 8192; \
            _Pragma("unroll") for (int g8 = 0; g8 < 2; ++g8) *(LAS bf16x8*)(xc + wq * 2048 + (g8 * 64 + lane) * 16) = pack8(sc[0], 8 * g8);        \
            TEAM_BAR();                                        \
              \
            float lg[4]; float mx; \
            { f32x4 v = {0.f, 0.f, 0.f, 0.f}; \
              _Pragma("unroll") for (int w = 0; w < 4; ++w) { const u32x2 pw = *(const LAS u32x2*)(xc + w * 2048 + qoff); v = v + (f32x4){bflo(pw.x), bfhi(pw.x), bflo(pw.y), bfhi(pw.y)}; } \
              const u32x4 bk4 = *(const LAS u32x4*)(bktP + 32 * (c) + 8 * wq + 4 * h); \
              _Pragma("unroll") for (int e = 0; e < 4; ++e) { const float bias = *(const LAS float*)((const LAS unsigned char*)t5c + bk4[e] + 4 * (lane & 31)); lg[e] = v[e] * cs + bias; } \
              mx = xhalf_max(fmaxf(fmaxf(lg[0], lg[1]), fmaxf(lg[2], lg[3]))); } \
            if ((c) == 0) {                                    \
                *(LAS float*)(mbuf + (lane & 31) * 16 + wq * 4) = mx; \
                TEAM_BAR(); \
                const f32x4 m4 = *(const LAS f32x4*)(mbuf + (lane & 31) * 16); m = fmaxf(fmaxf(m4[0], m4[1]), fmaxf(m4[2], m4[3])); \
            } \
              \
            { const float p0 = fast_exp2(fminf(lg[0] - m, 100.f)), p1 = fast_exp2(fminf(lg[1] - m, 100.f)), p2 = fast_exp2(fminf(lg[2] - m, 100.f)), p3 = fast_exp2(fminf(lg[3] - m, 100.f)); \
              l += (p0 + p1) + (p2 + p3); \
              *(LAS u32x2*)(pbuf + qoff) = (u32x2){cvtpk(p0, p1), cvtpk(p2, p3)}; \
              if ((c) != 0) *(LAS float*)(mbuf + (lane & 31) * 16 + wq * 4) = mx; } \
            TEAM_BAR();                                        \
            bf16x8 p[1][2]; \
            p[0][0] = *(const LAS bf16x8*)(pbuf + lane * 16); p[0][1] = *(const LAS bf16x8*)(pbuf + (64 + lane) * 16); \
            _Pragma("unroll") for (int cc = 0; cc < 4; ++cc) \
                _Pragma("unroll") for (int s_ = 0; s_ < 2; ++s_) { const bf16x8 af = vfrag2(latw, vbase, cc, 4096 * s_); o[cc] = __builtin_amdgcn_mfma_f32_32x32x16_bf16(af, p[0][s_], o[cc], 0, 0, 0); } \
            if ((c) != 0) {                                    \
                const f32x4 m4 = *(const LAS f32x4*)(mbuf + (lane & 31) * 16); const float mxa = fmaxf(fmaxf(m4[0], m4[1]), fmaxf(m4[2], m4[3])); \
                if (__any(mxa > m + 8.0f)) { const float mn = fmaxf(m, mxa), alpha = fast_exp2(m - mn); l *= alpha; m = mn; \
                    _Pragma("unroll") for (int cc = 0; cc < 4; ++cc) o[cc] = o[cc] * alpha; } \
            } \
            if ((c) == 3 && has_next) { DSA_TABLES(par ^ 1, qn, nxt_idx);        \
                if (qp + 2 * G < 4096) nxt_idx = DSA_SELLOAD(qn + 2 * G); } \
        } while (0)
        for (int c2 = 0; c2 < 8; c2 += 2) { DSA_CHUNK(stA, c2); DSA_CHUNK(stB, c2 + 1); }
#undef DSA_CHUNK
        l = xhalf_sum(l);
        *(LAS float*)(lbuf + (lane & 31) * 16 + wq * 4) = l;
        TEAM_BAR();
        const f32x4 l4 = *(const LAS f32x4*)(lbuf + (lane & 31) * 16);
        const float il = 1.0f / ((l4[0] + l4[1]) + (l4[2] + l4[3]));
        GAS bf16_t* op = olat + (size_t)q * 16384 + (lane & 31) * 512 + 128 * wq + 4 * h;
#pragma unroll
        for (int cc = 0; cc < 4; ++cc)
#pragma unroll
            for (int g4 = 0; g4 < 4; ++g4) { u32x2 w; w.x = cvtpk(o[cc][4 * g4] * il, o[cc][4 * g4 + 1] * il); w.y = cvtpk(o[cc][4 * g4 + 2] * il, o[cc][4 * g4 + 3] * il); *(GAS u32x2*)(op + 32 * cc + 8 * g4) = w; }
    }
    __syncthreads();
#undef TEAM_BAR
#undef TAB_SEL
#undef TAB_BKT
#undef DSA_TABLES
#undef DSA_SELLOAD
#undef DSA_QLOAD
#undef DSA_GATHER
}

constexpr int PH_FINAL = 50, NPH = PH_FINAL + 1;

struct TJob { int in_id; long src_lstride; int ldsrc, K, src_col0, ncols; long dst_off  ; int ldt, dst_row0, gain_id; long gain_lstride, gain_off0; int lsel, flags; };
constexpr int NTJ_E = 12, NTJ_O = 11;
__constant__ TJob g_tj_even[NTJ_E] = {
#define EWIN_JOB(c0, n, r0) {I_EWIN, (long)4096 * 12816, 12816, 4096, c0, n, (long)WS_EWIN, 4096, r0, I_NORMG, (long)2 * 4096, 0, 0, 2}
    EWIN_JOB(0, 2048, E_QA), EWIN_JOB(2048, 2048, E_KA), EWIN_JOB(4096, 2048, E_VA), EWIN_JOB(6160, 2048, E_GA), EWIN_JOB(8208, 2048, E_QB),
    EWIN_JOB(10768, 2048, E_GB), EWIN_JOB(10256, 256, E_KB), EWIN_JOB(10512, 256, E_VB), EWIN_JOB(6144, 16, E_FA),
    {I_EWOUT, (long)4096 * 4096, 4096, 4096, 0, 4096, (long)WS_EWOUT, 4096, 0, -1, 0, 0, 0, 2},
    {I_PWGATE, (long)4096 * 4096, 4096, 4096, 0, 4096, (long)WS_EGATE, 4096, 0, I_PNORMG, (long)4096, 0, 1, 2},
    {I_PWPROJ, (long)256 * 4096, 4096, 256, 0, 4096, (long)WS_EPROJ, 256, 0, -1, 0, 0, 1, 0},
};
__constant__ TJob g_tj_odd[NTJ_O] = {
#define OWIN_JOB(c0, n, r0) {I_OWIN, (long)4096 * 5728, 5728, 4096, c0, n, (long)WS_OWIN, 4096, r0, I_NORMG, (long)2 * 4096, 4096, 0, 0}
    {I_OWIN, (long)4096 * 5728, 5728, 4096, 1632, 4096, (long)WS_OWIN8, 4096, 0, I_NORMG, (long)2 * 4096, 4096, 0, 2},
    OWIN_JOB(0, 1024, 0), OWIN_JOB(1024, 512, 1024), OWIN_JOB(1536, 64, 1536), OWIN_JOB(1600, 32, 1600),
    {I_OWOUT, (long)4096 * 4096, 4096, 4096, 0, 4096, (long)WS_OWOUT, 4096, 0, -1, 0, 0, 0, 2},
    {I_PWGATE, (long)4096 * 4096, 4096, 4096, 0, 4096, (long)WS_OGATE, 4096, 0, I_PNORMG, (long)4096, 0, 1, 2},
    {I_PWPROJ, (long)256 * 4096, 4096, 256, 0, 4096, (long)WS_OPROJ, 256, 0, -1, 0, 0, 1, 0},
    {I_OWUQ,  (long)1024 * 4096, 4096, 1024, 0, 4096, (long)WS_OWUQ, 1024, 0,    -1, 0, 0, 0, 0},
    {I_OWUQI, (long)1024 * 2048, 2048, 1024, 0, 2048, (long)WS_OWUQ, 1024, 4096, -1, 0, 0, 0, 0},
    {I_OWUV, (long)512 * 4096, 4096, 512, 0, 4096, (long)WS_OWUV, 1024, 0, -1, 0, 0, 0, 1},
};

__device__ __forceinline__ void transpose_item(const Args& a, GAS unsigned char* ws, const TJob& jb, int L, int item, LAS float* scr, int lane) {
    const int ncb = (jb.ncols + 31) >> 5, kb = item / ncb, nb = item % ncb, k0 = 64 * kb, n0 = 32 * nb;
    const int li = jb.lsel ? L : (L >> 1);
    const GAS float* W = (const GAS float*)a.in[jb.in_id] + (size_t)li * jb.src_lstride;
    const GAS float* gain = jb.gain_id >= 0 ? (const GAS float*)a.in[jb.gain_id] + (size_t)li * jb.gain_lstride + jb.gain_off0 : nullptr;
    const int r8 = lane >> 3, c4 = lane & 7; const bool cv = (n0 + 4 * c4) < jb.ncols;
    f32x4 v[8];
    const GAS float* src = W + (size_t)(k0 + r8) * jb.ldsrc + jb.src_col0 + n0 + 4 * c4;
#pragma unroll
    for (int i = 0; i < 8; ++i) v[i] = cv ? __builtin_nontemporal_load((const GAS f32x4*)(src + (size_t)(8 * i) * jb.ldsrc)) : (f32x4){0.f, 0.f, 0.f, 0.f};
    const int c = lane & 7;
    f32x4 g0 = {1.f, 1.f, 1.f, 1.f}, g1 = g0;
    if (gain) { g0 = *(const GAS f32x4*)(gain + k0 + 8 * c); g1 = *(const GAS f32x4*)(gain + k0 + 8 * c + 4); }
#pragma unroll
    for (int i = 0; i < 8; ++i) { LAS float* d = scr + (8 * i + r8) * 33 + 4 * c4; d[0] = v[i][0]; d[1] = v[i][1]; d[2] = v[i][2]; d[3] = v[i][3]; }
    LDS_WAIT(); asm volatile("" ::: "memory");
    GAS bf16_t* WT = (GAS bf16_t*)(ws + jb.dst_off);
#pragma unroll
    for (int j = 0; j < 4; ++j) { const int n = (lane >> 3) + 8 * j; const LAS float* s = scr + (8 * c) * 33 + n;
        int drow = jb.dst_row0 + n0 + n, dk = k0 + 8 * c;
        if (jb.flags & 2) {
            u32x2 q; q.x = pack4_q8_(s[0 * 33] * g0[0] * W8_SCALE, s[1 * 33] * g0[1] * W8_SCALE, s[2 * 33] * g0[2] * W8_SCALE, s[3 * 33] * g0[3] * W8_SCALE);
            q.y = pack4_q8_(s[4 * 33] * g1[0] * W8_SCALE, s[5 * 33] * g1[1] * W8_SCALE, s[6 * 33] * g1[2] * W8_SCALE, s[7 * 33] * g1[3] * W8_SCALE);
            *(GAS u32x2*)((GAS unsigned char*)ws + jb.dst_off + (size_t)drow * jb.ldt + dk) = q; continue; }
        u32x4 o; o.x = cvtpk(s[0 * 33] * g0[0], s[1 * 33] * g0[1]); o.y = cvtpk(s[2 * 33] * g0[2], s[3 * 33] * g0[3]); o.z = cvtpk(s[4 * 33] * g1[0], s[5 * 33] * g1[1]); o.w = cvtpk(s[6 * 33] * g1[2], s[7 * 33] * g1[3]);
        if (jb.flags & 1) { const int col = n0 + n, h = col >> 7, d = col & 127; drow = (h >> 1) * 256 + (h & 1) * 128 + d; dk = (h & 1) * 512 + k0 + 8 * c; }
        *(GAS u32x4*)(WT + (size_t)drow * jb.ldt + dk) = o; }
    LDS_WAIT(); asm volatile("" ::: "memory");
}

__device__ __forceinline__ void convert_layer_weights(const Args& a, int L, LAS unsigned char* lds, int gw, int NGW, int wave) {
    const int lane = lane_id_();
    unsigned char* ws_ = a.ws; OPAQUE_S(ws_); GAS unsigned char* ws = (GAS unsigned char*)ws_;
    LAS float* scr = (LAS float*)(lds + wave * 16384);
    const bool odd = (L & 1) != 0; const int nj = odd ? NTJ_O : NTJ_E;
    int jstart = 0;
    for (int j = 0; j < nj; ++j) {
        const TJob jb = odd ? g_tj_odd[j] : g_tj_even[j];
        const int nitems = (jb.K >> 6) * ((jb.ncols + 31) >> 5);
        const int first = (gw - (jstart % NGW) + NGW) % NGW;
        for (int it = first; it < nitems; it += NGW) transpose_item(a, ws, jb, L, it, scr, lane);
        jstart += nitems;
    }
    if (!odd) {
        GAS u32x4* z = (GAS u32x4*)(ws + WS_EWIN + (size_t)12832 * 4096); const int n = 224 * 4096 / 16;
        for (int i = gw * 64 + lane; i < n; i += NGW * 64) z[i] = zero4_();
    } else {
        GAS u32x4* z2 = (GAS u32x4*)(ws + WS_OWIN + (size_t)1632 * 4096 * 2); const int n2 = 160 * 4096 * 2 / 16;
        for (int i = gw * 64 + lane; i < n2; i += NGW * 64) z2[i] = zero4_();
        GAS u32x4* z3 = (GAS u32x4*)(ws + WS_OWUV);
        for (int i = gw * 64 + lane; i < 4096 * 64; i += NGW * 64) { const int r = i >> 6, c16 = i & 63; const int zh = ((r >> 7) & 1) ^ 1; z3[(size_t)r * 128 + zh * 64 + c16] = zero4_(); }
        const GAS f32x4* s = (const GAS f32x4*)(((const GAS float*)a.in[I_OWUK]) + (size_t)(L >> 1) * 512 * 4096); GAS u32x2* d = (GAS u32x2*)(ws + WS_OWUK); const int n = 512 * 4096 / 4;
        for (int i = gw * 64 + lane; i < n; i += NGW * 64) { const f32x4 v = __builtin_nontemporal_load(s + i); d[i] = (u32x2){cvtpk(v[0], v[1]), cvtpk(v[2], v[3])}; }
    }
}

__device__ __forceinline__ void phase_convert(const Args& a, LAS unsigned char* lds, int gw, int NGW, int wave) {
    const int lane = lane_id_();
    unsigned char* ws_ = a.ws; OPAQUE_S(ws_); GAS unsigned char* ws = (GAS unsigned char*)ws_;
    {
        const GAS f32x4* s2 = (const GAS f32x4*)((const GAS float*)a.in[I_P]); GAS u32x2* d2 = (GAS u32x2*)(ws + WS_PB); const int n2 = 4 * M * 256 / 4;
        for (int i = gw * 64 + lane; i < n2; i += NGW * 64) { const f32x4 v = __builtin_nontemporal_load(s2 + i); d2[i] = (u32x2){cvtpk(v[0], v[1]), cvtpk(v[2], v[3])}; }
    }
    {
        const GAS float* x = ((const GAS float*)a.in[I_X]); GAS unsigned char* HQ = ws + WS_HQ; GAS float* asc = (GAS float*)(ws + WS_ASCALE); GAS u64* ss = (GAS u64*)(ws + WS_SUMSQ);
        for (int row = gw; row < M; row += NGW) {
            const GAS f32x4* xr = (const GAS f32x4*)(x + (size_t)row * DM); GAS unsigned* qr = (GAS unsigned*)(HQ + (size_t)row * DM); GAS u32x2* hr = (GAS u32x2*)(ws + WS_H + (size_t)row * DM * 2);
            f32x4 v[16]; float s = 0.f, am = 0.f;
#pragma unroll
            for (int j = 0; j < 16; ++j) { v[j] = xr[lane + 64 * j]; s += (v[j][0] * v[j][0] + v[j][1] * v[j][1]) + (v[j][2] * v[j][2] + v[j][3] * v[j][3]); am = fmaxf(fmaxf(am, fmaxf(fabsf(v[j][0]), fabsf(v[j][1]))), fmaxf(fabsf(v[j][2]), fabsf(v[j][3]))); }
            s = wave_sum(s);
#pragma unroll
            for (int o = 1; o < 64; o <<= 1) am = fmaxf(am, __shfl_xor(am, o));
            am = fmaxf(am, 1e-20f); const float qs = 127.0f / am;
#pragma unroll
            for (int j = 0; j < 16; ++j) { qr[lane + 64 * j] = pack4_q8_(v[j][0] * qs, v[j][1] * qs, v[j][2] * qs, v[j][3] * qs); hr[lane + 64 * j] = (u32x2){cvtpk(v[j][0], v[j][1]), cvtpk(v[j][2], v[j][3])}; }
            if (lane == 0) { ss[row] = ss_fix(s); asc[row] = am * (1.0f / 127.0f); }
        }
    }
}

__device__ __forceinline__ void phase_quant_yin(const Args& a, int gw, int NGW) {
    const int lane = lane_id_();
    unsigned char* ws_ = a.ws; OPAQUE_S(ws_); GAS unsigned char* ws = (GAS unsigned char*)ws_;
    const GAS bf16_t* yin = (const GAS bf16_t*)(ws + WS_YIN); GAS unsigned char* yq = ws + WS_YQ; GAS float* asc = (GAS float*)(ws + WS_ASCALEY);
    for (int row = gw; row < M; row += NGW) {
        const GAS u32x4* yr = (const GAS u32x4*)(yin + (size_t)row * DM); GAS u32x2* qr = (GAS u32x2*)(yq + (size_t)row * DM);
        u32x4 w[8]; float am = 0.f;
#pragma unroll
        for (int j = 0; j < 8; ++j) { w[j] = yr[lane + 64 * j];
            am = fmaxf(am, fmaxf(fmaxf(fmaxf(fabsf(bflo(w[j].x)), fabsf(bfhi(w[j].x))), fmaxf(fabsf(bflo(w[j].y)), fabsf(bfhi(w[j].y)))), fmaxf(fmaxf(fabsf(bflo(w[j].z)), fabsf(bfhi(w[j].z))), fmaxf(fabsf(bflo(w[j].w)), fabsf(bfhi(w[j].w)))))); }
#pragma unroll
        for (int o = 1; o < 64; o <<= 1) am = fmaxf(am, __shfl_xor(am, o));
        am = fmaxf(am, 1e-20f); const float qs = 127.0f / am;
#pragma unroll
        for (int j = 0; j < 8; ++j) { u32x2 q; q.x = pack4_q8_(bflo(w[j].x) * qs, bfhi(w[j].x) * qs, bflo(w[j].y) * qs, bfhi(w[j].y) * qs); q.y = pack4_q8_(bflo(w[j].z) * qs, bfhi(w[j].z) * qs, bflo(w[j].w) * qs, bfhi(w[j].w) * qs); qr[lane + 64 * j] = q; }
        if (lane == 0) asc[row] = am * (1.0f / 127.0f);
    }
}
__device__ __forceinline__ void phase_final(const Args& a, int gw, int NGW) {
    const int lane = lane_id_();
    unsigned char* ws_ = a.ws; OPAQUE_S(ws_); GAS unsigned char* ws = (GAS unsigned char*)ws_;
    const GAS bf16_t* H = (const GAS bf16_t*)(ws + WS_H); const GAS u64* ss = (const GAS u64*)(ws + WS_SUMSQ) + 4 * M; const GAS f32x4* g = (const GAS f32x4*)((const GAS float*)a.in[I_FINALG]);
    for (int row = gw; row < M; row += NGW) {
        const float r = 1.0f / sqrtf((float)ss[row] * (1.0f / 16777216.0f) * (1.0f / 4096.0f) + EPS);
        const GAS u32x2* hr = (const GAS u32x2*)(H + (size_t)row * DM); GAS f32x4* orow = (GAS f32x4*)(a.out + (size_t)row * DM);
#pragma unroll 4
        for (int j = 0; j < 16; ++j) { const u32x2 hw = hr[lane + 64 * j]; const f32x4 v = (f32x4){bflo(hw.x), bfhi(hw.x), bflo(hw.y), bfhi(hw.y)}, gg = g[lane + 64 * j]; orow[lane + 64 * j] = v * r * gg; }
    }
}

__global__ void __launch_bounds__(512, 2) fwd(Args args) {
    extern __shared__ __attribute__((aligned(16))) unsigned char lds_raw[];
    LAS unsigned char* lds = (LAS unsigned char*)lds_raw;
    volatile LAS unsigned* MISC = (volatile LAS unsigned*)(lds + MISC_OFF);
    const int wave0 = __builtin_amdgcn_readfirstlane((int)threadIdx.x >> 6);
    if (wave0 == 0) { const int l_ = lane_id_(); MISC[l_] = (l_ == 16) ? (unsigned)gridDim.x : (l_ == 17) ? (unsigned)blockIdx.x : (l_ == 18) ? (unsigned)args.ph_lo : (l_ == 19) ? (unsigned)args.ph_hi : 0u; }
    __syncthreads();
#define KS_RD(i) ((int)__builtin_amdgcn_readfirstlane((int)*(volatile LAS unsigned*)(size_t)(opaque_vu_((unsigned)MISC_OFF) + 4u * (i))))
#define KS_G0 KS_RD(16)
#define KS_BX0 KS_RD(17)
#define KS_LO KS_RD(18)
#define KS_HI KS_RD(19)
    if (KS_HI - KS_LO > 1) (void)xcd_barrier_post((unsigned*)(args.ws + WS_CTL), MISC + 8, wave0);
#define IN(k) (KS_LO <= (k) && (k) < KS_HI)
#define PHASE_LOCALS() int wave = wave0, G = KS_G0, bx = KS_BX0; asm volatile("" : "+s"(wave), "+s"(G), "+s"(bx)); const int gw = bx * 8 + wave, NGW = G * 8; (void)gw; (void)NGW; \
        unsigned char* ws = args.ws; OPAQUE_S(ws); u64* sumsq = (u64*)(ws + WS_SUMSQ); (void)sumsq; \
        bf16_t* hb_cur = (bf16_t*)(ws + (hbswap ? WS_HBB : WS_HBA)); bf16_t* hb_oth = (bf16_t*)(ws + (hbswap ? WS_HBA : WS_HBB)); (void)hb_cur; (void)hb_oth
#undef SEAM
#define SEAM(k) do { if (IN(k) && IN((k) + 1)) { int wave = wave0; asm volatile("" : "+s"(wave)); unsigned char* _w = args.ws; OPAQUE_S(_w); XcdBarrier _b; _b.bar = (unsigned*)(_w + WS_CTL); _b.x = xb_xcc_id(); _b.st = (volatile LAS unsigned*)(lds + MISC_OFF) + 8; xcd_barrier(_b, wave); } } while (0)
    for (int L = -1; L < 4; ++L) {
        const int base = 10 * (L + 1); const bool odd = L >= 0 && (L & 1) != 0;
        const bool mixed = MK_STAGE >= (odd ? 3 : 2);
        const bool hbswap = (MK_STAGE < 3) && ((MK_STAGE == 1 && (L & 1)) || (MK_STAGE == 2 && L >= 2));
        if (IN(base + 0) && mixed && L >= 0)
#pragma unroll 1
        for (int rep_ = 0; rep_ < (((MK_DUP & (1024 | (1 << 26))) && !odd) || ((MK_DUP & 2048) && odd) ? 2 : 1); ++rep_) {
            PHASE_LOCALS();
            if (odd) {
                {
                    pg8::Gemm g{(const bf16_t*)(ws + WS_HQ), (const bf16_t*)(ws + WS_OWIN8), DM, DM, DM, 32, 16, 1, 0, 0};
                    pg8::Sched S; S.init(g, G, bx);
                    pg8::EpiBf16Q E{(bf16_t*)(ws + WS_PROJ), ON, sumsq + L * M, (const float*)(ws + WS_ASCALE), nullptr, 0};
                    pg8::gemm_phase<pg8::EpiBf16Q, true>(lds, g, S, E, wave); }
                {
                    PHASE_LOCALS();
                    pg8::Gemm g{(const bf16_t*)(ws + WS_H), (const bf16_t*)(ws + WS_OWIN), DM, DM, DM, 32, 7, 1, 0, 0};
                    pg8::Sched S; S.init(g, G, bx);
                    pg8::EpiBf16 E{(bf16_t*)(ws + WS_PROJ) + 4096, ON, 0, sumsq + L * M};
                    pg8::gemm_phase(lds, g, S, E, wave); }
            } else {
                pg8::Gemm g{(const bf16_t*)(ws + WS_HQ), (const bf16_t*)(ws + WS_EWIN), DM, DM, DM, 32, EN / 256, 1, 0, 0};
                pg8::Sched S; S.init(g, G, bx);
                pg8::EpiBf16Q E{(bf16_t*)(ws + WS_PROJ), EN, sumsq + L * M, (const float*)(ws + WS_ASCALE), (u64*)(ws + WS_KN) + (size_t)(L >> 1) * 16 * M, ((MK_DUP & (1 << 26)) && rep_ == 0) ? 1 : 0};
                pg8::gemm_phase<pg8::EpiBf16Q, true>(lds, g, S, E, wave);
            }
        }
        if (L >= 0) SEAM(base + 0);
        if (IN(base + 1)) {
            PHASE_LOCALS();
            if (mixed && !odd && L >= 0) { phase_even_attn(args, L >> 1, lds, G, bx, wave, 3); if (MK_DUP & 1) phase_even_attn(args, L >> 1, lds, G, bx, wave, 3); if (MK_DUP & 32) phase_even_attn(args, L >> 1, lds, G, bx, wave, 1); if (MK_DUP & 64) phase_even_attn(args, L >> 1, lds, G, bx, wave, 2); }
            if (mixed && odd) for (int rep_ = 0; rep_ < ((MK_DUP & 65536) ? 2 : 1); ++rep_) phase_odd_norms(args, L >> 1, gw, NGW);
            __syncthreads();
            if (L < 0) for (int rep_ = 0; rep_ < ((MK_DUP & 262144) ? 2 : 1); ++rep_) phase_convert(args, lds, gw, NGW, wave);
            if (L < 3) for (int rep = 0; rep < ((MK_DUP & 8) ? 2 : 1); ++rep) convert_layer_weights(args, L + 1, lds, gw, NGW, wave);
            __syncthreads();
        }
        SEAM(base + 1);
        if (mixed && odd) {
            if (IN(base + 2))
#pragma unroll 1
            for (int rep_ = 0; rep_ < ((MK_DUP & 4096) ? 2 : 1); ++rep_) {
                PHASE_LOCALS();
                pg8::Gemm g{(const bf16_t*)(ws + WS_CQN), (const bf16_t*)(ws + WS_OWUQ), 1024, 1024, 1024, 32, QW / 256, 1, 0, 0};
                pg8::Sched S; S.init(g, G, bx);
                pg8::EpiBf16 E{(bf16_t*)(ws + WS_QBUF), QW, 0, nullptr};
                pg8::gemm_phase(lds, g, S, E, wave);
            }
            SEAM(base + 2);
            if (IN(base + 3)) {
#pragma unroll 1
                for (int rep_ = 0; rep_ < ((MK_DUP & 8192) ? 2 : 1); ++rep_) { PHASE_LOCALS();
                  pg8::Gemm g{(const bf16_t*)(ws + WS_QBUF), (const bf16_t*)(ws + WS_OWUK), QW, 4096, 128, 32, 2, 32, 128, 128};
                  pg8::Sched S; S.init(g, G, bx);
                  pg8::EpiBf16 E{(bf16_t*)(ws + WS_QABS), 16384, 512, nullptr};
                  pg8::gemm_phase(lds, g, S, E, wave); }
                { PHASE_LOCALS(); if (MK_DUP & 128) phase_indexer(args, lds, G, bx, wave, false); phase_indexer(args, lds, G, bx, wave, true); if (MK_DUP & 2) phase_indexer(args, lds, G, bx, wave, true); }
            }
            SEAM(base + 3);
            if (IN(base + 4)) { PHASE_LOCALS(); phase_dsa(args, lds, G, bx, wave, 0); if (MK_DUP & 4) phase_dsa(args, lds, G, bx, wave, 0); }
            SEAM(base + 4);
            if (IN(base + 5))
#pragma unroll 1
            for (int rep_ = 0; rep_ < ((MK_DUP & 16384) ? 2 : 1); ++rep_) {
                PHASE_LOCALS();
                pg8::Gemm g{(const bf16_t*)(ws + WS_OLAT), (const bf16_t*)(ws + WS_OWUV), 16384, 1024, 1024, 32, 1, 16, 1024, (size_t)256 * 1024};
                pg8::Sched S; S.init(g, G, bx);
                pg8::EpiOGate E{(bf16_t*)(ws + WS_YIN), (const bf16_t*)(ws + WS_PROJ) + O_GC, ON};
                pg8::gemm_phase(lds, g, S, E, wave);
            }
            SEAM(base + 5);
        }
        const int phq = odd ? base + 6 : base + 2, ph5 = phq + 1, ph6 = ph5 + 1;
        if (IN(phq) && L >= 0) for (int rep_ = 0; rep_ < ((MK_DUP & 32768) ? 2 : 1); ++rep_) { PHASE_LOCALS(); phase_quant_yin(args, gw, NGW); }
        if (L >= 0) SEAM(phq);
        if (IN(ph5) && L >= 0) {
            if (mixed) {
                PHASE_LOCALS();
                pg8::Gemm g{(const bf16_t*)(ws + WS_YQ), (const bf16_t*)(ws + (odd ? WS_OWOUT : WS_EWOUT)), DM, DM, DM, 32, 16, 1, 0, 0};
                pg8::Sched S; S.init(g, G, bx);
                pg8::EpiResid E{(const bf16_t*)(ws + WS_H), (bf16_t*)(ws + WS_H), (signed char*)(ws + WS_HBB), (float*)(ws + WS_ASCALE1), sumsq + L * M, sumsq + (5 + L) * M, (const float*)(ws + WS_ASCALEY)};
                pg8::gemm_phase<pg8::EpiResid, true>(lds, g, S, E, wave);
            }
#pragma unroll 1
            for (int rep_ = 0; rep_ < ((MK_DUP & 131072) ? 2 : 1); ++rep_) {
                PHASE_LOCALS();
                pg8::Gemm g{(const bf16_t*)(ws + WS_PB) + (size_t)L * M * 256, (const bf16_t*)(ws + (odd ? WS_OPROJ : WS_EPROJ)), 256, 256, 256, 32, 16, 1, 0, 0};
                pg8::Sched S; S.init(g, G, bx);
                pg8::EpiBf16 E{(bf16_t*)(ws + WS_PP), DM, 0, nullptr};
                pg8::gemm_phase(lds, g, S, E, wave);
            }
        }
        if (L >= 0) SEAM(ph5);
        if (IN(ph6) && L >= 0) {
            PHASE_LOCALS();
            pg8::Gemm g{(const bf16_t*)(ws + WS_HBB), (const bf16_t*)(ws + (odd ? WS_OGATE : WS_EGATE)), DM, DM, DM, 32, 16, 1, 0, 0};
            pg8::Sched S; S.init(g, G, bx);
            pg8::EpiGate E{(bf16_t*)(ws + WS_H), (const bf16_t*)(ws + WS_PP), sumsq + (mixed ? (5 + L) : L) * M, sumsq + (L + 1) * M, (L < 3) ? (signed char*)(ws + WS_HQ) : nullptr, (float*)(ws + WS_ASCALE), (const float*)(ws + WS_ASCALE1)};
            pg8::gemm_phase<pg8::EpiGate, true>(lds, g, S, E, wave);
        }
        if (L >= 0) SEAM(ph6);
    }
    if (IN(PH_FINAL)) for (int rep_ = 0; rep_ < ((MK_DUP & 524288) ? 2 : 1); ++rep_) phase_final(args, KS_BX0 * 8 + wave0, KS_G0 * 8);
#undef IN
#undef SEAM
}

extern "C" void kernel_launch(void* const* d_in, const int* in_sizes, int n_in, void* d_out, int out_size, void* d_ws, size_t ws_size, hipStream_t stream) {
    static int grid = 0;
    if (grid == 0) {
        if (n_in != 22 || out_size != M * DM || ws_size < WS_END) { fprintf(stderr, "kernel_launch: unexpected shapes (n_in %d out %d ws %zu, need %zu)\n", n_in, out_size, ws_size, (size_t)WS_END); grid = -1; return; }
        int dev = 0, cus = 0, per_cu = 0;
        if (hipGetDevice(&dev) != hipSuccess || hipDeviceGetAttribute(&cus, hipDeviceAttributeMultiprocessorCount, dev) != hipSuccess) { grid = -1; return; }
        if (hipFuncSetAttribute((const void*)fwd, hipFuncAttributeMaxDynamicSharedMemorySize, LDS_BYTES) != hipSuccess) { fprintf(stderr, "kernel_launch: hipFuncSetAttribute failed\n"); grid = -1; return; }
        if (hipOccupancyMaxActiveBlocksPerMultiprocessor(&per_cu, (const void*)fwd, 512, LDS_BYTES) != hipSuccess || per_cu < 1) { fprintf(stderr, "kernel_launch: occupancy query says %d\n", per_cu); }
        (void)hipGetLastError();
        grid = cus;
    }
    if (grid < 0) return;
    if (hipMemsetAsync((char*)d_ws + WS_CTL, 0, WS_ZERO_BYTES, stream) != hipSuccess) return;
    Args a{};
    for (int i = 0; i < 22; ++i) a.in[i] = (const float*)d_in[i];
    a.out = (float*)d_out; a.ws = (unsigned char*)d_ws;
#if MK_ONE_LAUNCH
    a.ph_lo = 0; a.ph_hi = NPH;
    hipLaunchKernelGGL(fwd, dim3(grid), dim3(512), LDS_BYTES, stream, a);
#else
    for (int ph = 0; ph < NPH; ++ph) {
        if (ph < PH_FINAL) { const int L = ph / 10 - 1, k = ph % 10; if (L < 0 && k != 1) continue; if (L >= 0 && !(L & 1) && k >= 5) continue; if (L >= 0 && (L & 1) && k >= 9) continue; }
        a.ph_lo = ph; a.ph_hi = ph + 1;
        hipLaunchKernelGGL(fwd, dim3(grid), dim3(512), LDS_BYTES, stream, a);
    }
#endif
}
```

```cpp
#include <hip/hip_runtime.h>
#include <cstdio>
#include <cstdint>

#define LAS __attribute__((address_space(3)))
#define GAS __attribute__((address_space(1)))
typedef unsigned short bf16_t;
typedef short bf16x8 __attribute__((ext_vector_type(8)));
typedef short s16x4 __attribute__((ext_vector_type(4)));
typedef short v4i16_t __attribute__((ext_vector_type(4)));
typedef float f32x2 __attribute__((ext_vector_type(2)));
typedef float f32x4 __attribute__((ext_vector_type(4)));
typedef float f32x16 __attribute__((ext_vector_type(16)));
typedef unsigned u32x2 __attribute__((ext_vector_type(2)));
typedef unsigned u32x4 __attribute__((ext_vector_type(4)));
typedef __bf16 bf16x2_t __attribute__((ext_vector_type(2)));
typedef GAS unsigned gu32;

#ifndef MK_STAGE
#define MK_STAGE 3
#endif
#ifndef MK_DUP
#define MK_DUP 0
#endif
#ifndef MK_ONE_LAUNCH
#define MK_ONE_LAUNCH 1
#endif

constexpr int M = 8192, DM = 4096, SEQ = 4096;
constexpr float EPS = 1e-6f;
constexpr float LOG2E = 1.4426950408889634f;
constexpr int EN = 13056;
constexpr int ON = 5888;
constexpr int E_QA = 0, E_KA = 2048, E_VA = 4096, E_GA = 6144, E_QB = 8192, E_GB = 10240, E_KB = 12288, E_VB = 12544, E_FA = 12800;
constexpr int O_GC = 0, O_CQ = 4096, O_CKV = 5120, O_KIDX = 5632, O_WIDX = 5696;
constexpr int QW = 6144;

constexpr size_t MiB = 1u << 20;
constexpr size_t WS_CTL = 0;
constexpr size_t WS_SUMSQ = 1 * MiB;
constexpr size_t WS_KN = 2 * MiB;
constexpr size_t WS_ZERO_BYTES = 4 * MiB;
constexpr size_t SZ_SQ = (size_t)4096 * 4096 * 2;
constexpr size_t SZ_WPROJ = (size_t)4096 * 256 * 2;
constexpr size_t WS_EWIN = 4 * MiB;
constexpr size_t WS_EWOUT = WS_EWIN + (size_t)EN * 4096 * 2;
constexpr size_t WS_EGATE = WS_EWOUT + SZ_SQ;
constexpr size_t WS_EPROJ = WS_EGATE + SZ_SQ;
constexpr size_t WS_OWIN = WS_EPROJ + SZ_WPROJ;
constexpr size_t WS_OWIN8 = WS_OWIN + (size_t)1792 * 4096 * 2;
constexpr size_t WS_OWUQ = WS_OWIN + (size_t)ON * 4096 * 2;
constexpr size_t WS_OWUK = WS_OWUQ + (size_t)QW * 1024 * 2;
constexpr size_t WS_OWUV = WS_OWUK + (size_t)512 * 4096 * 2;
constexpr size_t WS_OWOUT = WS_OWUV + (size_t)16 * 256 * 1024 * 2;
constexpr size_t WS_OGATE = WS_OWOUT + SZ_SQ;
constexpr size_t WS_OPROJ = WS_OGATE + SZ_SQ;
constexpr size_t WS_H = WS_OPROJ + SZ_WPROJ;
constexpr size_t WS_HBA = WS_H + (size_t)M * 4096 * 4;
constexpr size_t SZ_ACT = (size_t)M * 4096 * 2;
constexpr size_t WS_HBB = WS_HBA + SZ_ACT;
constexpr size_t WS_YIN = WS_HBB + SZ_ACT;
constexpr size_t WS_SCORE = WS_YIN;
constexpr size_t WS_PP = WS_YIN + SZ_ACT;
constexpr size_t WS_PB = WS_PP + SZ_ACT;
constexpr size_t WS_PROJ = WS_PB + (size_t)4 * M * 256 * 2;
constexpr size_t WS_CQN = WS_PROJ + (size_t)M * EN * 2;
constexpr size_t WS_LAT = WS_CQN + (size_t)M * 1024 * 2;
constexpr size_t WS_KIDX = WS_LAT + (size_t)M * 512 * 2;
constexpr size_t WS_WIDX = WS_KIDX + (size_t)M * 64 * 2;
constexpr size_t WS_SEL = WS_WIDX + (size_t)M * 32 * 4;
constexpr size_t WS_QBUF = WS_SEL + (size_t)M * 256 * 4;
constexpr size_t WS_QABS = WS_QBUF + (size_t)M * QW * 2;
constexpr size_t WS_OLAT = WS_QABS + (size_t)M * 16384 * 2;
constexpr size_t WS_HQ = WS_OLAT + (size_t)M * 16384 * 2;
constexpr size_t WS_ASCALE = WS_HQ + (size_t)M * 4096;
constexpr size_t WS_ASCALE1 = WS_ASCALE + (size_t)M * 4;
constexpr size_t WS_ASCALEY = WS_ASCALE1 + (size_t)M * 4;
constexpr size_t WS_YQ = WS_PROJ;
constexpr size_t WS_END = WS_ASCALEY + (size_t)M * 4;
static_assert(WS_END <= (size_t)4 * 2 * 4096 * 12816 * 4, "workspace map exceeds the guaranteed size (4 x the largest input)");

constexpr int LDS_BYTES = 155648;
constexpr int MISC_OFF = LDS_BYTES - 256;

__device__ __forceinline__ unsigned cvtpk(float lo, float hi) { f32x2 v = {lo, hi}; bf16x2_t b = __builtin_convertvector(v, bf16x2_t); return __builtin_bit_cast(unsigned, b); }
__device__ __forceinline__ float bf2f(unsigned short b) { return __uint_as_float(((unsigned)b) << 16); }
__device__ __forceinline__ float bflo(unsigned w) { return __uint_as_float(w << 16); }
__device__ __forceinline__ float bfhi(unsigned w) { return __uint_as_float(w & 0xffff0000u); }
__device__ __forceinline__ float wave_sum(float v) {
#pragma unroll
    for (int o = 1; o < 64; o <<= 1) v += __shfl_xor(v, o);
    return v;
}
__device__ __forceinline__ float xhalf_max(float m) { auto rr = __builtin_amdgcn_permlane32_swap(__float_as_uint(m), __float_as_uint(m), false, false); return fmaxf(__uint_as_float(rr[0]), __uint_as_float(rr[1])); }
__device__ __forceinline__ float xhalf_sum(float m) { auto rr = __builtin_amdgcn_permlane32_swap(__float_as_uint(m), __float_as_uint(m), false, false); return __uint_as_float(rr[0]) + __uint_as_float(rr[1]); }
__device__ __forceinline__ int lane_id_() { int l = (int)__builtin_amdgcn_mbcnt_hi(~0u, __builtin_amdgcn_mbcnt_lo(~0u, 0u)); asm volatile("" : "+v"(l)); return l; }
typedef unsigned long long u64;
__device__ __forceinline__ u64 ss_fix(float s2) { return (u64)(s2 * 16777216.0f); }
__device__ __forceinline__ float ss_rstd(u64 v) { return __builtin_amdgcn_rsqf((float)v * (1.0f / 16777216.0f) * (1.0f / 4096.0f) + EPS); }
__device__ __forceinline__ unsigned opaque_vu_(unsigned v) { asm volatile("" : "+v"(v)); return v; }
__device__ __forceinline__ u32x4 zero4_() { unsigned z = 0u; asm volatile("" : "+v"(z)); return (u32x4){z, z, z, z}; }
typedef int i32x4 __attribute__((ext_vector_type(4)));
constexpr float W8_SCALE = 1354.0f;
__device__ __forceinline__ int q8_(float v) { const int q = (int)__builtin_rintf(v); return q < -127 ? -127 : (q > 127 ? 127 : q); }
__device__ __forceinline__ unsigned pack4_q8_(float a, float b, float c, float d) { return (unsigned)(q8_(a) & 255) | ((unsigned)(q8_(b) & 255) << 8) | ((unsigned)(q8_(c) & 255) << 16) | ((unsigned)(q8_(d) & 255) << 24); }
__device__ __forceinline__ float fast_exp2(float x) { return __builtin_amdgcn_exp2f(x); }
__device__ __forceinline__ float sigmoidf_(float x) { return 1.0f / (1.0f + __expf(-x)); }
__device__ __forceinline__ float siluf_(float x) { return x / (1.0f + __expf(-x)); }
#define OPAQUE_S(p) do { unsigned long long _v = (unsigned long long)(p); unsigned _lo = (unsigned)_v, _hi = (unsigned)(_v >> 32); asm volatile("" : "+v"(_lo), "+v"(_hi)); \
    _lo = __builtin_amdgcn_readfirstlane(_lo); _hi = __builtin_amdgcn_readfirstlane(_hi); (p) = (decltype(p))(((unsigned long long)_hi << 32) | _lo); } while (0)
#define G1(T, p) ((GAS T*)(p))
#define CAS __attribute__((address_space(4)))
__device__ __forceinline__ const float* karg_in(int id) {
    const CAS char* kp = (const CAS char*)__builtin_amdgcn_kernarg_segment_ptr();
    asm volatile("" : "+s"(kp));
    return *(const float* const CAS*)(kp + 8 * id);
}
#define LDS_WAIT() asm volatile("s_waitcnt lgkmcnt(0)" ::: "memory")
#define VM_WAIT() asm volatile("s_waitcnt vmcnt(0)" ::: "memory")

#define XB_TMO      128
#define XB_XCNT(j)  (256  + 64 * (j))
#define XB_XSUB(j)  (1280 + 64 * (j))
#define XB_XGEN(j)  (2304 + 64 * (j))
#define XB_TOP      3328
#define XB_TOPGEN   3392
#define XCD_BAR_WORDS 3456
#define XB_SPIN_CAP (1u << 22)
__device__ __forceinline__ unsigned xb_ld(unsigned* p)              { return __hip_atomic_load((gu32*)p, __ATOMIC_RELAXED, __HIP_MEMORY_SCOPE_AGENT); }
__device__ __forceinline__ unsigned xb_add(unsigned* p, unsigned v) { return __hip_atomic_fetch_add((gu32*)p, v, __ATOMIC_RELAXED, __HIP_MEMORY_SCOPE_AGENT); }
__device__ __forceinline__ unsigned xb_xcc_id() { return (unsigned)__builtin_amdgcn_s_getreg((3 << 11) | 20) & 0xFu; }
#define XB_SPIN(cond, bar) do { unsigned _sp = 0; while (cond) { __builtin_amdgcn_s_sleep(1); \
    if ((++_sp & 255u) == 0u) { if (xb_ld(&(bar)[XB_TMO])) break; if (_sp > XB_SPIN_CAP) { (void)xb_add(&(bar)[XB_TMO], 1u); break; } } } } while (0)
struct XcdBarrier { unsigned* bar; unsigned x; volatile LAS unsigned* st; };
__device__ __forceinline__ XcdBarrier xcd_barrier_post(unsigned* bar, volatile LAS unsigned* st, const int wave) {
    XcdBarrier b; b.bar = bar; b.x = xb_xcc_id(); b.st = st;
    if (wave == 0 && lane_id_() == 0) (void)xb_add(&bar[XB_XCNT(b.x)], 1u);
    return b;
}
__device__ __forceinline__ void xcd_barrier_complete(unsigned* bar, unsigned x, unsigned& nloc, unsigned& nx) {
    const unsigned G = gridDim.x * gridDim.y * gridDim.z;
    unsigned sum, cnt, mine, sp = 0u;
    for (;;) {
        sum = 0u; cnt = 0u; mine = 0u;
#pragma unroll 1
        for (unsigned j = 0; j < 16; ++j) { const unsigned c = xb_ld(&bar[XB_XCNT(j)]); sum += c; cnt += (c > 0u) ? 1u : 0u; mine = (j == x) ? c : mine; }
        if (sum == G) break;
        __builtin_amdgcn_s_sleep(1);
        if ((++sp & 255u) == 0u) { if (xb_ld(&bar[XB_TMO])) break; if (sp > XB_SPIN_CAP) { (void)xb_add(&bar[XB_TMO], 1u); break; } }
    }
    nloc = mine > 0u ? mine : 1u; nx = cnt > 0u ? cnt : 1u;
}
__device__ __forceinline__ void xcd_barrier(const XcdBarrier& b, const int wave) {
    asm volatile("s_waitcnt vmcnt(0)" ::: "memory");
    __syncthreads();
    if (wave == 0 && lane_id_() == 0) {
        unsigned* bar = b.bar;
        __builtin_amdgcn_s_waitcnt(0);
        unsigned nloc = b.st[0], nx = b.st[1];
        if (nloc == 0u) { xcd_barrier_complete(bar, b.x, nloc, nx); b.st[0] = nloc; b.st[1] = nx; }
        const unsigned old = xb_add(&bar[XB_XSUB(b.x)], 1u);
        const unsigned gen = old / nloc;
        if (old + 1u == (gen + 1u) * nloc) {
            __builtin_amdgcn_fence(__ATOMIC_RELEASE, "agent");
            asm volatile("s_waitcnt vmcnt(0)" ::: "memory");
            const unsigned og = xb_add(&bar[XB_TOP], 1u);
            const unsigned tg = og / nx;
            if (og + 1u == (tg + 1u) * nx) xb_add(&bar[XB_TOPGEN], 1u);
            else XB_SPIN(xb_ld(&bar[XB_TOPGEN]) == tg, bar);
            __builtin_amdgcn_fence(__ATOMIC_ACQUIRE, "agent");
            xb_add(&bar[XB_XGEN(b.x)], 1u);
            asm volatile("s_waitcnt vmcnt(0)" ::: "memory");
        } else {
            XB_SPIN(xb_ld(&bar[XB_XGEN(b.x)]) == gen, bar);
            __builtin_amdgcn_fence(__ATOMIC_ACQUIRE, "agent");
            asm volatile("s_waitcnt vmcnt(0)" ::: "memory");
        }
    }
    __syncthreads();
}

namespace pg8 {
__device__ __forceinline__ void glds16_s(const void* sbase, unsigned voff, unsigned lds_dst) {
    unsigned keep;
    asm volatile("s_mov_b32 %0, m0\n\ts_mov_b32 m0, %3\n\ts_nop 0\n\tglobal_load_lds_dwordx4 %1, %2\n\ts_mov_b32 m0, %0" : "=&s"(keep) : "v"(voff), "s"(sbase), "s"(lds_dst) : "memory");
}
constexpr int BM = 256, BK = 64, HALF = 128, HTB = HALF * BK * 2, STAGE_BYTES = 8 * HTB, NXCD = 8, WGM = 8;
__host__ __device__ __forceinline__ int lds_byte(int r, int c) { const int st = (r >> 4) * 2 + (c >> 5), rr = r & 15, cc = c & 31, ob = rr * 64 + cc * 2; return st * 1024 + (ob ^ (((ob >> 9) & 1) << 5)); }
__host__ __device__ __forceinline__ void stage_rc(int b, int& R, int& C) { const int st = b / 1024, sb = b % 1024, swz = sb ^ (((sb >> 9) & 1) << 5); R = (st >> 1) * 16 + swz / 64; C = (st & 1) * 32 + (swz % 64) / 2; }
__host__ __device__ __forceinline__ int perm32(int rho) { const int n = rho >> 4, i = rho & 15; return 8 * (i >> 2) + 4 * n + (i & 3); }

struct Unit { int pm, pn, g; };
struct Gemm { const bf16_t* A; const bf16_t* Bt; int lda, ldb, K, nM, nN, ng; size_t gsA, gsB; };

struct Sched {
    int nM, nN, nwg, total, G, c;
    __device__ void init(const Gemm& g, int G_, int c_) { nM = g.nM; nN = g.nN; nwg = nM * nN; total = nwg * g.ng; G = G_; c = c_; }
    __device__ bool next(int i, Unit& u) const {
        const long L = (long)i * G + c; if (L >= total) return false;
        u.g = (int)(L / nwg); int wgid = (int)(L % nwg);
        { const int q = nwg / NXCD, r = nwg % NXCD, xcd = wgid % NXCD, off = wgid / NXCD; wgid = (xcd < r ? xcd * (q + 1) : r * (q + 1) + (xcd - r) * q) + off; }
        const int nig = WGM * nN, gid = wgid / nig, fm = gid * WGM, gsz = (nM - fm) < WGM ? (nM - fm) : WGM;
        u.pm = fm + ((wgid % nig) % gsz); u.pn = (wgid % nig) / gsz; return true;
    }
};

template <class Epi, bool I8 = false>
__device__ __forceinline__ void gemm_phase(LAS unsigned char* lds, const Gemm g, const Sched& S, const Epi& E, const int wid) {
    const int lane = lane_id_(), tid = wid * 64 + lane;
    const int wr = wid >> 2, wc = wid & 3, fr = lane & 15, fq = lane >> 4;
    const bf16_t* gA = g.A; const bf16_t* gB = g.Bt; OPAQUE_S(gA); OPAQUE_S(gB);
    constexpr int ESZ = I8 ? 1 : 2;
    const int K = g.K, nt = K * ESZ / (BK * 2);
    unsigned voffA[2], voffB[2];
#pragma unroll
    for (int i = 0; i < 2; ++i) { int R, C; stage_rc(tid * 16 + i * 8192, R, C); const int Rb = (R & ~31) + perm32(R & 31);
        voffA[i] = (unsigned)(R * g.lda * ESZ + C * 2); voffB[i] = (unsigned)(Rb * g.ldb * ESZ + C * 2); }
    const size_t kstep = (size_t)(BK * 2);
    const size_t hstepA = (size_t)HALF * g.lda * ESZ, hstepB = (size_t)HALF * g.ldb * ESZ;
    const size_t tstepA = 2 * hstepA, tstepB = 2 * hstepB;
    const unsigned ldsbase = (unsigned)(size_t)lds + (unsigned)wid * 1024u;
    const int aoff = lds_byte(wr * 64 + fr, fq * 8), boff = lds_byte(wc * 32 + fr, fq * 8);
#define PG8_SA(b, h) (((b) * 2 + (h)) * HTB)
#define PG8_SB(b, h) ((4 + (b) * 2 + (h)) * HTB)
#define PG8_STAGE(bufoff, gbase, voff) do { _Pragma("unroll") for (int _i = 0; _i < 2; ++_i) glds16_s((const void*)(gbase), (voff)[_i], ldsbase + (unsigned)((bufoff) + _i * 8192)); } while (0)
#define PG8_LDA(dst, b, h) do { _Pragma("unroll") for (int m = 0; m < 4; ++m) _Pragma("unroll") for (int k = 0; k < 2; ++k) dst[m][k] = *(const LAS bf16x8*)(lds + PG8_SA(b, h) + aoff + m * 2048 + k * 1024); } while (0)
#define PG8_LDB(dst, b, h) do { _Pragma("unroll") for (int n = 0; n < 2; ++n) _Pragma("unroll") for (int k = 0; k < 2; ++k) dst[n][k] = *(const LAS bf16x8*)(lds + PG8_SB(b, h) + boff + n * 2048 + k * 1024); } while (0)
#define PG8_MMA(ai, bj, At, Bt) do { __builtin_amdgcn_s_setprio(1); _Pragma("unroll") for (int m = 0; m < 4; ++m) _Pragma("unroll") for (int n = 0; n < 2; ++n) _Pragma("unroll") for (int k = 0; k < 2; ++k) { \
        if constexpr (I8) acc[ai][bj][m][n] = __builtin_bit_cast(f32x4, __builtin_amdgcn_mfma_i32_16x16x64_i8(__builtin_bit_cast(i32x4, Bt[n][k]), __builtin_bit_cast(i32x4, At[m][k]), __builtin_bit_cast(i32x4, acc[ai][bj][m][n]), 0, 0, 0)); \
        else acc[ai][bj][m][n] = __builtin_amdgcn_mfma_f32_16x16x32_bf16(Bt[n][k], At[m][k], acc[ai][bj][m][n], 0, 0, 0); } __builtin_amdgcn_s_setprio(0); } while (0)
#define PG8_WAIT_V(n) asm volatile("s_waitcnt vmcnt(" #n ")" ::: "memory")
#define PG8_WAIT_L(n) asm volatile("s_waitcnt lgkmcnt(" #n ")" ::: "memory")
#define PG8_BAR __builtin_amdgcn_s_barrier()
#define PG8_SCHED __builtin_amdgcn_sched_barrier(0)
    Unit cur, nxt; int ui = 0;
    if (!S.next(0, cur)) return;
    f32x4 acc[2][2][4][2];
#pragma unroll
    for (int a = 0; a < 2; ++a)
#pragma unroll
        for (int b = 0; b < 2; ++b)
#pragma unroll
            for (int m = 0; m < 4; ++m)
#pragma unroll
                for (int n = 0; n < 2; ++n) acc[a][b][m][n] = (f32x4){0.f, 0.f, 0.f, 0.f};
    bf16x8 At[4][2], B0[2][2], B1[2][2];
    const char* cA = (const char*)(gA + (size_t)cur.g * g.gsA) + (size_t)cur.pm * tstepA; const char* cB = (const char*)(gB + (size_t)cur.g * g.gsB) + (size_t)cur.pn * tstepB;
    PG8_STAGE(PG8_SB(0, 0), cB, voffB); PG8_STAGE(PG8_SB(0, 1), cB + hstepB, voffB); PG8_STAGE(PG8_SA(0, 0), cA, voffA); PG8_STAGE(PG8_SA(0, 1), cA + hstepA, voffA);
    if (wr == 1) PG8_BAR;
    PG8_WAIT_V(2); PG8_BAR;
    PG8_STAGE(PG8_SB(1, 0), cB + kstep, voffB); PG8_STAGE(PG8_SA(1, 0), cA + kstep, voffA); PG8_STAGE(PG8_SB(1, 1), cB + hstepB + kstep, voffB);
    PG8_WAIT_V(6); PG8_BAR;
    for (;;) {
        const bool has_next = S.next(ui + 1, nxt);
        const char* nA = has_next ? (const char*)(gA + (size_t)nxt.g * g.gsA) + (size_t)nxt.pm * tstepA : cA; const char* nB = has_next ? (const char*)(gB + (size_t)nxt.g * g.gsB) + (size_t)nxt.pn * tstepB : cB;
        for (int t = 0; t < nt; t += 2) {
            const bool last = (t == nt - 2);
            const char* a1 = cA + (size_t)(t + 1) * kstep;
            const char* a2 = last ? nA : cA + (size_t)(t + 2) * kstep; const char* b2 = last ? nB : cB + (size_t)(t + 2) * kstep;
            const char* a3 = a2 + kstep; const char* b3 = b2 + kstep;
            PG8_LDB(B0, 0, 0); PG8_LDB(B1, 0, 1); PG8_SCHED; PG8_LDA(At, 0, 0); PG8_STAGE(PG8_SA(1, 1), a1 + hstepA, voffA);
            PG8_WAIT_V(8); PG8_WAIT_L(0); PG8_BAR; PG8_MMA(0, 0, At, B0); PG8_MMA(0, 1, At, B1); PG8_BAR; PG8_SCHED;
            PG8_LDA(At, 0, 1); PG8_STAGE(PG8_SB(0, 0), b2, voffB); PG8_STAGE(PG8_SB(0, 1), b2 + hstepB, voffB); PG8_STAGE(PG8_SA(0, 0), a2, voffA);
            PG8_WAIT_V(8); PG8_WAIT_L(0); PG8_BAR; PG8_MMA(1, 0, At, B0); PG8_MMA(1, 1, At, B1); PG8_BAR; PG8_SCHED;
            PG8_LDB(B0, 1, 0); PG8_LDB(B1, 1, 1); PG8_SCHED; PG8_LDA(At, 1, 0); PG8_STAGE(PG8_SA(0, 1), a2 + hstepA, voffA);
            PG8_WAIT_V(8); PG8_WAIT_L(0); PG8_BAR; PG8_MMA(0, 0, At, B0); PG8_MMA(0, 1, At, B1); PG8_BAR; PG8_SCHED;
            PG8_LDA(At, 1, 1); PG8_STAGE(PG8_SB(1, 0), b3, voffB); PG8_STAGE(PG8_SB(1, 1), b3 + hstepB, voffB); PG8_STAGE(PG8_SA(1, 0), a3, voffA);
            PG8_WAIT_V(8); PG8_WAIT_L(0); PG8_BAR; PG8_MMA(1, 0, At, B0); PG8_MMA(1, 1, At, B1); PG8_BAR; PG8_SCHED;
        }
        if (wr == 0) PG8_BAR;
        { const int l2 = lane_id_(); E(acc, cur, wid >> 2, wid & 3, l2 & 15, l2 >> 4); }
        if (!has_next) break;
#pragma unroll
        for (int a = 0; a < 2; ++a)
#pragma unroll
            for (int b = 0; b < 2; ++b)
#pragma unroll
                for (int m = 0; m < 4; ++m)
#pragma unroll
                    for (int n = 0; n < 2; ++n) acc[a][b][m][n] = (f32x4){0.f, 0.f, 0.f, 0.f};
        cur = nxt; cA = nA; cB = nB; ++ui;
        if (wr == 1) PG8_BAR;
    }
    PG8_WAIT_V(0);
    PG8_BAR;
#undef PG8_SA
#undef PG8_SB
#undef PG8_STAGE
#undef PG8_LDA
#undef PG8_LDB
#undef PG8_MMA
#undef PG8_WAIT_V
#undef PG8_WAIT_L
#undef PG8_BAR
#undef PG8_SCHED
}

struct EpiBf16 {
    bf16_t* O; int ldc; size_t gsO; const u64* ss;
    __device__ __forceinline__ void operator()(const f32x4 (&acc)[2][2][4][2], const Unit& u, int wr, int wc, int fr, int fq) const {
        const int row0 = u.pm * BM + wr * 64 + fr, col0 = u.pn * BM + wc * 32 + 8 * fq;
        bf16_t* base = O + (size_t)u.g * gsO;
        u64 sv[2][4];
        if (ss) {
#pragma unroll
            for (int ai = 0; ai < 2; ++ai)
#pragma unroll
                for (int m = 0; m < 4; ++m) sv[ai][m] = *G1(const u64, ss + row0 + ai * HALF + m * 16);
            __builtin_amdgcn_sched_barrier(0); }
#pragma unroll
        for (int ai = 0; ai < 2; ++ai)
#pragma unroll
            for (int m = 0; m < 4; ++m) { const int row = row0 + ai * HALF + m * 16; bf16_t* rowp = base + (size_t)row * ldc + col0;
                const float sc = ss ? ss_rstd(sv[ai][m]) : 1.0f;
#pragma unroll
                for (int bj = 0; bj < 2; ++bj) { const f32x4 v0 = acc[ai][bj][m][0] * sc, v1 = acc[ai][bj][m][1] * sc;
                    u32x4 w; w.x = cvtpk(v0[0], v0[1]); w.y = cvtpk(v0[2], v0[3]); w.z = cvtpk(v1[0], v1[1]); w.w = cvtpk(v1[2], v1[3]);
                    *G1(u32x4, rowp + bj * HALF) = w; } }
    }
};
struct EpiBf16Q {
    bf16_t* O; int ldc; const u64* ss; const float* ascale; u64* kn; int dry;
    __device__ __forceinline__ void operator()(const f32x4 (&acc)[2][2][4][2], const Unit& u, int wr, int wc, int fr, int fq) const {
        const int row0 = u.pm * BM + wr * 64 + fr, col0 = u.pn * BM + wc * 32 + 8 * fq;
        const bool ktile = kn != nullptr && u.pn >= 8 && u.pn < 16;
        if (dry) { float t_ = 0.f;
#pragma unroll
            for (int ai = 0; ai < 2; ++ai)
#pragma unroll
                for (int bj = 0; bj < 2; ++bj)
#pragma unroll
                    for (int m = 0; m < 4; ++m) t_ += acc[ai][bj][m][0][0] + acc[ai][bj][m][1][3];
            if (t_ == 1.2345e38f) *G1(float, (float*)O) = t_; return; }
        u64 sv[2][4]; float av[2][4];
#pragma unroll
        for (int ai = 0; ai < 2; ++ai)
#pragma unroll
            for (int m = 0; m < 4; ++m) { const int row = row0 + ai * HALF + m * 16; sv[ai][m] = *G1(const u64, ss + row); av[ai][m] = *G1(const float, ascale + row); }
        __builtin_amdgcn_sched_barrier(0);
#pragma unroll
        for (int ai = 0; ai < 2; ++ai)
#pragma unroll
            for (int m = 0; m < 4; ++m) { const int row = row0 + ai * HALF + m * 16; bf16_t* rowp = O + (size_t)row * ldc + col0;
                const float sc = ss_rstd(sv[ai][m]) * av[ai][m] * (1.0f / W8_SCALE);
#pragma unroll
                for (int bj = 0; bj < 2; ++bj) { const i32x4 i0 = __builtin_bit_cast(i32x4, acc[ai][bj][m][0]), i1 = __builtin_bit_cast(i32x4, acc[ai][bj][m][1]);
                    const float f0 = (float)i0[0] * sc, f1 = (float)i0[1] * sc, f2 = (float)i0[2] * sc, f3 = (float)i0[3] * sc, f4 = (float)i1[0] * sc, f5 = (float)i1[1] * sc, f6 = (float)i1[2] * sc, f7 = (float)i1[3] * sc;
                    u32x4 w; w.x = cvtpk(f0, f1); w.y = cvtpk(f2, f3); w.z = cvtpk(f4, f5); w.w = cvtpk(f6, f7);
                    *G1(u32x4, rowp + bj * HALF) = w;
                    if (ktile) { float s2 = (f0 * f0 + f1 * f1) + (f2 * f2 + f3 * f3) + (f4 * f4 + f5 * f5) + (f6 * f6 + f7 * f7); s2 += __shfl_xor(s2, 16); s2 += __shfl_xor(s2, 32);
                        if (fq == 0) (void)__hip_atomic_fetch_add(G1(u64, kn + (size_t)((u.pn - 8) * 2 + bj) * M + row), ss_fix(s2), __ATOMIC_RELAXED, __HIP_MEMORY_SCOPE_AGENT); } } }
    }
};
struct EpiResid {
    const bf16_t* Hin; bf16_t* H; signed char* HQ; float* ascale; const u64* ssin; u64* ssout; const float* ascale_y;
    __device__ __forceinline__ void operator()(const f32x4 (&acc)[2][2][4][2], const Unit& u, int wr, int wc, int fr, int fq) const {
        const int row0 = u.pm * BM + wr * 64 + fr, col0 = u.pn * BM + wc * 32 + 8 * fq;
#pragma unroll
        for (int ai = 0; ai < 2; ++ai) {
        u32x4 hv[2][4][2]; u64 sv[2][4]; float yv[2][4];
#pragma unroll
            for (int m = 0; m < 4; ++m) { const int row = row0 + ai * HALF + m * 16; const bf16_t* hi = Hin + (size_t)row * DM + col0;
                sv[ai][m] = *G1(const u64, ssin + row); yv[ai][m] = *G1(const float, ascale_y + row);
#pragma unroll
                for (int bj = 0; bj < 2; ++bj) hv[ai][m][bj] = *G1(const u32x4, hi + bj * HALF); }
        __builtin_amdgcn_sched_barrier(0);
#pragma unroll
            for (int m = 0; m < 4; ++m) { const int row = row0 + ai * HALF + m * 16; bf16_t* hp = H + (size_t)row * DM + col0; signed char* bp = HQ + (size_t)row * DM + col0; float s2 = 0.f;
                const float qs = 15.875f * ss_rstd(sv[ai][m]);
                if (fq == 0 && wc == 0 && u.pn == 0) *G1(float, ascale + row) = 1.0f / qs;
                const float ys = yv[ai][m] * (1.0f / W8_SCALE);
#pragma unroll
                for (int bj = 0; bj < 2; ++bj) { const i32x4 i0 = __builtin_bit_cast(i32x4, acc[ai][bj][m][0]), i1 = __builtin_bit_cast(i32x4, acc[ai][bj][m][1]); const u32x4 hw = hv[ai][m][bj];
                    const f32x4 v0 = (f32x4){bflo(hw.x), bfhi(hw.x), bflo(hw.y), bfhi(hw.y)} + (f32x4){(float)i0[0], (float)i0[1], (float)i0[2], (float)i0[3]} * ys, v1 = (f32x4){bflo(hw.z), bfhi(hw.z), bflo(hw.w), bfhi(hw.w)} + (f32x4){(float)i1[0], (float)i1[1], (float)i1[2], (float)i1[3]} * ys;
                    { u32x4 w; w.x = cvtpk(v0[0], v0[1]); w.y = cvtpk(v0[2], v0[3]); w.z = cvtpk(v1[0], v1[1]); w.w = cvtpk(v1[2], v1[3]); *G1(u32x4, hp + bj * HALF) = w; }
                    s2 += (v0[0] * v0[0] + v0[1] * v0[1]) + (v0[2] * v0[2] + v0[3] * v0[3]) + (v1[0] * v1[0] + v1[1] * v1[1]) + (v1[2] * v1[2] + v1[3] * v1[3]);
                    u32x2 q; q.x = pack4_q8_(v0[0] * qs, v0[1] * qs, v0[2] * qs, v0[3] * qs); q.y = pack4_q8_(v1[0] * qs, v1[1] * qs, v1[2] * qs, v1[3] * qs);
                    *G1(u32x2, bp + bj * HALF) = q; }
                s2 += __shfl_xor(s2, 16); s2 += __shfl_xor(s2, 32);
                if (fq == 0) (void)__hip_atomic_fetch_add(G1(u64, ssout + row), ss_fix(s2), __ATOMIC_RELAXED, __HIP_MEMORY_SCOPE_AGENT); }
        __builtin_amdgcn_sched_barrier(0);
        }
    }
};
struct EpiGate {
    bf16_t* H; const bf16_t* PP; const u64* ssin; u64* ssout; signed char* HQ; float* ascale; const float* ascale_in;
    __device__ __forceinline__ void operator()(const f32x4 (&acc)[2][2][4][2], const Unit& u, int wr, int wc, int fr, int fq) const {
        const int row0 = u.pm * BM + wr * 64 + fr, col0 = u.pn * BM + wc * 32 + 8 * fq;
#pragma unroll
        for (int ai = 0; ai < 2; ++ai) {
            u32x4 hv[4][2], pv[4][2]; u64 sv[4]; float av[4];
#pragma unroll
            for (int m = 0; m < 4; ++m) { const int row = row0 + ai * HALF + m * 16; const bf16_t* hp = H + (size_t)row * DM + col0; const bf16_t* pp = PP + (size_t)row * DM + col0;
                sv[m] = *G1(const u64, ssin + row); av[m] = *G1(const float, ascale_in + row);
#pragma unroll
                for (int bj = 0; bj < 2; ++bj) { pv[m][bj] = *G1(const u32x4, pp + bj * HALF); hv[m][bj] = *G1(const u32x4, hp + bj * HALF); } }
            __builtin_amdgcn_sched_barrier(0);
#pragma unroll
            for (int m = 0; m < 4; ++m) { const int row = row0 + ai * HALF + m * 16; bf16_t* hp = H + (size_t)row * DM + col0;
                const float sc = ss_rstd(sv[m]); float s2 = 0.f;
                const float qs = 15.875f * sc;
                const float scq = sc * av[m] * (1.0f / W8_SCALE);
                if (HQ && fq == 0 && wc == 0 && u.pn == 0) *G1(float, ascale + row) = 1.0f / qs;
#pragma unroll
                for (int bj = 0; bj < 2; ++bj) { const u32x4 pw = pv[m][bj], hw = hv[m][bj];
                    f32x4 v0 = (f32x4){bflo(hw.x), bfhi(hw.x), bflo(hw.y), bfhi(hw.y)}, v1 = (f32x4){bflo(hw.z), bfhi(hw.z), bflo(hw.w), bfhi(hw.w)};
                    const i32x4 i0 = __builtin_bit_cast(i32x4, acc[ai][bj][m][0]), i1 = __builtin_bit_cast(i32x4, acc[ai][bj][m][1]);
                    const f32x4 a0 = (f32x4){(float)i0[0], (float)i0[1], (float)i0[2], (float)i0[3]} * scq, a1 = (f32x4){(float)i1[0], (float)i1[1], (float)i1[2], (float)i1[3]} * scq;
                    v0[0] += sigmoidf_(a0[0]) * bflo(pw.x); v0[1] += sigmoidf_(a0[1]) * bfhi(pw.x); v0[2] += sigmoidf_(a0[2]) * bflo(pw.y); v0[3] += sigmoidf_(a0[3]) * bfhi(pw.y);
                    v1[0] += sigmoidf_(a1[0]) * bflo(pw.z); v1[1] += sigmoidf_(a1[1]) * bfhi(pw.z); v1[2] += sigmoidf_(a1[2]) * bflo(pw.w); v1[3] += sigmoidf_(a1[3]) * bfhi(pw.w);
                    { u32x4 w; w.x = cvtpk(v0[0], v0[1]); w.y = cvtpk(v0[2], v0[3]); w.z = cvtpk(v1[0], v1[1]); w.w = cvtpk(v1[2], v1[3]); *G1(u32x4, hp + bj * HALF) = w; }
                    s2 += (v0[0] * v0[0] + v0[1] * v0[1]) + (v0[2] * v0[2] + v0[3] * v0[3]) + (v1[0] * v1[0] + v1[1] * v1[1]) + (v1[2] * v1[2] + v1[3] * v1[3]);
                    if (HQ) { u32x2 q; q.x = pack4_q8_(v0[0] * qs, v0[1] * qs, v0[2] * qs, v0[3] * qs); q.y = pack4_q8_(v1[0] * qs, v1[1] * qs, v1[2] * qs, v1[3] * qs); *G1(u32x2, HQ + (size_t)row * DM + col0 + bj * HALF) = q; } }
                s2 += __shfl_xor(s2, 16); s2 += __shfl_xor(s2, 32);
                if (fq == 0) (void)__hip_atomic_fetch_add(G1(u64, ssout + row), ss_fix(s2), __ATOMIC_RELAXED, __HIP_MEMORY_SCOPE_AGENT); }
            __builtin_amdgcn_sched_barrier(0);
        }
    }
};
struct EpiOGate {
    bf16_t* Y; const bf16_t* GC; int ldg;
    __device__ __forceinline__ void operator()(const f32x4 (&acc)[2][2][4][2], const Unit& u, int wr, int wc, int fr, int fq) const {
        const int row0 = u.pm * BM + wr * 64 + fr, col0 = u.g * 256 + wc * 32 + 8 * fq;
        u32x4 gv[2][4][2];
#pragma unroll
        for (int ai = 0; ai < 2; ++ai)
#pragma unroll
            for (int m = 0; m < 4; ++m) { const int row = row0 + ai * HALF + m * 16; const bf16_t* gp = GC + (size_t)row * ldg + col0;
#pragma unroll
                for (int bj = 0; bj < 2; ++bj) gv[ai][m][bj] = *G1(const u32x4, gp + bj * HALF); }
        __builtin_amdgcn_sched_barrier(0);
#pragma unroll
        for (int ai = 0; ai < 2; ++ai)
#pragma unroll
            for (int m = 0; m < 4; ++m) { const int row = row0 + ai * HALF + m * 16; bf16_t* yp = Y + (size_t)row * DM + col0;
#pragma unroll
                for (int bj = 0; bj < 2; ++bj) { const u32x4 gw = gv[ai][m][bj]; const f32x4 a0 = acc[ai][bj][m][0], a1 = acc[ai][bj][m][1];
                    u32x4 w; w.x = cvtpk(a0[0] * siluf_(bflo(gw.x)), a0[1] * siluf_(bfhi(gw.x))); w.y = cvtpk(a0[2] * siluf_(bflo(gw.y)), a0[3] * siluf_(bfhi(gw.y)));
                    w.z = cvtpk(a1[0] * siluf_(bflo(gw.z)), a1[1] * siluf_(bfhi(gw.z))); w.w = cvtpk(a1[2] * siluf_(bflo(gw.w)), a1[3] * siluf_(bfhi(gw.w)));
                    *G1(u32x4, yp + bj * HALF) = w; } }
    }
};
}

struct Args { const float* in[22]; float* out; unsigned char* ws; int ph_lo, ph_hi; };
enum { I_X = 0, I_P, I_T5, I_NORMG, I_EWIN, I_EBF, I_ESINK, I_EWOUT, I_OWIN, I_OQNG, I_OKVNG, I_OWUQ, I_OWUQI, I_OLNG, I_OLNB, I_OWUK, I_OWUV, I_OWOUT, I_PWPROJ, I_PNORMG, I_PWGATE, I_FINALG };


__device__ __forceinline__ unsigned off_b(unsigned row, unsigned ch) { return 256u * row + 16u * (ch ^ (((row & 3) << 2) | ((row >> 2) & 3))); }
__device__ __forceinline__ s16x4 vtr(LAS const unsigned char* p) { return __builtin_bit_cast(s16x4, __builtin_amdgcn_ds_read_tr16_b64_v4i16((LAS v4i16_t*)p)); }
__device__ __forceinline__ bf16x8 pack8(const f32x16& s, int o) {
    u32x4 w; w.x = cvtpk(s[o + 0], s[o + 1]); w.y = cvtpk(s[o + 2], s[o + 3]); w.z = cvtpk(s[o + 4], s[o + 5]); w.w = cvtpk(s[o + 6], s[o + 7]);
    return __builtin_bit_cast(bf16x8, w);
}
template <int NSB, int NOB>
__device__ __forceinline__ void sm_step(f32x16 (&s)[NSB], float& m, float& l, f32x16 (&o)[NOB], bf16x8 (&p)[NSB][2]) {
    float mx = s[0][0];
#pragma unroll
    for (int b = 0; b < NSB; ++b)
#pragma unroll
        for (int r = 0; r < 16; ++r) mx = fmaxf(mx, s[b][r]);
    mx = xhalf_max(mx);
    if (__any(mx > m + 8.0f)) {
        const float mn = fmaxf(m, mx), alpha = fast_exp2(m - mn);
        l *= alpha; m = mn;
#pragma unroll
        for (int c = 0; c < NOB; ++c) o[c] = o[c] * alpha;
    }
    float sum = 0.f;
#pragma unroll
    for (int b = 0; b < NSB; ++b)
#pragma unroll
        for (int r = 0; r < 16; ++r) { s[b][r] = fast_exp2(s[b][r] - m); sum += s[b][r]; }
    sum = xhalf_sum(sum);
    l += sum;
#pragma unroll
    for (int b = 0; b < NSB; ++b) { p[b][0] = pack8(s[b], 0); p[b][1] = pack8(s[b], 8); }
}
__device__ __forceinline__ unsigned vt_addr(int lane, int krow0, int c, int t) {
    const unsigned h = lane >> 5, blk = (lane >> 4) & 1, q = (lane & 15) >> 2, p = lane & 3;
    return off_b(krow0 + 8 * t + 4 * h + q, 4 * c + 2 * blk + (p >> 1)) + 8 * (p & 1);
}
__device__ __forceinline__ bf16x8 vfrag(LAS const unsigned char* img, int lane, int krow0, int c) {
    const s16x4 lo = vtr(img + vt_addr(lane, krow0, c, 0)), hi = vtr(img + vt_addr(lane, krow0, c, 1));
    return (bf16x8){lo[0], lo[1], lo[2], lo[3], hi[0], hi[1], hi[2], hi[3]};
}
__device__ __forceinline__ unsigned krow_base(int lane) { const unsigned r = lane & 31, h = lane >> 5, x = ((r & 3) << 2) | ((r >> 2) & 3); return 256u * r + 16u * ((x & 14u) | (h ^ (x & 1u))); }
__device__ __forceinline__ unsigned vt_base(int lane) { const unsigned h = lane >> 5, blk = (lane >> 4) & 1, q = (lane & 15) >> 2, p = lane & 3; const unsigned low0 = (2 * blk + (p >> 1)) ^ h;
    return 256u * (4 * h + q) + 64u * q + 16u * low0 + 8u * (p & 1); }
__device__ __forceinline__ bf16x8 vfrag2(LAS const unsigned char* img, unsigned vb, int c, int imm) {
    const unsigned a0 = vb ^ (unsigned)(c << 6);
    const s16x4 lo = vtr(img + a0 + imm), hi = vtr(img + (a0 ^ 32u) + imm + 2048);
    return (bf16x8){lo[0], lo[1], lo[2], lo[3], hi[0], hi[1], hi[2], hi[3]};
}
__device__ __forceinline__ float log_sigmoid_(float x) { return x > 0.f ? -log1pf(expf(-x)) : x - log1pf(expf(x)); }

constexpr int FOX_KV = 0, FOX_CUM = 65536, FOX_SCAN = FOX_CUM + 16384, FOX_KMAX = FOX_SCAN + 64, FOX_FLAGS = FOX_SCAN + 128;
constexpr float FOX_SKIP_LOG2 = 64.0f;
template <int CTRL> __device__ __forceinline__ float dpp_(float v) { return __int_as_float(__builtin_amdgcn_update_dpp(0, __float_as_int(v), CTRL, 0xF, 0xF, true)); }
__device__ __forceinline__ float row16_sum(float s) { s += dpp_<0xB1>(s); s += dpp_<0x4E>(s); s += dpp_<0x141>(s); s += dpp_<0x140>(s); return s; }
__device__ __forceinline__ float wave_max_u(float v) {
    v = fmaxf(v, dpp_<0xB1>(v)); v = fmaxf(v, dpp_<0x4E>(v)); v = fmaxf(v, dpp_<0x141>(v)); v = fmaxf(v, dpp_<0x140>(v));
    const float a0 = __int_as_float(__builtin_amdgcn_readlane(__float_as_int(v), 0)), a1 = __int_as_float(__builtin_amdgcn_readlane(__float_as_int(v), 16));
    const float a2 = __int_as_float(__builtin_amdgcn_readlane(__float_as_int(v), 32)), a3 = __int_as_float(__builtin_amdgcn_readlane(__float_as_int(v), 48));
    return fmaxf(fmaxf(a0, a1), fmaxf(a2, a3));
}
__device__ __forceinline__ void fox_scan(const GAS bf16_t* proj, const GAS u64* kn, const GAS float* bfp, int b, int hd, LAS unsigned char* lds, int tid, int lane, int wave) {
    LAS float* cumL = (LAS float*)(lds + FOX_CUM); LAS float* scanL = (LAS float*)(lds + FOX_SCAN); LAS float* kmaxL = (LAS float*)(lds + FOX_KMAX);
    const float bias = bfp[hd]; float v[8]; float run = 0.f;
#pragma unroll
    for (int i = 0; i < 8; ++i) { const float f = bf2f(proj[(size_t)(b * SEQ + 8 * tid + i) * EN + E_FA + hd]); run += log_sigmoid_(f + bias); v[i] = run; }
    float inc = run;
#pragma unroll
    for (int o = 1; o < 64; o <<= 1) { const float t = __shfl_up(inc, o); if (lane >= o) inc += t; }
    float kq = 0.f;
    { const GAS u64* kp = kn + (size_t)hd * M + (size_t)b * SEQ + 8 * tid;
#pragma unroll
      for (int i = 0; i < 8; ++i) kq = fmaxf(kq, (float)kp[i] * (1.0f / 16777216.0f)); }
    kq = wave_max_u(kq);
    if (lane == 63) scanL[wave] = inc;
    if (lane == 0) scanL[8 + wave] = kq;
    __syncthreads();
    float wbase = 0.f, km = 0.f;
#pragma unroll
    for (int w = 0; w < 8; ++w) { const float t = scanL[w]; if (w < wave) wbase += t; km = fmaxf(km, scanL[8 + w]); }
    const float excl = wbase + inc - run;
#pragma unroll
    for (int i = 0; i < 8; ++i) cumL[8 * tid + i] = -(excl + v[i]) * LOG2E;
    if (tid == 0) kmaxL[0] = sqrtf(km) * 1.005f;
    __syncthreads();
}
__device__ __forceinline__ void fox_unit(const GAS bf16_t* proj, GAS bf16_t* yin, int b, int hd, int qb, LAS unsigned char* lds, int tid, int lane, int wave) {
    const LAS float* cumL = (const LAS float*)(lds + FOX_CUM); volatile LAS int* flags = (volatile LAS int*)(lds + FOX_FLAGS);
    const int t0 = 256 * qb, q0 = t0 + 32 * wave, qme = q0 + (lane & 31), h = lane >> 5;
    const size_t rowb = (size_t)b * SEQ;
    const float cs = 0.08838834764831845f * LOG2E;
    const unsigned kbase = krow_base(lane), vbase = vt_base(lane);
    bf16x8 qf[8];
    { const GAS bf16_t* qp = proj + (rowb + qme) * EN + E_QA + hd * 128 + 8 * h;
#pragma unroll
      for (int s = 0; s < 8; ++s) qf[s] = *(const GAS bf16x8*)(qp + 16 * s); }
    float qn2 = 0.f;
#pragma unroll
    for (int s = 0; s < 8; ++s)
#pragma unroll
        for (int e = 0; e < 8; ++e) { const float x = bf2f((unsigned short)qf[s][e]); qn2 += x * x; }
    qn2 = xhalf_sum(qn2);
    const float cbound = sqrtf(qn2) * 1.0001f * ((const LAS float*)(lds + FOX_KMAX))[0] * cs;
    f32x16 o[4];
#pragma unroll
    for (int c = 0; c < 4; ++c)
#pragma unroll
        for (int r = 0; r < 16; ++r) o[c][r] = 0.f;
    float m = -1e30f, l = 0.f;
    const int ntile = 4 * (qb + 1);
    const int r0 = tid >> 4, c0 = tid & 15;
    const GAS bf16_t* kg = proj + (rowb + r0) * EN + E_KA + hd * 128 + c0 * 8;
    const GAS bf16_t* vg = proj + (rowb + r0) * EN + E_VA + hd * 128 + c0 * 8;
    const unsigned so0 = off_b(r0, c0), so1 = off_b(r0 + 32, c0);
    u32x4 sk0, sk1, sv0, sv1;
    { const size_t adv = (size_t)64 * (ntile - 1) * EN; sk0 = *(const GAS u32x4*)(kg + adv); sk1 = *(const GAS u32x4*)(kg + adv + (size_t)32 * EN); sv0 = *(const GAS u32x4*)(vg + adv); sv1 = *(const GAS u32x4*)(vg + adv + (size_t)32 * EN); }
    __syncthreads();
    { LAS unsigned char* kb = lds + FOX_KV; *(LAS u32x4*)(kb + so0) = sk0; *(LAS u32x4*)(kb + so1) = sk1; *(LAS u32x4*)(kb + 16384 + so0) = sv0; *(LAS u32x4*)(kb + 16384 + so1) = sv1; }
    __syncthreads();
    bool done_w = false;
    for (int it = 0; it < ntile; ++it) {
        const int kt = ntile - 1 - it, cur = it & 1; const LAS unsigned char* Kt = lds + FOX_KV + cur * 32768; const LAS unsigned char* Vt = Kt + 16384;
        const bool more = kt > 0;
        if (more) { const size_t adv = (size_t)64 * (kt - 1) * EN; sk0 = *(const GAS u32x4*)(kg + adv); sk1 = *(const GAS u32x4*)(kg + adv + (size_t)32 * EN); sv0 = *(const GAS u32x4*)(vg + adv); sv1 = *(const GAS u32x4*)(vg + adv + (size_t)32 * EN); }
        const int k0 = 64 * kt;
        if (k0 <= q0 + 31 && !done_w) {
            f32x16 sc[2];
#pragma unroll
            for (int kb = 0; kb < 2; ++kb) {
#pragma unroll
                for (int r = 0; r < 16; ++r) sc[kb][r] = 0.f;
#pragma unroll
                for (int s = 0; s < 8; ++s) { const bf16x8 a = *(const LAS bf16x8*)(Kt + (kbase ^ (unsigned)(s << 5)) + 8192 * kb); sc[kb] = __builtin_amdgcn_mfma_f32_32x32x16_bf16(a, qf[s], sc[kb], 0, 0, 0); }
            }
            const bool diag = (k0 + 63 > q0);
#pragma unroll
            for (int kb = 0; kb < 2; ++kb)
#pragma unroll
                for (int g4 = 0; g4 < 4; ++g4) { const int key0 = k0 + 32 * kb + 8 * g4 + 4 * h; const f32x4 nb = *(const LAS f32x4*)(cumL + key0);
#pragma unroll
                    for (int e = 0; e < 4; ++e) { float v = sc[kb][4 * g4 + e] * cs + nb[e]; if (diag && (key0 + e > qme)) v = -1e30f; sc[kb][4 * g4 + e] = v; } }
            bf16x8 p[2][2];
            sm_step<2, 4>(sc, m, l, o, p);
#pragma unroll
            for (int c = 0; c < 4; ++c)
#pragma unroll
                for (int kb = 0; kb < 2; ++kb)
#pragma unroll
                    for (int s = 0; s < 2; ++s) { const bf16x8 a = vfrag2(Vt, vbase, c, 256 * (32 * kb + 16 * s)); o[c] = __builtin_amdgcn_mfma_f32_32x32x16_bf16(a, p[kb][s], o[c], 0, 0, 0); }
            if (more) { const float amax = wave_max_u(cbound - m); done_w = (amax + cumL[k0 - 1] < -FOX_SKIP_LOG2); }
        }
        if (lane == 0) flags[cur * 8 + wave] = done_w ? 1 : 0;
        if (more) { LAS unsigned char* kb = lds + FOX_KV + (cur ^ 1) * 32768; *(LAS u32x4*)(kb + so0) = sk0; *(LAS u32x4*)(kb + so1) = sk1; *(LAS u32x4*)(kb + 16384 + so0) = sv0; *(LAS u32x4*)(kb + 16384 + so1) = sv1; }
        __syncthreads();
        int alld = 1;
#pragma unroll
        for (int w = 0; w < 8; ++w) alld &= flags[cur * 8 + w];
        if (alld) break;
    }
    const float il = 1.0f / l;
    const GAS bf16_t* gp = proj + (rowb + qme) * EN + E_GA + hd * 128 + 4 * h; GAS bf16_t* yp = yin + (rowb + qme) * DM + hd * 128 + 4 * h;
#pragma unroll
    for (int c = 0; c < 4; ++c)
#pragma unroll
        for (int g4 = 0; g4 < 4; ++g4) { const u32x2 gw = *(const GAS u32x2*)(gp + 32 * c + 8 * g4);
            u32x2 w; w.x = cvtpk(o[c][4 * g4 + 0] * il * siluf_(bflo(gw.x)), o[c][4 * g4 + 1] * il * siluf_(bfhi(gw.x))); w.y = cvtpk(o[c][4 * g4 + 2] * il * siluf_(bflo(gw.y)), o[c][4 * g4 + 3] * il * siluf_(bfhi(gw.y)));
            *(GAS u32x2*)(yp + 32 * c + 8 * g4) = w; }
}

constexpr int SWA_K = 0, SWA_V = 65536, SWA_TB = 131072;
__device__ __forceinline__ int t5_bucket_(int rel) {
    if (rel < 16) return rel;
    if (rel >= 128) return 31;
    const int v = 16 + (int)(logf((float)rel * (1.0f / 16.0f)) / 2.0794415416798357f * 16.0f);
    return v < 31 ? v : 31;
}
__device__ __forceinline__ void swa_unit(const GAS bf16_t* proj, GAS bf16_t* yin, const GAS float* t5, const GAS float* sinks, int b, int nb, int kvh, LAS unsigned char* lds, int tid, int lane, int wave) {
    const size_t rowb = (size_t)b * SEQ; const int hq = kvh * 8 + wave, h = lane >> 5;
    __syncthreads();
#pragma unroll
    for (int i = 0; i < 4; ++i) { const int c = tid + 512 * i, row = c >> 3, ch = c & 7; const int key = 128 * (nb - 1) + row;
        u32x4 kv = zero4_(), vv = kv;
        if (key >= 0) { const GAS bf16_t* src = proj + (rowb + key) * EN + kvh * 64 + ch * 8; kv = *(const GAS u32x4*)(src + E_KB); vv = *(const GAS u32x4*)(src + E_VB); }
        *(LAS u32x4*)(lds + SWA_K + off_b(row, ch)) = kv; *(LAS u32x4*)(lds + SWA_V + off_b(row, ch)) = vv; }
    LAS float* tb = (LAS float*)(lds + SWA_TB + wave * 512);
#pragma unroll
    for (int i = 0; i < 2; ++i) { const int rel = lane + 64 * i; tb[rel] = t5[t5_bucket_(rel) * 64 + hq] * LOG2E; }
    __syncthreads();
    const float cs = 0.125f * LOG2E, sink2 = sinks[hq] * LOG2E;
    const unsigned kbase = krow_base(lane), vbase = vt_base(lane);
    for (int cg = 0; cg < 4; ++cg) {
        const int qi = 32 * cg + (lane & 31); const size_t row = rowb + 128 * nb + qi;
        bf16x8 qf[4];
        { const GAS bf16_t* qp = proj + row * EN + E_QB + hq * 64 + 8 * h;
#pragma unroll
          for (int s = 0; s < 4; ++s) qf[s] = *(const GAS bf16x8*)(qp + 16 * s); }
        f32x16 o[2];
#pragma unroll
        for (int c = 0; c < 2; ++c)
#pragma unroll
            for (int r = 0; r < 16; ++r) o[c][r] = 0.f;
        float m = sink2, l = 1.0f;
        for (int kb = cg; kb < cg + 5; ++kb) {
            f32x16 sc[1];
#pragma unroll
            for (int r = 0; r < 16; ++r) sc[0][r] = 0.f;
#pragma unroll
            for (int s = 0; s < 4; ++s) { const bf16x8 a = *(const LAS bf16x8*)(lds + SWA_K + (kbase ^ (unsigned)(s << 5)) + 8192 * kb); sc[0] = __builtin_amdgcn_mfma_f32_32x32x16_bf16(a, qf[s], sc[0], 0, 0, 0); }
#pragma unroll
            for (int r = 0; r < 16; ++r) { const int kj = 32 * kb + (r & 3) + 8 * (r >> 2) + 4 * h, rel = qi + 128 - kj;
                const bool valid = (rel >= 0) && (rel < 128) && (nb > 0 || kj >= 128);
                const float bias = tb[rel & 127];
                sc[0][r] = sc[0][r] * cs + bias + (valid ? 0.f : -1e30f); }
            bf16x8 p[1][2];
            sm_step<1, 2>(sc, m, l, o, p);
#pragma unroll
            for (int c = 0; c < 2; ++c)
#pragma unroll
                for (int s = 0; s < 2; ++s) { const bf16x8 a = vfrag2(lds + SWA_V + 8192 * kb, vbase, c, 4096 * s); o[c] = __builtin_amdgcn_mfma_f32_32x32x16_bf16(a, p[0][s], o[c], 0, 0, 0); }
        }
        const float il = 1.0f / l;
        const GAS bf16_t* gp = proj + row * EN + E_GB + hq * 64 + 4 * h; GAS bf16_t* yp = yin + row * DM + 2048 + hq * 64 + 4 * h;
#pragma unroll
        for (int c = 0; c < 2; ++c)
#pragma unroll
            for (int g4 = 0; g4 < 4; ++g4) { const u32x2 gw = *(const GAS u32x2*)(gp + 32 * c + 8 * g4);
                u32x2 w; w.x = cvtpk(o[c][4 * g4 + 0] * il * siluf_(bflo(gw.x)), o[c][4 * g4 + 1] * il * siluf_(bfhi(gw.x))); w.y = cvtpk(o[c][4 * g4 + 2] * il * siluf_(bflo(gw.y)), o[c][4 * g4 + 3] * il * siluf_(bfhi(gw.y)));
                *(GAS u32x2*)(yp + 32 * c + 8 * g4) = w; }
    }
}
__device__ __forceinline__ void phase_even_attn(const Args& a, int j, LAS unsigned char* lds, int G, int bx, const int wave, const int which) {
    const int lane = lane_id_(), tid = wave * 64 + lane;
    unsigned char* ws_ = a.ws; OPAQUE_S(ws_); GAS unsigned char* ws = (GAS unsigned char*)ws_;
    const GAS bf16_t* proj = (const GAS bf16_t*)(ws + WS_PROJ); GAS bf16_t* yin = (GAS bf16_t*)(ws + WS_YIN);
    if (which & 1) for (int u = bx; u < 256; u += G) {
        const int b = u >> 7, hd = (u >> 3) & 15, i = u & 7;
        __syncthreads();
        fox_scan(proj, (const GAS u64*)(ws + WS_KN) + (size_t)j * 16 * M, ((const GAS float*)karg_in(I_EBF)) + j * 16, b, hd, lds, tid, lane, wave);
        fox_unit(proj, yin, b, hd, 15 - i, lds, tid, lane, wave);
        fox_unit(proj, yin, b, hd, i, lds, tid, lane, wave);
    }
    if (which & 2) for (int u = bx; u < 256; u += G) {
        const int b = u >> 7, nb = (u >> 2) & 31, kvh = u & 3;
        swa_unit(proj, yin, ((const GAS float*)karg_in(I_T5)), ((const GAS float*)karg_in(I_ESINK)) + j * 32, b, nb, kvh, lds, tid, lane, wave);
    }
    __syncthreads();
}

#define BAR_LDS() asm volatile("s_waitcnt lgkmcnt(0)\n\ts_barrier" ::: "memory")
__device__ __forceinline__ void phase_odd_norms(const Args& a, int j, int gw, int NGW) {
    const int lane = lane_id_();
    unsigned char* ws_ = a.ws; OPAQUE_S(ws_); GAS unsigned char* ws = (GAS unsigned char*)ws_;
    const GAS bf16_t* proj = (const GAS bf16_t*)(ws + WS_PROJ); GAS bf16_t* cqn = (GAS bf16_t*)(ws + WS_CQN); GAS bf16_t* lat = (GAS bf16_t*)(ws + WS_LAT); GAS bf16_t* kidx = (GAS bf16_t*)(ws + WS_KIDX); GAS float* widx = (GAS float*)(ws + WS_WIDX);
    const GAS float* qg = ((const GAS float*)karg_in(I_OQNG)) + j * 1024; const GAS float* kvg = ((const GAS float*)karg_in(I_OKVNG)) + j * 512; const GAS float* lng = ((const GAS float*)karg_in(I_OLNG)) + j * 64; const GAS float* lnb = ((const GAS float*)karg_in(I_OLNB)) + j * 64;
    for (int row = gw; row < M; row += NGW) {
        const GAS bf16_t* pr = proj + (size_t)row * ON;
        {
            const u32x4 w0 = *(const GAS u32x4*)(pr + O_CQ + lane * 8), w1 = *(const GAS u32x4*)(pr + O_CQ + 512 + lane * 8);
            float v[16] = {bflo(w0.x), bfhi(w0.x), bflo(w0.y), bfhi(w0.y), bflo(w0.z), bfhi(w0.z), bflo(w0.w), bfhi(w0.w), bflo(w1.x), bfhi(w1.x), bflo(w1.y), bfhi(w1.y), bflo(w1.z), bfhi(w1.z), bflo(w1.w), bfhi(w1.w)};
            float ss = 0.f;
#pragma unroll
            for (int i = 0; i < 16; ++i) ss += v[i] * v[i];
            ss = wave_sum(ss); const float r = 1.0f / sqrtf(ss * (1.0f / 1024.0f) + EPS);
            const f32x4 g0 = *(const GAS f32x4*)(qg + lane * 8), g1 = *(const GAS f32x4*)(qg + lane * 8 + 4), g2 = *(const GAS f32x4*)(qg + 512 + lane * 8), g3 = *(const GAS f32x4*)(qg + 512 + lane * 8 + 4);
            u32x4 o0, o1;
            o0.x = cvtpk(v[0] * r * g0[0], v[1] * r * g0[1]); o0.y = cvtpk(v[2] * r * g0[2], v[3] * r * g0[3]); o0.z = cvtpk(v[4] * r * g1[0], v[5] * r * g1[1]); o0.w = cvtpk(v[6] * r * g1[2], v[7] * r * g1[3]);
            o1.x = cvtpk(v[8] * r * g2[0], v[9] * r * g2[1]); o1.y = cvtpk(v[10] * r * g2[2], v[11] * r * g2[3]); o1.z = cvtpk(v[12] * r * g3[0], v[13] * r * g3[1]); o1.w = cvtpk(v[14] * r * g3[2], v[15] * r * g3[3]);
            *(GAS u32x4*)(cqn + (size_t)row * 1024 + lane * 8) = o0; *(GAS u32x4*)(cqn + (size_t)row * 1024 + 512 + lane * 8) = o1;
        }
        {
            const u32x4 w0 = *(const GAS u32x4*)(pr + O_CKV + lane * 8);
            float v[8] = {bflo(w0.x), bfhi(w0.x), bflo(w0.y), bfhi(w0.y), bflo(w0.z), bfhi(w0.z), bflo(w0.w), bfhi(w0.w)};
            float ss = 0.f;
#pragma unroll
            for (int i = 0; i < 8; ++i) ss += v[i] * v[i];
            ss = wave_sum(ss); const float r = 1.0f / sqrtf(ss * (1.0f / 512.0f) + EPS);
            const f32x4 g0 = *(const GAS f32x4*)(kvg + lane * 8), g1 = *(const GAS f32x4*)(kvg + lane * 8 + 4);
            u32x4 o0; o0.x = cvtpk(v[0] * r * g0[0], v[1] * r * g0[1]); o0.y = cvtpk(v[2] * r * g0[2], v[3] * r * g0[3]); o0.z = cvtpk(v[4] * r * g1[0], v[5] * r * g1[1]); o0.w = cvtpk(v[6] * r * g1[2], v[7] * r * g1[3]);
            *(GAS u32x4*)(lat + (size_t)row * 512 + lane * 8) = o0;
        }
        {
            const float x = bf2f(pr[O_KIDX + lane]); const float mu = wave_sum(x) * (1.0f / 64.0f); const float xc = x - mu; const float var = wave_sum(xc * xc) * (1.0f / 64.0f);
            const float y = xc * (1.0f / sqrtf(var + EPS)) * lng[lane] + lnb[lane];
            kidx[(size_t)row * 64 + lane] = (bf16_t)(cvtpk(y, 0.f) & 0xffffu);
        }
        if (lane < 32) widx[(size_t)row * 32 + lane] = bf2f(pr[O_WIDX + lane]) * 0.022097086912079608f;
    }
}

__device__ __forceinline__ unsigned sortable_(float f) { const unsigned u = __float_as_uint(f); return (u & 0x80000000u) ? ~u : (u | 0x80000000u); }
__device__ __forceinline__ int wave_isum(int v) {
#pragma unroll
    for (int o = 1; o < 64; o <<= 1) v += __shfl_xor(v, o);
    return v;
}
__device__ __forceinline__ void topk_row(const GAS float* srow, GAS int* sel, int t, int lane) {
    const int nvalid = t + 1;
    if (nvalid <= 256) {
#pragma unroll
        for (int i = 0; i < 4; ++i) sel[64 * i + lane] = (64 * i + lane < nvalid) ? 64 * i + lane : 0;
        return;
    }
    unsigned key[64];
    const int ngrp = (nvalid + 511) >> 9;
#pragma unroll
    for (int g = 0; g < 8; ++g) {
        if (g < ngrp) {
#pragma unroll
            for (int i = 8 * g; i < 8 * g + 8; ++i) { const int e = 64 * i + lane; const float v = srow[e]; key[i] = (e < nvalid) ? sortable_(v) : 0u; }
        } else {
#pragma unroll
            for (int i = 8 * g; i < 8 * g + 8; ++i) key[i] = 0u;
        }
    }
    unsigned T = 0u;
#pragma unroll 1
    for (int bit = 31; bit >= 0; --bit) {
        const unsigned cand = T | (1u << bit); int cnt = 0;
#pragma unroll
        for (int g = 0; g < 8; ++g) {
            if (g < ngrp) {
#pragma unroll
                for (int i = 0; i < 8; ++i) cnt += __builtin_popcountll(__ballot(key[8 * g + i] >= cand));
            }
            __builtin_amdgcn_sched_barrier(0);
        }
        if (cnt >= 256) T = cand;
        if (cnt == 256) break;
    }
    int cgt = 0;
#pragma unroll
    for (int g = 0; g < 8; ++g) {
        if (g < ngrp) {
#pragma unroll
            for (int i = 0; i < 8; ++i) cgt += __builtin_popcountll(__ballot(key[8 * g + i] > T));
        }
        __builtin_amdgcn_sched_barrier(0);
    }
    const int need = 256 - cgt; int pos = 0, eqseen = 0;
#pragma unroll
    for (int g = 0; g < 8; ++g) {
        if (g < ngrp) {
#pragma unroll
            for (int i = 8 * g; i < 8 * g + 8; ++i) {
                const bool gt = key[i] > T, eq = key[i] == T;
                const unsigned long long meq = __ballot(eq);
                const int rank = eqseen + (int)__builtin_amdgcn_mbcnt_hi((unsigned)(meq >> 32), __builtin_amdgcn_mbcnt_lo((unsigned)meq, 0u));
                const bool take = gt || (eq && rank < need);
                const unsigned long long mt = __ballot(take);
                const int p = pos + (int)__builtin_amdgcn_mbcnt_hi((unsigned)(mt >> 32), __builtin_amdgcn_mbcnt_lo((unsigned)mt, 0u));
                if (take && p < 256) sel[p] = 64 * i + lane;
                pos += __builtin_popcountll(mt); eqseen += __builtin_popcountll(meq);
            }
        }
    }
}
__device__ __forceinline__ void phase_indexer(const Args& a, LAS unsigned char* lds, int G, int bx, const int wave, const bool do_topk) {
    unsigned char* ws_ = a.ws; OPAQUE_S(ws_); GAS unsigned char* ws = (GAS unsigned char*)ws_;
    const GAS bf16_t* qbuf = (const GAS bf16_t*)(ws + WS_QBUF); const GAS bf16_t* kidx = (const GAS bf16_t*)(ws + WS_KIDX); const GAS float* widx = (const GAS float*)(ws + WS_WIDX);
    GAS float* score = (GAS float*)(ws + WS_SCORE) + (size_t)bx * 16 * 4096; GAS int* sel = (GAS int*)(ws + WS_SEL);
    for (int u = bx; u < 256; u += G) {
        const int b = u >> 7, i0 = u & 127;
        for (int half = 0; half < 2; ++half) {
            const int lane = lane_id_(), tid = wave * 64 + lane, h = lane >> 5;
            const unsigned key = lane & 31, x = (key >> 1) & 7;
            const unsigned bbase = 128u * key + 16u * ((x & 6u) | ((unsigned)h ^ (x & 1u)));
            const int qg = half ? 255 - i0 : i0;
            const int tq = 16 * qg + 2 * wave; const size_t rowb = (size_t)b * SEQ;
            bf16x8 qa[2][4]; f32x4 wv[2][4];
#pragma unroll
            for (int q = 0; q < 2; ++q) { const GAS bf16_t* qp = qbuf + (rowb + tq + q) * QW + 4096 + (lane & 31) * 64 + 8 * h; const GAS float* wp = widx + (rowb + tq + q) * 32 + 4 * h;
#pragma unroll
                for (int s = 0; s < 4; ++s) qa[q][s] = *(const GAS bf16x8*)(qp + 16 * s);
#pragma unroll
                for (int g4 = 0; g4 < 4; ++g4) wv[q][g4] = *(const GAS f32x4*)(wp + 8 * g4); }
            const int kmax = 16 * qg + 15, ntile = kmax / 256 + 1;
            const GAS bf16_t* kg = kidx + rowb * 64 + tid * 8;
            u32x4 st[4];
#pragma unroll
            for (int i = 0; i < 4; ++i) st[i] = *(const GAS u32x4*)(kg + i * 4096);
            __syncthreads();
#pragma unroll
            for (int i = 0; i < 4; ++i) { const int c = tid + 512 * i, row = c >> 3, ch = c & 7; *(LAS u32x4*)(lds + row * 128 + ((ch ^ ((row >> 1) & 7)) << 4)) = st[i]; }
            __syncthreads();
            for (int kt = 0; kt < ntile; ++kt) {
                const int cur = kt & 1; const bool more = kt + 1 < ntile;
                if (more) {
#pragma unroll
                    for (int i = 0; i < 4; ++i) st[i] = *(const GAS u32x4*)(kg + (size_t)(kt + 1) * 16384 + i * 4096); }
                const LAS unsigned char* Kt = lds + cur * 32768;
                const int nkb = (kmax - 256 * kt) / 32 + 1 < 8 ? (kmax - 256 * kt) / 32 + 1 : 8;
#define IDX_LOAD(B, kb_) do { _Pragma("unroll") for (int s_ = 0; s_ < 4; ++s_) B[s_] = *(const LAS bf16x8*)(Kt + (bbase ^ (unsigned)(s_ << 5)) + 4096 * (kb_)); } while (0)
#define IDX_BLOCK(B, kb_) do { f32x16 acc0, acc1; \
                    _Pragma("unroll") for (int r = 0; r < 16; ++r) { acc0[r] = 0.f; acc1[r] = 0.f; } \
                    _Pragma("unroll") for (int s_ = 0; s_ < 4; ++s_) acc0 = __builtin_amdgcn_mfma_f32_32x32x16_bf16(qa[0][s_], B[s_], acc0, 0, 0, 0); \
                    _Pragma("unroll") for (int s_ = 0; s_ < 4; ++s_) acc1 = __builtin_amdgcn_mfma_f32_32x32x16_bf16(qa[1][s_], B[s_], acc1, 0, 0, 0); \
                    float sc0 = 0.f, sc1 = 0.f; \
                    _Pragma("unroll") for (int r = 0; r < 16; ++r) sc0 += wv[0][r >> 2][r & 3] * fmaxf(acc0[r], 0.f); \
                    _Pragma("unroll") for (int r = 0; r < 16; ++r) sc1 += wv[1][r >> 2][r & 3] * fmaxf(acc1[r], 0.f); \
                    sc0 = xhalf_sum(sc0); sc1 = xhalf_sum(sc1); \
                    if (lane < 32) { score[(size_t)(2 * wave) * 4096 + 256 * kt + 32 * (kb_) + lane] = sc0; score[(size_t)(2 * wave + 1) * 4096 + 256 * kt + 32 * (kb_) + lane] = sc1; } } while (0)
                { bf16x8 fa[4], fb[4];
                  IDX_LOAD(fa, 0);
                  for (int kb = 0; kb < nkb; kb += 2) {
                      if (kb + 1 < nkb) IDX_LOAD(fb, kb + 1);
                      IDX_BLOCK(fa, kb);
                      if (kb + 1 < nkb) { if (kb + 2 < nkb) IDX_LOAD(fa, kb + 2); IDX_BLOCK(fb, kb + 1); }
                  } }
#undef IDX_LOAD
#undef IDX_BLOCK
                if (more) {
#pragma unroll
                    for (int i = 0; i < 4; ++i) { const int c = tid + 512 * i, row = c >> 3, ch = c & 7; *(LAS u32x4*)(lds + (cur ^ 1) * 32768 + row * 128 + ((ch ^ ((row >> 1) & 7)) << 4)) = st[i]; } }
                __syncthreads();
            }
            VM_WAIT();
            __builtin_amdgcn_fence(__ATOMIC_ACQUIRE, "agent");
            VM_WAIT();
            if (do_topk) { const int lane2 = lane_id_();
#pragma unroll 1
              for (int q = 0; q < 2; ++q) topk_row(score + (size_t)(2 * wave + q) * 4096, sel + (rowb + tq + q) * 256, tq + q, lane2); }
        }
    }
    __syncthreads();
}

constexpr int DSA_LAT = 0, DSA_XCH = 65536, DSA_TAB = 131072, DSA_T5 = 143360, DSA_TCNT = 147456, DSA_MASKROW = 4352;
__device__ __forceinline__ void phase_dsa(const Args& a, LAS unsigned char* lds, int G, int bx, const int wave, const int mode) {
    (void)mode;
    const int lane = lane_id_(), tid = wave * 64 + lane, h = lane >> 5, team = wave >> 2, wq = wave & 3, ttid = tid & 255;
    unsigned char* ws_ = a.ws; OPAQUE_S(ws_); GAS unsigned char* ws = (GAS unsigned char*)ws_;
    const GAS bf16_t* qabs = (const GAS bf16_t*)(ws + WS_QABS); const GAS bf16_t* lat = (const GAS bf16_t*)(ws + WS_LAT); const GAS int* sel = (const GAS int*)(ws + WS_SEL); GAS bf16_t* olat = (GAS bf16_t*)(ws + WS_OLAT);
    LAS float* t5c = (LAS float*)(lds + DSA_T5);
    volatile LAS unsigned* tcnt = (volatile LAS unsigned*)(lds + DSA_TCNT + team * 64);
    __syncthreads();
    for (int i = tid; i < 1024; i += 512) t5c[i] = ((const GAS float*)karg_in(I_T5))[(i >> 5) * 64 + 32 + (i & 31)] * LOG2E;
    if (tid < 32) ((volatile LAS unsigned*)(lds + DSA_TCNT))[tid] = 0u;
    if (tid >= 64 && tid < 96) ((LAS float*)((LAS unsigned char*)t5c + DSA_MASKROW))[tid - 64] = -1e30f;
    __syncthreads();
    LAS unsigned char* latw = lds + DSA_LAT + wave * 8192; LAS unsigned char* xch = lds + DSA_XCH + team * 32768;
    LAS unsigned char* pbuf = xch + 16384; LAS unsigned char* mbuf = xch + 18432; LAS unsigned char* lbuf = xch + 18944;
    const unsigned qoff = (unsigned)(((wq >> 1) * 64 + lane) * 16 + (wq & 1) * 8);
    LAS unsigned char* tabs = lds + DSA_TAB + team * 6144;
#define TAB_SEL(p) ((LAS int*)(tabs + (p) * 3072))
#define TAB_BKT(p) ((LAS int*)(tabs + (p) * 3072 + 1024))
    const unsigned kbase = krow_base(lane), vbase = vt_base(lane);
    const float cs = 0.08838834764831845f * LOG2E;
    unsigned tepoch = 0u;
#define TEAM_BAR() do { asm volatile("s_waitcnt lgkmcnt(0)" ::: "memory"); ++tepoch; if (lane == 0) __hip_atomic_fetch_add((LAS unsigned*)tcnt, 1u, __ATOMIC_RELAXED, __HIP_MEMORY_SCOPE_WORKGROUP); \
        while (__builtin_amdgcn_readfirstlane((int)*tcnt) < (int)(4u * tepoch)) __builtin_amdgcn_s_sleep(1); asm volatile("" ::: "memory"); } while (0)
    const int gr = lane >> 4, gc = lane & 15;
    const unsigned wbase = 256u * gr + 16u * (gc ^ (gr << 2));
#define DSA_TABLES(p, qq, idxv) do { const int t_ = (qq) & 4095, ns_ = t_ + 1 < 256 ? t_ + 1 : 256; const bool valid_ = ttid < ns_; const int id_ = valid_ ? (idxv) : 0; \
        TAB_SEL(p)[ttid] = id_; TAB_BKT(p)[ttid] = valid_ ? 128 * t5_bucket_(t_ - id_) : DSA_MASKROW; } while (0)
#define DSA_SELLOAD(qq) ((ttid < ((((qq) & 4095) + 1 < 256) ? ((qq) & 4095) + 1 : 256)) ? sel[(size_t)(qq) * 256 + ttid] : 0)
#define DSA_QLOAD(qq) do { const GAS bf16_t* qp_ = qabs + (size_t)(qq) * 16384 + (lane & 31) * 512 + 128 * wq + 8 * h; _Pragma("unroll") for (int s_ = 0; s_ < 8; ++s_) qf[s_] = *(const GAS bf16x8*)(qp_ + 16 * s_); } while (0)
#define DSA_GATHER(ST, lr, tab, cc) do { _Pragma("unroll") for (int i = 0; i < 8; ++i) ST[i] = *(const GAS u32x4*)((lr) + (size_t)(tab)[32 * (cc) + gr + 4 * i] * 512); } while (0)
    int qp = bx, par = 0;
    bf16x8 qf[8]; u32x4 stA[8], stB[8];
    int nxt_idx = 0;
    { const int q0 = 2 * qp + team;
      DSA_TABLES(0, q0, sel[(size_t)q0 * 256 + ttid]);
      if (qp + G < 4096) nxt_idx = DSA_SELLOAD(q0 + 2 * G);
      DSA_QLOAD(q0);
      TEAM_BAR();
      const GAS bf16_t* lr0 = lat + (size_t)(q0 >> 12) * SEQ * 512 + 128 * wq + gc * 8;
      DSA_GATHER(stA, lr0, TAB_SEL(0), 0); DSA_GATHER(stB, lr0, TAB_SEL(0), 1); }
    for (; qp < 4096; qp += G, par ^= 1) {
        const int q = 2 * qp + team, b = q >> 12;
        const bool has_next = qp + G < 4096; const int qn = q + 2 * G;
        const LAS int* selP = TAB_SEL(par); const LAS int* bktP = TAB_BKT(par); const LAS int* selN = TAB_SEL(par ^ 1);
        const GAS bf16_t* lrow = lat + (size_t)b * SEQ * 512 + 128 * wq + gc * 8;
        const GAS bf16_t* lrowN = lat + (size_t)(qn >> 12) * SEQ * 512 + 128 * wq + gc * 8;
        f32x16 o[4];
#pragma unroll
        for (int c = 0; c < 4; ++c)
#pragma unroll
            for (int r = 0; r < 16; ++r) o[c][r] = 0.f;
        float m = -1e30f, l = 0.f;
#define DSA_CHUNK(ST, c) do { \
            _Pragma("unroll") for (int i = 0; i < 8; ++i) *(LAS u32x4*)(latw + (wbase ^ (unsigned)((i & 3) << 4)) + 1024 * i) = ST[i];        \
            if ((c) + 2 < 8) DSA_GATHER(ST, lrow, selP, (c) + 2); else if (has_next) DSA_GATHER(ST, lrowN, selN, (c) + 2 - 8);        \
            f32x16 sc[1]; \
            _Pragma("unroll") for (int r = 0; r < 16; ++r) sc[0][r] = 0.f; \
            _Pragma("unroll") for (int s_ = 0; s_ < 8; ++s_) { const bf16x8 af = *(const LAS bf16x8*)(latw + (kbase ^ (unsigned)(s_ << 5))); sc[0] = __builtin_amdgcn_mfma_f32_32x32x16_bf16(af, qf[s_], sc[0], 0, 0, 0); } \
            if ((c) == 7 && has_next) DSA_QLOAD(qn);            \
            LAS unsigned char* xc = xch + ((c) & 1) * 8192; \
            _Pragma("unroll") for (int g8 = 0; g8 < 2; ++g8) *(LAS bf16x8*)(xc + wq * 2048 + (g8 * 64 + lane) * 16) = pack8(sc[0], 8 * g8);        \
            TEAM_BAR();                                        \
              \
            float lg[4]; float mx; \
            { f32x4 v = {0.f, 0.f, 0.f, 0.f}; \
              _Pragma("unroll") for (int w = 0; w < 4; ++w) { const u32x2 pw = *(const LAS u32x2*)(xc + w * 2048 + qoff); v = v + (f32x4){bflo(pw.x), bfhi(pw.x), bflo(pw.y), bfhi(pw.y)}; } \
              const u32x4 bk4 = *(const LAS u32x4*)(bktP + 32 * (c) + 8 * wq + 4 * h); \
              _Pragma("unroll") for (int e = 0; e < 4; ++e) { const float bias = *(const LAS float*)((const LAS unsigned char*)t5c + bk4[e] + 4 * (lane & 31)); lg[e] = v[e] * cs + bias; } \
              mx = xhalf_max(fmaxf(fmaxf(lg[0], lg[1]), fmaxf(lg[2], lg[3]))); } \
            if ((c) == 0) {                                    \
                *(LAS float*)(mbuf + (lane & 31) * 16 + wq * 4) = mx; \
                TEAM_BAR(); \
                const f32x4 m4 = *(const LAS f32x4*)(mbuf + (lane & 31) * 16); m = fmaxf(fmaxf(m4[0], m4[1]), fmaxf(m4[2], m4[3])); \
            } \
              \
            { const float p0 = fast_exp2(fminf(lg[0] - m, 100.f)), p1 = fast_exp2(fminf(lg[1] - m, 100.f)), p2 = fast_exp2(fminf(lg[2] - m, 100.f)), p3 = fast_exp2(fminf(lg[3] - m, 100.f)); \
              l += (p0 + p1) + (p2 + p3); \
              *(LAS u32x2*)(pbuf + qoff) = (u32x2){cvtpk(p0, p1), cvtpk(p2, p3)}; \
              if ((c) != 0) *(LAS float*)(mbuf + (lane & 31) * 16 + wq * 4) = mx; } \
            TEAM_BAR();                                        \
            bf16x8 p[1][2]; \
            p[0][0] = *(const LAS bf16x8*)(pbuf + lane * 16); p[0][1] = *(const LAS bf16x8*)(pbuf + (64 + lane) * 16); \
            _Pragma("unroll") for (int cc = 0; cc < 4; ++cc) \
                _Pragma("unroll") for (int s_ = 0; s_ < 2; ++s_) { const bf16x8 af = vfrag2(latw, vbase, cc, 4096 * s_); o[cc] = __builtin_amdgcn_mfma_f32_32x32x16_bf16(af, p[0][s_], o[cc], 0, 0, 0); } \
            if ((c) != 0) {                                    \
                const f32x4 m4 = *(const LAS f32x4*)(mbuf + (lane & 31) * 16); const float mxa = fmaxf(fmaxf(m4[0], m4[1]), fmaxf(m4[2], m4[3])); \
                if (__any(mxa > m + 8.0f)) { const float mn = fmaxf(m, mxa), alpha = fast_exp2(m - mn); l *= alpha; m = mn; \
                    _Pragma("unroll") for (int cc = 0; cc < 4; ++cc) o[cc] = o[cc] * alpha; } \
            } \
            if ((c) == 3 && has_next) { DSA_TABLES(par ^ 1, qn, nxt_idx);        \
                if (qp + 2 * G < 4096) nxt_idx = DSA_SELLOAD(qn + 2 * G); } \
        } while (0)
        for (int c2 = 0; c2 < 8; c2 += 2) { DSA_CHUNK(stA, c2); DSA_CHUNK(stB, c2 + 1); }
#undef DSA_CHUNK
        l = xhalf_sum(l);
        *(LAS float*)(lbuf + (lane & 31) * 16 + wq * 4) = l;
        TEAM_BAR();
        const f32x4 l4 = *(const LAS f32x4*)(lbuf + (lane & 31) * 16);
        const float il = 1.0f / ((l4[0] + l4[1]) + (l4[2] + l4[3]));
        GAS bf16_t* op = olat + (size_t)q * 16384 + (lane & 31) * 512 + 128 * wq + 4 * h;
#pragma unroll
        for (int cc = 0; cc < 4; ++cc)
#pragma unroll
            for (int g4 = 0; g4 < 4; ++g4) { u32x2 w; w.x = cvtpk(o[cc][4 * g4] * il, o[cc][4 * g4 + 1] * il); w.y = cvtpk(o[cc][4 * g4 + 2] * il, o[cc][4 * g4 + 3] * il); *(GAS u32x2*)(op + 32 * cc + 8 * g4) = w; }
    }
    __syncthreads();
#undef TEAM_BAR
#undef TAB_SEL
#undef TAB_BKT
#undef DSA_TABLES
#undef DSA_SELLOAD
#undef DSA_QLOAD
#undef DSA_GATHER
}

constexpr int PH_FINAL = 50, NPH = PH_FINAL + 1;

struct TJob { int in_id; long src_lstride; int ldsrc, K, src_col0, ncols; long dst_off  ; int ldt, dst_row0, gain_id; long gain_lstride, gain_off0; int lsel, flags; };
constexpr int NTJ_E = 12, NTJ_O = 11;
__constant__ TJob g_tj_even[NTJ_E] = {
#define EWIN_JOB(c0, n, r0) {I_EWIN, (long)4096 * 12816, 12816, 4096, c0, n, (long)WS_EWIN, 4096, r0, I_NORMG, (long)2 * 4096, 0, 0, 2}
    EWIN_JOB(0, 2048, E_QA), EWIN_JOB(2048, 2048, E_KA), EWIN_JOB(4096, 2048, E_VA), EWIN_JOB(6160, 2048, E_GA), EWIN_JOB(8208, 2048, E_QB),
    EWIN_JOB(10768, 2048, E_GB), EWIN_JOB(10256, 256, E_KB), EWIN_JOB(10512, 256, E_VB), EWIN_JOB(6144, 16, E_FA),
    {I_EWOUT, (long)4096 * 4096, 4096, 4096, 0, 4096, (long)WS_EWOUT, 4096, 0, -1, 0, 0, 0, 2},
    {I_PWGATE, (long)4096 * 4096, 4096, 4096, 0, 4096, (long)WS_EGATE, 4096, 0, I_PNORMG, (long)4096, 0, 1, 2},
    {I_PWPROJ, (long)256 * 4096, 4096, 256, 0, 4096, (long)WS_EPROJ, 256, 0, -1, 0, 0, 1, 0},
};
__constant__ TJob g_tj_odd[NTJ_O] = {
#define OWIN_JOB(c0, n, r0) {I_OWIN, (long)4096 * 5728, 5728, 4096, c0, n, (long)WS_OWIN, 4096, r0, I_NORMG, (long)2 * 4096, 4096, 0, 0}
    {I_OWIN, (long)4096 * 5728, 5728, 4096, 1632, 4096, (long)WS_OWIN8, 4096, 0, I_NORMG, (long)2 * 4096, 4096, 0, 2},
    OWIN_JOB(0, 1024, 0), OWIN_JOB(1024, 512, 1024), OWIN_JOB(1536, 64, 1536), OWIN_JOB(1600, 32, 1600),
    {I_OWOUT, (long)4096 * 4096, 4096, 4096, 0, 4096, (long)WS_OWOUT, 4096, 0, -1, 0, 0, 0, 2},
    {I_PWGATE, (long)4096 * 4096, 4096, 4096, 0, 4096, (long)WS_OGATE, 4096, 0, I_PNORMG, (long)4096, 0, 1, 2},
    {I_PWPROJ, (long)256 * 4096, 4096, 256, 0, 4096, (long)WS_OPROJ, 256, 0, -1, 0, 0, 1, 0},
    {I_OWUQ,  (long)1024 * 4096, 4096, 1024, 0, 4096, (long)WS_OWUQ, 1024, 0,    -1, 0, 0, 0, 0},
    {I_OWUQI, (long)1024 * 2048, 2048, 1024, 0, 2048, (long)WS_OWUQ, 1024, 4096, -1, 0, 0, 0, 0},
    {I_OWUV, (long)512 * 4096, 4096, 512, 0, 4096, (long)WS_OWUV, 1024, 0, -1, 0, 0, 0, 1},
};

__device__ __forceinline__ void transpose_item(const Args& a, GAS unsigned char* ws, const TJob& jb, int L, int item, LAS float* scr, int lane) {
    const int ncb = (jb.ncols + 31) >> 5, kb = item / ncb, nb = item % ncb, k0 = 64 * kb, n0 = 32 * nb;
    const int li = jb.lsel ? L : (L >> 1);
    const GAS float* W = (const GAS float*)karg_in(jb.in_id) + (size_t)li * jb.src_lstride;
    const GAS float* gain = jb.gain_id >= 0 ? (const GAS float*)karg_in(jb.gain_id) + (size_t)li * jb.gain_lstride + jb.gain_off0 : nullptr;
    const int r8 = lane >> 3, c4 = lane & 7; const bool cv = (n0 + 4 * c4) < jb.ncols;
    f32x4 v[8];
    const GAS float* src = W + (size_t)(k0 + r8) * jb.ldsrc + jb.src_col0 + n0 + 4 * c4;
#pragma unroll
    for (int i = 0; i < 8; ++i) v[i] = cv ? __builtin_nontemporal_load((const GAS f32x4*)(src + (size_t)(8 * i) * jb.ldsrc)) : (f32x4){0.f, 0.f, 0.f, 0.f};
    const int c = lane & 7;
    f32x4 g0 = {1.f, 1.f, 1.f, 1.f}, g1 = g0;
    if (gain) { g0 = *(const GAS f32x4*)(gain + k0 + 8 * c); g1 = *(const GAS f32x4*)(gain + k0 + 8 * c + 4); }
#pragma unroll
    for (int i = 0; i < 8; ++i) { LAS float* d = scr + (8 * i + r8) * 33 + 4 * c4; d[0] = v[i][0]; d[1] = v[i][1]; d[2] = v[i][2]; d[3] = v[i][3]; }
    LDS_WAIT(); asm volatile("" ::: "memory");
    GAS bf16_t* WT = (GAS bf16_t*)(ws + jb.dst_off);
#pragma unroll
    for (int j = 0; j < 4; ++j) { const int n = (lane >> 3) + 8 * j; const LAS float* s = scr + (8 * c) * 33 + n;
        int drow = jb.dst_row0 + n0 + n, dk = k0 + 8 * c;
        if (jb.flags & 2) {
            u32x2 q; q.x = pack4_q8_(s[0 * 33] * g0[0] * W8_SCALE, s[1 * 33] * g0[1] * W8_SCALE, s[2 * 33] * g0[2] * W8_SCALE, s[3 * 33] * g0[3] * W8_SCALE);
            q.y = pack4_q8_(s[4 * 33] * g1[0] * W8_SCALE, s[5 * 33] * g1[1] * W8_SCALE, s[6 * 33] * g1[2] * W8_SCALE, s[7 * 33] * g1[3] * W8_SCALE);
            *(GAS u32x2*)((GAS unsigned char*)ws + jb.dst_off + (size_t)drow * jb.ldt + dk) = q; continue; }
        u32x4 o; o.x = cvtpk(s[0 * 33] * g0[0], s[1 * 33] * g0[1]); o.y = cvtpk(s[2 * 33] * g0[2], s[3 * 33] * g0[3]); o.z = cvtpk(s[4 * 33] * g1[0], s[5 * 33] * g1[1]); o.w = cvtpk(s[6 * 33] * g1[2], s[7 * 33] * g1[3]);
        if (jb.flags & 1) { const int col = n0 + n, h = col >> 7, d = col & 127; drow = (h >> 1) * 256 + (h & 1) * 128 + d; dk = (h & 1) * 512 + k0 + 8 * c; }
        *(GAS u32x4*)(WT + (size_t)drow * jb.ldt + dk) = o; }
    LDS_WAIT(); asm volatile("" ::: "memory");
}

__device__ __forceinline__ void convert_layer_weights(const Args& a, int L, LAS unsigned char* lds, int gw, int NGW, int wave, int part) {
    const int lane = lane_id_();
    unsigned char* ws_ = a.ws; OPAQUE_S(ws_); GAS unsigned char* ws = (GAS unsigned char*)ws_;
    LAS float* scr = (LAS float*)(lds + wave * 16384);
    const bool odd = (L & 1) != 0; const int nj = odd ? NTJ_O : NTJ_E;
    int jstart = 0;
    for (int j = 0; j < nj; ++j) {
        const TJob jb = odd ? g_tj_odd[j] : g_tj_even[j];
        if (part != 0 && ((part == 1) != (jb.in_id == I_OWIN))) continue;
        const int nitems = (jb.K >> 6) * ((jb.ncols + 31) >> 5);
        const int first = (gw - (jstart % NGW) + NGW) % NGW;
        for (int it = first; it < nitems; it += NGW) transpose_item(a, ws, jb, L, it, scr, lane);
        jstart += nitems;
    }
    if (part == 1) return;
    if (!odd) {
        GAS u32x4* z = (GAS u32x4*)(ws + WS_EWIN + (size_t)12832 * 4096); const int n = 224 * 4096 / 16;
        for (int i = gw * 64 + lane; i < n; i += NGW * 64) z[i] = zero4_();
    } else {
        GAS u32x4* z2 = (GAS u32x4*)(ws + WS_OWIN + (size_t)1632 * 4096 * 2); const int n2 = 160 * 4096 * 2 / 16;
        for (int i = gw * 64 + lane; i < n2; i += NGW * 64) z2[i] = zero4_();
        GAS u32x4* z3 = (GAS u32x4*)(ws + WS_OWUV);
        for (int i = gw * 64 + lane; i < 4096 * 64; i += NGW * 64) { const int r = i >> 6, c16 = i & 63; const int zh = ((r >> 7) & 1) ^ 1; z3[(size_t)r * 128 + zh * 64 + c16] = zero4_(); }
        const GAS f32x4* s = (const GAS f32x4*)(((const GAS float*)karg_in(I_OWUK)) + (size_t)(L >> 1) * 512 * 4096); GAS u32x2* d = (GAS u32x2*)(ws + WS_OWUK); const int n = 512 * 4096 / 4;
        for (int i = gw * 64 + lane; i < n; i += NGW * 64) { const f32x4 v = __builtin_nontemporal_load(s + i); d[i] = (u32x2){cvtpk(v[0], v[1]), cvtpk(v[2], v[3])}; }
    }
}

__device__ __forceinline__ void phase_convert(const Args& a, LAS unsigned char* lds, int gw, int NGW, int wave) {
    const int lane = lane_id_();
    unsigned char* ws_ = a.ws; OPAQUE_S(ws_); GAS unsigned char* ws = (GAS unsigned char*)ws_;
    {
        const GAS f32x4* s2 = (const GAS f32x4*)((const GAS float*)karg_in(I_P)); GAS u32x2* d2 = (GAS u32x2*)(ws + WS_PB); const int n2 = 4 * M * 256 / 4;
        for (int i = gw * 64 + lane; i < n2; i += NGW * 64) { const f32x4 v = __builtin_nontemporal_load(s2 + i); d2[i] = (u32x2){cvtpk(v[0], v[1]), cvtpk(v[2], v[3])}; }
    }
    {
        const GAS float* x = ((const GAS float*)karg_in(I_X)); GAS unsigned char* HQ = ws + WS_HQ; GAS float* asc = (GAS float*)(ws + WS_ASCALE); GAS u64* ss = (GAS u64*)(ws + WS_SUMSQ);
        for (int row = gw; row < M; row += NGW) {
            const GAS f32x4* xr = (const GAS f32x4*)(x + (size_t)row * DM); GAS unsigned* qr = (GAS unsigned*)(HQ + (size_t)row * DM); GAS u32x2* hr = (GAS u32x2*)(ws + WS_H + (size_t)row * DM * 2);
            f32x4 v[16]; float s = 0.f, am = 0.f;
#pragma unroll
            for (int j = 0; j < 16; ++j) { v[j] = xr[lane + 64 * j]; s += (v[j][0] * v[j][0] + v[j][1] * v[j][1]) + (v[j][2] * v[j][2] + v[j][3] * v[j][3]); am = fmaxf(fmaxf(am, fmaxf(fabsf(v[j][0]), fabsf(v[j][1]))), fmaxf(fabsf(v[j][2]), fabsf(v[j][3]))); }
            s = wave_sum(s);
#pragma unroll
            for (int o = 1; o < 64; o <<= 1) am = fmaxf(am, __shfl_xor(am, o));
            am = fmaxf(am, 1e-20f); const float qs = 127.0f / am;
#pragma unroll
            for (int j = 0; j < 16; ++j) { qr[lane + 64 * j] = pack4_q8_(v[j][0] * qs, v[j][1] * qs, v[j][2] * qs, v[j][3] * qs); hr[lane + 64 * j] = (u32x2){cvtpk(v[j][0], v[j][1]), cvtpk(v[j][2], v[j][3])}; }
            if (lane == 0) { ss[row] = ss_fix(s); asc[row] = am * (1.0f / 127.0f); }
        }
    }
}

__device__ __forceinline__ void phase_quant_yin(const Args& a, int gw, int NGW) {
    const int lane = lane_id_();
    unsigned char* ws_ = a.ws; OPAQUE_S(ws_); GAS unsigned char* ws = (GAS unsigned char*)ws_;
    const GAS bf16_t* yin = (const GAS bf16_t*)(ws + WS_YIN); GAS unsigned char* yq = ws + WS_YQ; GAS float* asc = (GAS float*)(ws + WS_ASCALEY);
    for (int row = gw; row < M; row += NGW) {
        const GAS u32x4* yr = (const GAS u32x4*)(yin + (size_t)row * DM); GAS u32x2* qr = (GAS u32x2*)(yq + (size_t)row * DM);
        u32x4 w[8]; float am = 0.f;
#pragma unroll
        for (int j = 0; j < 8; ++j) { w[j] = yr[lane + 64 * j];
            am = fmaxf(am, fmaxf(fmaxf(fmaxf(fabsf(bflo(w[j].x)), fabsf(bfhi(w[j].x))), fmaxf(fabsf(bflo(w[j].y)), fabsf(bfhi(w[j].y)))), fmaxf(fmaxf(fabsf(bflo(w[j].z)), fabsf(bfhi(w[j].z))), fmaxf(fabsf(bflo(w[j].w)), fabsf(bfhi(w[j].w)))))); }
#pragma unroll
        for (int o = 1; o < 64; o <<= 1) am = fmaxf(am, __shfl_xor(am, o));
        am = fmaxf(am, 1e-20f); const float qs = 127.0f / am;
#pragma unroll
        for (int j = 0; j < 8; ++j) { u32x2 q; q.x = pack4_q8_(bflo(w[j].x) * qs, bfhi(w[j].x) * qs, bflo(w[j].y) * qs, bfhi(w[j].y) * qs); q.y = pack4_q8_(bflo(w[j].z) * qs, bfhi(w[j].z) * qs, bflo(w[j].w) * qs, bfhi(w[j].w) * qs); qr[lane + 64 * j] = q; }
        if (lane == 0) asc[row] = am * (1.0f / 127.0f);
    }
}
__device__ __forceinline__ void phase_final(const Args& a, int gw, int NGW) {
    const int lane = lane_id_();
    unsigned char* ws_ = a.ws; OPAQUE_S(ws_); GAS unsigned char* ws = (GAS unsigned char*)ws_;
    const GAS bf16_t* H = (const GAS bf16_t*)(ws + WS_H); const GAS u64* ss = (const GAS u64*)(ws + WS_SUMSQ) + 4 * M; const GAS f32x4* g = (const GAS f32x4*)((const GAS float*)karg_in(I_FINALG));
    for (int row = gw; row < M; row += NGW) {
        const float r = 1.0f / sqrtf((float)ss[row] * (1.0f / 16777216.0f) * (1.0f / 4096.0f) + EPS);
        const GAS u32x2* hr = (const GAS u32x2*)(H + (size_t)row * DM); GAS f32x4* orow = (GAS f32x4*)(a.out + (size_t)row * DM);
#pragma unroll 4
        for (int j = 0; j < 16; ++j) { const u32x2 hw = hr[lane + 64 * j]; const f32x4 v = (f32x4){bflo(hw.x), bfhi(hw.x), bflo(hw.y), bfhi(hw.y)}, gg = g[lane + 64 * j]; orow[lane + 64 * j] = v * r * gg; }
    }
}

__global__ void __launch_bounds__(512, 2) fwd(Args args) {
    extern __shared__ __attribute__((aligned(16))) unsigned char lds_raw[];
    LAS unsigned char* lds = (LAS unsigned char*)lds_raw;
    volatile LAS unsigned* MISC = (volatile LAS unsigned*)(lds + MISC_OFF);
    int wave0_ = __builtin_amdgcn_readfirstlane((int)threadIdx.x >> 6);
    asm volatile("" : "+s"(wave0_));
    const int wave0 = wave0_;
    if (wave0 == 0) { const int l_ = lane_id_(); MISC[l_] = (l_ == 16) ? (unsigned)gridDim.x : (l_ == 17) ? (unsigned)blockIdx.x : (l_ == 18) ? (unsigned)args.ph_lo : (l_ == 19) ? (unsigned)args.ph_hi : 0u; }
    __syncthreads();
#define KS_RD(i) ((int)__builtin_amdgcn_readfirstlane((int)*(volatile LAS unsigned*)(size_t)(opaque_vu_((unsigned)MISC_OFF) + 4u * (i))))
#define KS_G0 KS_RD(16)
#define KS_BX0 KS_RD(17)
#define KS_LO KS_RD(18)
#define KS_HI KS_RD(19)
    if (KS_HI - KS_LO > 1) (void)xcd_barrier_post((unsigned*)(args.ws + WS_CTL), MISC + 8, wave0);
#define IN(k) (KS_LO <= (k) && (k) < KS_HI)
#define PHASE_LOCALS() int wave = wave0, G = KS_G0, bx = KS_BX0; asm volatile("" : "+s"(wave), "+s"(G), "+s"(bx)); const int gw = bx * 8 + wave, NGW = G * 8; (void)gw; (void)NGW; \
        unsigned char* ws = args.ws; OPAQUE_S(ws); u64* sumsq = (u64*)(ws + WS_SUMSQ); (void)sumsq; \
        bf16_t* hb_cur = (bf16_t*)(ws + (hbswap ? WS_HBB : WS_HBA)); bf16_t* hb_oth = (bf16_t*)(ws + (hbswap ? WS_HBA : WS_HBB)); (void)hb_cur; (void)hb_oth
#undef SEAM
#define SEAM(k) do { if (IN(k) && IN((k) + 1)) { int wave = wave0; asm volatile("" : "+s"(wave)); unsigned char* _w = args.ws; OPAQUE_S(_w); XcdBarrier _b; _b.bar = (unsigned*)(_w + WS_CTL); _b.x = xb_xcc_id(); _b.st = (volatile LAS unsigned*)(lds + MISC_OFF) + 8; xcd_barrier(_b, wave); } } while (0)
    for (int LL = -2; LL < 8; ++LL) {
        const int L = LL >> 1, st_ = LL & 1;
        const int base = 10 * (L + 1); const bool odd = L >= 0 && (L & 1) != 0;
        const bool mixed = MK_STAGE >= (odd ? 3 : 2);
        const bool hbswap = (MK_STAGE < 3) && ((MK_STAGE == 1 && (L & 1)) || (MK_STAGE == 2 && L >= 2));
        if (st_ == 0) {
        if (IN(base + 0) && mixed && L >= 0)
#pragma unroll 1
        for (int rep_ = 0; rep_ < (((MK_DUP & (1024 | (1 << 26))) && !odd) || ((MK_DUP & 2048) && odd) ? 2 : 1); ++rep_) {
            PHASE_LOCALS();
            if (odd) {
                {
                    pg8::Gemm g{(const bf16_t*)(ws + WS_HQ), (const bf16_t*)(ws + WS_OWIN8), DM, DM, DM, 32, 16, 1, 0, 0};
                    pg8::Sched S; S.init(g, G, bx);
                    pg8::EpiBf16Q E{(bf16_t*)(ws + WS_PROJ), ON, sumsq + L * M, (const float*)(ws + WS_ASCALE), nullptr, 0};
                    pg8::gemm_phase<pg8::EpiBf16Q, true>(lds, g, S, E, wave); }
                {
                    PHASE_LOCALS();
                    pg8::Gemm g{(const bf16_t*)(ws + WS_H), (const bf16_t*)(ws + WS_OWIN), DM, DM, DM, 32, 7, 1, 0, 0};
                    pg8::Sched S; S.init(g, G, bx);
                    pg8::EpiBf16 E{(bf16_t*)(ws + WS_PROJ) + 4096, ON, 0, sumsq + L * M};
                    pg8::gemm_phase(lds, g, S, E, wave); }
            } else {
                pg8::Gemm g{(const bf16_t*)(ws + WS_HQ), (const bf16_t*)(ws + WS_EWIN), DM, DM, DM, 32, EN / 256, 1, 0, 0};
                pg8::Sched S; S.init(g, G, bx);
                pg8::EpiBf16Q E{(bf16_t*)(ws + WS_PROJ), EN, sumsq + L * M, (const float*)(ws + WS_ASCALE), (u64*)(ws + WS_KN) + (size_t)(L >> 1) * 16 * M, ((MK_DUP & (1 << 26)) && rep_ == 0) ? 1 : 0};
                pg8::gemm_phase<pg8::EpiBf16Q, true>(lds, g, S, E, wave);
            }
        }
        } else if (IN(base + 1)) {
            PHASE_LOCALS();
            if (mixed && !odd && L >= 0) { phase_even_attn(args, L >> 1, lds, G, bx, wave, 3); if (MK_DUP & 1) phase_even_attn(args, L >> 1, lds, G, bx, wave, 3); if (MK_DUP & 32) phase_even_attn(args, L >> 1, lds, G, bx, wave, 1); if (MK_DUP & 64) phase_even_attn(args, L >> 1, lds, G, bx, wave, 2); }
            if (mixed && odd) for (int rep_ = 0; rep_ < ((MK_DUP & 65536) ? 2 : 1); ++rep_) phase_odd_norms(args, L >> 1, gw, NGW);
            __syncthreads();
            if (L < 0) for (int rep_ = 0; rep_ < ((MK_DUP & 262144) ? 2 : 1); ++rep_) phase_convert(args, lds, gw, NGW, wave);
        }
        { const bool go_ = st_ == 0 ? (IN(base + 0) && mixed && L >= 0 && !odd && L < 3) : (IN(base + 1) && L < 3);
          if (go_) {
            PHASE_LOCALS();
            const int tail_ = (L >= 0 && !odd) ? (32 * (EN / 256)) % G : 0;
            int cgw_ = gw, cn_ = NGW, part_ = tail_ > 0 ? 2 : 0;
            if (st_ == 0) { part_ = (tail_ > 0 && bx >= tail_) ? 1 : -1; cgw_ = (bx - tail_) * 8 + wave; cn_ = (G - tail_) * 8; }
            asm volatile("" : "+s"(cgw_), "+s"(cn_), "+s"(part_));
            if (part_ >= 0) { __syncthreads(); convert_layer_weights(args, L + 1, lds, cgw_, cn_, wave, part_); __syncthreads(); }
          } }
        if (st_ == 0) { if (L >= 0) SEAM(base + 0); continue; }
        SEAM(base + 1);
        if (mixed && odd) {
            if (IN(base + 2))
#pragma unroll 1
            for (int rep_ = 0; rep_ < ((MK_DUP & 4096) ? 2 : 1); ++rep_) {
                PHASE_LOCALS();
                pg8::Gemm g{(const bf16_t*)(ws + WS_CQN), (const bf16_t*)(ws + WS_OWUQ), 1024, 1024, 1024, 32, QW / 256, 1, 0, 0};
                pg8::Sched S; S.init(g, G, bx);
                pg8::EpiBf16 E{(bf16_t*)(ws + WS_QBUF), QW, 0, nullptr};
                pg8::gemm_phase(lds, g, S, E, wave);
            }
            SEAM(base + 2);
            if (IN(base + 3)) {
#pragma unroll 1
                for (int rep_ = 0; rep_ < ((MK_DUP & 8192) ? 2 : 1); ++rep_) { PHASE_LOCALS();
                  pg8::Gemm g{(const bf16_t*)(ws + WS_QBUF), (const bf16_t*)(ws + WS_OWUK), QW, 4096, 128, 32, 2, 32, 128, 128};
                  pg8::Sched S; S.init(g, G, bx);
                  pg8::EpiBf16 E{(bf16_t*)(ws + WS_QABS), 16384, 512, nullptr};
                  pg8::gemm_phase(lds, g, S, E, wave); }
                { PHASE_LOCALS(); if (MK_DUP & 128) phase_indexer(args, lds, G, bx, wave, false); phase_indexer(args, lds, G, bx, wave, true); if (MK_DUP & 2) phase_indexer(args, lds, G, bx, wave, true); }
            }
            SEAM(base + 3);
            if (IN(base + 4)) { PHASE_LOCALS(); phase_dsa(args, lds, G, bx, wave, 0); if (MK_DUP & 4) phase_dsa(args, lds, G, bx, wave, 0); }
            SEAM(base + 4);
            if (IN(base + 5))
#pragma unroll 1
            for (int rep_ = 0; rep_ < ((MK_DUP & 16384) ? 2 : 1); ++rep_) {
                PHASE_LOCALS();
                pg8::Gemm g{(const bf16_t*)(ws + WS_OLAT), (const bf16_t*)(ws + WS_OWUV), 16384, 1024, 1024, 32, 1, 16, 1024, (size_t)256 * 1024};
                pg8::Sched S; S.init(g, G, bx);
                pg8::EpiOGate E{(bf16_t*)(ws + WS_YIN), (const bf16_t*)(ws + WS_PROJ) + O_GC, ON};
                pg8::gemm_phase(lds, g, S, E, wave);
            }
            SEAM(base + 5);
        }
        const int phq = odd ? base + 6 : base + 2, ph5 = phq + 1, ph6 = ph5 + 1;
        if (IN(phq) && L >= 0) for (int rep_ = 0; rep_ < ((MK_DUP & 32768) ? 2 : 1); ++rep_) { PHASE_LOCALS(); phase_quant_yin(args, gw, NGW); }
        if (L >= 0) SEAM(phq);
        if (IN(ph5) && L >= 0) {
            if (mixed) {
                PHASE_LOCALS();
                pg8::Gemm g{(const bf16_t*)(ws + WS_YQ), (const bf16_t*)(ws + (odd ? WS_OWOUT : WS_EWOUT)), DM, DM, DM, 32, 16, 1, 0, 0};
                pg8::Sched S; S.init(g, G, bx);
                pg8::EpiResid E{(const bf16_t*)(ws + WS_H), (bf16_t*)(ws + WS_H), (signed char*)(ws + WS_HBB), (float*)(ws + WS_ASCALE1), sumsq + L * M, sumsq + (5 + L) * M, (const float*)(ws + WS_ASCALEY)};
                pg8::gemm_phase<pg8::EpiResid, true>(lds, g, S, E, wave);
            }
#pragma unroll 1
            for (int rep_ = 0; rep_ < ((MK_DUP & 131072) ? 2 : 1); ++rep_) {
                PHASE_LOCALS();
                pg8::Gemm g{(const bf16_t*)(ws + WS_PB) + (size_t)L * M * 256, (const bf16_t*)(ws + (odd ? WS_OPROJ : WS_EPROJ)), 256, 256, 256, 32, 16, 1, 0, 0};
                pg8::Sched S; S.init(g, G, bx);
                pg8::EpiBf16 E{(bf16_t*)(ws + WS_PP), DM, 0, nullptr};
                pg8::gemm_phase(lds, g, S, E, wave);
            }
        }
        if (L >= 0) SEAM(ph5);
        if (IN(ph6) && L >= 0) {
            PHASE_LOCALS();
            pg8::Gemm g{(const bf16_t*)(ws + WS_HBB), (const bf16_t*)(ws + (odd ? WS_OGATE : WS_EGATE)), DM, DM, DM, 32, 16, 1, 0, 0};
            pg8::Sched S; S.init(g, G, bx);
            pg8::EpiGate E{(bf16_t*)(ws + WS_H), (const bf16_t*)(ws + WS_PP), sumsq + (mixed ? (5 + L) : L) * M, sumsq + (L + 1) * M, (L < 3) ? (signed char*)(ws + WS_HQ) : nullptr, (float*)(ws + WS_ASCALE), (const float*)(ws + WS_ASCALE1)};
            pg8::gemm_phase<pg8::EpiGate, true>(lds, g, S, E, wave);
        }
        if (L >= 0) SEAM(ph6);
    }
    if (IN(PH_FINAL)) for (int rep_ = 0; rep_ < ((MK_DUP & 524288) ? 2 : 1); ++rep_) phase_final(args, KS_BX0 * 8 + wave0, KS_G0 * 8);
#undef IN
#undef SEAM
}

extern "C" void kernel_launch(void* const* d_in, const int* in_sizes, int n_in, void* d_out, int out_size, void* d_ws, size_t ws_size, hipStream_t stream) {
    static int grid = 0;
    if (grid == 0) {
        if (n_in != 22 || out_size != M * DM || ws_size < WS_END) { fprintf(stderr, "kernel_launch: unexpected shapes (n_in %d out %d ws %zu, need %zu)\n", n_in, out_size, ws_size, (size_t)WS_END); grid = -1; return; }
        int dev = 0, cus = 0, per_cu = 0;
        if (hipGetDevice(&dev) != hipSuccess || hipDeviceGetAttribute(&cus, hipDeviceAttributeMultiprocessorCount, dev) != hipSuccess) { grid = -1; return; }
        if (hipFuncSetAttribute((const void*)fwd, hipFuncAttributeMaxDynamicSharedMemorySize, LDS_BYTES) != hipSuccess) { fprintf(stderr, "kernel_launch: hipFuncSetAttribute failed\n"); grid = -1; return; }
        if (hipOccupancyMaxActiveBlocksPerMultiprocessor(&per_cu, (const void*)fwd, 512, LDS_BYTES) != hipSuccess || per_cu < 1) { fprintf(stderr, "kernel_launch: occupancy query says %d\n", per_cu); }
        (void)hipGetLastError();
        grid = cus;
    }
    if (grid < 0) return;
    if (hipMemsetAsync((char*)d_ws + WS_CTL, 0, WS_ZERO_BYTES, stream) != hipSuccess) return;
    Args a{};
    for (int i = 0; i < 22; ++i) a.in[i] = (const float*)d_in[i];
    a.out = (float*)d_out; a.ws = (unsigned char*)d_ws;
#if MK_ONE_LAUNCH
    a.ph_lo = 0; a.ph_hi = NPH;
    hipLaunchKernelGGL(fwd, dim3(grid), dim3(512), LDS_BYTES, stream, a);
#else
    for (int ph = 0; ph < NPH; ++ph) {
        if (ph < PH_FINAL) { const int L = ph / 10 - 1, k = ph % 10; if (L < 0 && k != 1) continue; if (L >= 0 && !(L & 1) && k >= 5) continue; if (L >= 0 && (L & 1) && k >= 9) continue; }
        a.ph_lo = ph; a.ph_hi = ph + 1;
        hipLaunchKernelGGL(fwd, dim3(grid), dim3(512), LDS_BYTES, stream, a);
    }
#endif
}
```

```cpp
#include <hip/hip_runtime.h>
#include <cstdio>
#include <cstdint>

#define LAS __attribute__((address_space(3)))
#define GAS __attribute__((address_space(1)))
typedef unsigned short bf16_t;
typedef short bf16x8 __attribute__((ext_vector_type(8)));
typedef short s16x4 __attribute__((ext_vector_type(4)));
typedef short v4i16_t __attribute__((ext_vector_type(4)));
typedef float f32x2 __attribute__((ext_vector_type(2)));
typedef float f32x4 __attribute__((ext_vector_type(4)));
typedef float f32x16 __attribute__((ext_vector_type(16)));
typedef unsigned u32x2 __attribute__((ext_vector_type(2)));
typedef unsigned u32x4 __attribute__((ext_vector_type(4)));
typedef __bf16 bf16x2_t __attribute__((ext_vector_type(2)));
typedef GAS unsigned gu32;

#ifndef MK_STAGE
#define MK_STAGE 3
#endif
#ifndef MK_DUP
#define MK_DUP 0
#endif
#ifndef MK_ONE_LAUNCH
#define MK_ONE_LAUNCH 1
#endif

constexpr int M = 8192, DM = 4096, SEQ = 4096;
constexpr float EPS = 1e-6f;
constexpr float LOG2E = 1.4426950408889634f;
constexpr int EN = 13056;
constexpr int ON = 5888;
constexpr int E_QA = 0, E_KA = 2048, E_VA = 4096, E_GA = 6144, E_QB = 8192, E_GB = 10240, E_KB = 12288, E_VB = 12544, E_FA = 12800;
constexpr int O_GC = 0, O_CQ = 4096, O_CKV = 5120, O_KIDX = 5632, O_WIDX = 5696;
constexpr int QW = 6144;

constexpr size_t MiB = 1u << 20;
constexpr size_t WS_CTL = 0;
constexpr size_t WS_SUMSQ = 1 * MiB;
constexpr size_t WS_KN = 2 * MiB;
constexpr size_t WS_ZERO_BYTES = 4 * MiB;
constexpr size_t SZ_SQ = (size_t)4096 * 4096 * 2;
constexpr size_t SZ_WPROJ = (size_t)4096 * 256 * 2;
constexpr size_t WS_EWIN = 4 * MiB;
constexpr size_t WS_EWOUT = WS_EWIN + (size_t)EN * 4096 * 2;
constexpr size_t WS_EGATE = WS_EWOUT + SZ_SQ;
constexpr size_t WS_EPROJ = WS_EGATE + SZ_SQ;
constexpr size_t WS_OWIN = WS_EPROJ + SZ_WPROJ;
constexpr size_t WS_OWIN8 = WS_OWIN + (size_t)1792 * 4096 * 2;
constexpr size_t WS_OWUQ = WS_OWIN + (size_t)ON * 4096 * 2;
constexpr size_t WS_OWUK = WS_OWUQ + (size_t)QW * 1024 * 2;
constexpr size_t WS_OWUV = WS_OWUK + (size_t)512 * 4096 * 2;
constexpr size_t WS_OWOUT = WS_OWUV + (size_t)16 * 256 * 1024 * 2;
constexpr size_t WS_OGATE = WS_OWOUT + SZ_SQ;
constexpr size_t WS_OPROJ = WS_OGATE + SZ_SQ;
constexpr size_t WS_H = WS_OPROJ + SZ_WPROJ;
constexpr size_t WS_HBA = WS_H + (size_t)M * 4096 * 4;
constexpr size_t SZ_ACT = (size_t)M * 4096 * 2;
constexpr size_t WS_HBB = WS_HBA + SZ_ACT;
constexpr size_t WS_YIN = WS_HBB + SZ_ACT;
constexpr size_t WS_SCORE = WS_YIN;
constexpr size_t WS_PP = WS_YIN + SZ_ACT;
constexpr size_t WS_PB = WS_PP + SZ_ACT;
constexpr size_t WS_PROJ = WS_PB + (size_t)4 * M * 256 * 2;
constexpr size_t WS_CQN = WS_PROJ + (size_t)M * EN * 2;
constexpr size_t WS_LAT = WS_CQN + (size_t)M * 1024 * 2;
constexpr size_t WS_KIDX = WS_LAT + (size_t)M * 512 * 2;
constexpr size_t WS_WIDX = WS_KIDX + (size_t)M * 64 * 2;
constexpr size_t WS_SEL = WS_WIDX + (size_t)M * 32 * 4;
constexpr size_t WS_QBUF = WS_SEL + (size_t)M * 256 * 4;
constexpr size_t WS_QABS = WS_QBUF + (size_t)M * QW * 2;
constexpr size_t WS_OLAT = WS_QABS + (size_t)M * 16384 * 2;
constexpr size_t WS_HQ = WS_OLAT + (size_t)M * 16384 * 2;
constexpr size_t WS_ASCALE = WS_HQ + (size_t)M * 4096;
constexpr size_t WS_ASCALE1 = WS_ASCALE + (size_t)M * 4;
constexpr size_t WS_ASCALEY = WS_ASCALE1 + (size_t)M * 4;
constexpr size_t WS_YQ = WS_PROJ;
constexpr size_t WS_END = WS_ASCALEY + (size_t)M * 4;
static_assert(WS_END <= (size_t)4 * 2 * 4096 * 12816 * 4, "workspace map exceeds the guaranteed size (4 x the largest input)");

constexpr int LDS_BYTES = 155648;
constexpr int MISC_OFF = LDS_BYTES - 256;

__device__ __forceinline__ unsigned cvtpk(float lo, float hi) { f32x2 v = {lo, hi}; bf16x2_t b = __builtin_convertvector(v, bf16x2_t); return __builtin_bit_cast(unsigned, b); }
__device__ __forceinline__ float bf2f(unsigned short b) { return __uint_as_float(((unsigned)b) << 16); }
__device__ __forceinline__ float bflo(unsigned w) { return __uint_as_float(w << 16); }
__device__ __forceinline__ float bfhi(unsigned w) { return __uint_as_float(w & 0xffff0000u); }
__device__ __forceinline__ float wave_sum(float v) {
#pragma unroll
    for (int o = 1; o < 64; o <<= 1) v += __shfl_xor(v, o);
    return v;
}
__device__ __forceinline__ float xhalf_max(float m) { auto rr = __builtin_amdgcn_permlane32_swap(__float_as_uint(m), __float_as_uint(m), false, false); return fmaxf(__uint_as_float(rr[0]), __uint_as_float(rr[1])); }
__device__ __forceinline__ float xhalf_sum(float m) { auto rr = __builtin_amdgcn_permlane32_swap(__float_as_uint(m), __float_as_uint(m), false, false); return __uint_as_float(rr[0]) + __uint_as_float(rr[1]); }
__device__ __forceinline__ int lane_id_() { int l = (int)__builtin_amdgcn_mbcnt_hi(~0u, __builtin_amdgcn_mbcnt_lo(~0u, 0u)); asm volatile("" : "+v"(l)); return l; }
typedef unsigned long long u64;
__device__ __forceinline__ u64 ss_fix(float s2) { return (u64)(s2 * 16777216.0f); }
__device__ __forceinline__ float ss_rstd(u64 v) { return __builtin_amdgcn_rsqf((float)v * (1.0f / 16777216.0f) * (1.0f / 4096.0f) + EPS); }
__device__ __forceinline__ unsigned opaque_vu_(unsigned v) { asm volatile("" : "+v"(v)); return v; }
__device__ __forceinline__ u32x4 zero4_() { unsigned z = 0u; asm volatile("" : "+v"(z)); return (u32x4){z, z, z, z}; }
typedef int i32x4 __attribute__((ext_vector_type(4)));
constexpr float W8_SCALE = 1354.0f;
__device__ __forceinline__ int q8_(float v) { const int q = (int)__builtin_rintf(v); return q < -127 ? -127 : (q > 127 ? 127 : q); }
__device__ __forceinline__ unsigned pack4_q8_(float a, float b, float c, float d) { return (unsigned)(q8_(a) & 255) | ((unsigned)(q8_(b) & 255) << 8) | ((unsigned)(q8_(c) & 255) << 16) | ((unsigned)(q8_(d) & 255) << 24); }
__device__ __forceinline__ float fast_exp2(float x) { return __builtin_amdgcn_exp2f(x); }
__device__ __forceinline__ float sigmoidf_(float x) { return 1.0f / (1.0f + __expf(-x)); }
__device__ __forceinline__ float siluf_(float x) { return x / (1.0f + __expf(-x)); }
#define OPAQUE_S(p) do { unsigned long long _v = (unsigned long long)(p); unsigned _lo = (unsigned)_v, _hi = (unsigned)(_v >> 32); asm volatile("" : "+v"(_lo), "+v"(_hi)); \
    _lo = __builtin_amdgcn_readfirstlane(_lo); _hi = __builtin_amdgcn_readfirstlane(_hi); (p) = (decltype(p))(((unsigned long long)_hi << 32) | _lo); } while (0)
#define G1(T, p) ((GAS T*)(p))
#define CAS __attribute__((address_space(4)))
__device__ __forceinline__ const float* karg_in(int id) {
    const CAS char* kp = (const CAS char*)__builtin_amdgcn_kernarg_segment_ptr();
    asm volatile("" : "+s"(kp));
    return *(const float* const CAS*)(kp + 8 * id);
}
#define LDS_WAIT() asm volatile("s_waitcnt lgkmcnt(0)" ::: "memory")
#define VM_WAIT() asm volatile("s_waitcnt vmcnt(0)" ::: "memory")

#define XB_TMO      128
#define XB_XCNT(j)  (256  + 64 * (j))
#define XB_XSUB(j)  (1280 + 64 * (j))
#define XB_XGEN(j)  (2304 + 64 * (j))
#define XB_TOP      3328
#define XB_TOPGEN   3392
#define XCD_BAR_WORDS 3456
#define XB_SPIN_CAP (1u << 22)
__device__ __forceinline__ unsigned xb_ld(unsigned* p)              { return __hip_atomic_load((gu32*)p, __ATOMIC_RELAXED, __HIP_MEMORY_SCOPE_AGENT); }
__device__ __forceinline__ unsigned xb_add(unsigned* p, unsigned v) { return __hip_atomic_fetch_add((gu32*)p, v, __ATOMIC_RELAXED, __HIP_MEMORY_SCOPE_AGENT); }
__device__ __forceinline__ unsigned xb_xcc_id() { return (unsigned)__builtin_amdgcn_s_getreg((3 << 11) | 20) & 0xFu; }
#define XB_SPIN(cond, bar) do { unsigned _sp = 0; while (cond) { __builtin_amdgcn_s_sleep(1); \
    if ((++_sp & 255u) == 0u) { if (xb_ld(&(bar)[XB_TMO])) break; if (_sp > XB_SPIN_CAP) { (void)xb_add(&(bar)[XB_TMO], 1u); break; } } } } while (0)
struct XcdBarrier { unsigned* bar; unsigned x; volatile LAS unsigned* st; };
__device__ __forceinline__ XcdBarrier xcd_barrier_post(unsigned* bar, volatile LAS unsigned* st, const int wave) {
    XcdBarrier b; b.bar = bar; b.x = xb_xcc_id(); b.st = st;
    if (wave == 0 && lane_id_() == 0) (void)xb_add(&bar[XB_XCNT(b.x)], 1u);
    return b;
}
__device__ __forceinline__ void xcd_barrier_complete(unsigned* bar, unsigned x, unsigned& nloc, unsigned& nx) {
    const unsigned G = gridDim.x * gridDim.y * gridDim.z;
    unsigned sum, cnt, mine, sp = 0u;
    for (;;) {
        sum = 0u; cnt = 0u; mine = 0u;
#pragma unroll 1
        for (unsigned j = 0; j < 16; ++j) { const unsigned c = xb_ld(&bar[XB_XCNT(j)]); sum += c; cnt += (c > 0u) ? 1u : 0u; mine = (j == x) ? c : mine; }
        if (sum == G) break;
        __builtin_amdgcn_s_sleep(1);
        if ((++sp & 255u) == 0u) { if (xb_ld(&bar[XB_TMO])) break; if (sp > XB_SPIN_CAP) { (void)xb_add(&bar[XB_TMO], 1u); break; } }
    }
    nloc = mine > 0u ? mine : 1u; nx = cnt > 0u ? cnt : 1u;
}
__device__ __forceinline__ void xcd_barrier(const XcdBarrier& b, const int wave) {
    asm volatile("s_waitcnt vmcnt(0)" ::: "memory");
    __syncthreads();
    if (wave == 0 && lane_id_() == 0) {
        unsigned* bar = b.bar;
        __builtin_amdgcn_s_waitcnt(0);
        unsigned nloc = b.st[0], nx = b.st[1];
        if (nloc == 0u) { xcd_barrier_complete(bar, b.x, nloc, nx); b.st[0] = nloc; b.st[1] = nx; }
        const unsigned old = xb_add(&bar[XB_XSUB(b.x)], 1u);
        const unsigned gen = old / nloc;
        if (old + 1u == (gen + 1u) * nloc) {
            __builtin_amdgcn_fence(__ATOMIC_RELEASE, "agent");
            asm volatile("s_waitcnt vmcnt(0)" ::: "memory");
            const unsigned og = xb_add(&bar[XB_TOP], 1u);
            const unsigned tg = og / nx;
            if (og + 1u == (tg + 1u) * nx) xb_add(&bar[XB_TOPGEN], 1u);
            else XB_SPIN(xb_ld(&bar[XB_TOPGEN]) == tg, bar);
            __builtin_amdgcn_fence(__ATOMIC_ACQUIRE, "agent");
            xb_add(&bar[XB_XGEN(b.x)], 1u);
            asm volatile("s_waitcnt vmcnt(0)" ::: "memory");
        } else {
            XB_SPIN(xb_ld(&bar[XB_XGEN(b.x)]) == gen, bar);
            __builtin_amdgcn_fence(__ATOMIC_ACQUIRE, "agent");
            asm volatile("s_waitcnt vmcnt(0)" ::: "memory");
        }
    }
    __syncthreads();
}

namespace pg8 {
__device__ __forceinline__ void glds16_s(const void* sbase, unsigned voff, unsigned lds_dst) {
    unsigned keep;
    asm volatile("s_mov_b32 %0, m0\n\ts_mov_b32 m0, %3\n\ts_nop 0\n\tglobal_load_lds_dwordx4 %1, %2\n\ts_mov_b32 m0, %0" : "=&s"(keep) : "v"(voff), "s"(sbase), "s"(lds_dst) : "memory");
}
constexpr int BM = 256, BK = 64, HALF = 128, HTB = HALF * BK * 2, STAGE_BYTES = 8 * HTB, NXCD = 8, WGM = 8;
__host__ __device__ __forceinline__ int lds_byte(int r, int c) { const int st = (r >> 4) * 2 + (c >> 5), rr = r & 15, cc = c & 31, ob = rr * 64 + cc * 2; return st * 1024 + (ob ^ (((ob >> 9) & 1) << 5)); }
__host__ __device__ __forceinline__ void stage_rc(int b, int& R, int& C) { const int st = b / 1024, sb = b % 1024, swz = sb ^ (((sb >> 9) & 1) << 5); R = (st >> 1) * 16 + swz / 64; C = (st & 1) * 32 + (swz % 64) / 2; }
__host__ __device__ __forceinline__ int perm32(int rho) { const int n = rho >> 4, i = rho & 15; return 8 * (i >> 2) + 4 * n + (i & 3); }

struct Unit { int pm, pn, g; };
struct Gemm { const bf16_t* A; const bf16_t* Bt; int lda, ldb, K, nM, nN, ng; size_t gsA, gsB; };

struct Sched {
    int nM, nN, nwg, total, G, c;
    __device__ void init(const Gemm& g, int G_, int c_) { nM = g.nM; nN = g.nN; nwg = nM * nN; total = nwg * g.ng; G = G_; c = c_; }
    __device__ bool next(int i, Unit& u) const {
        const long L = (long)i * G + c; if (L >= total) return false;
        u.g = (int)(L / nwg); int wgid = (int)(L % nwg);
        { const int q = nwg / NXCD, r = nwg % NXCD, xcd = wgid % NXCD, off = wgid / NXCD; wgid = (xcd < r ? xcd * (q + 1) : r * (q + 1) + (xcd - r) * q) + off; }
        const int nig = WGM * nN, gid = wgid / nig, fm = gid * WGM, gsz = (nM - fm) < WGM ? (nM - fm) : WGM;
        u.pm = fm + ((wgid % nig) % gsz); u.pn = (wgid % nig) / gsz; return true;
    }
};

template <class Epi, bool I8 = false>
__device__ __forceinline__ void gemm_phase(LAS unsigned char* lds, const Gemm g, const Sched& S, const Epi& E, const int wid) {
    const int lane = lane_id_(), tid = wid * 64 + lane;
    const int wr = wid >> 2, wc = wid & 3, fr = lane & 15, fq = lane >> 4;
    const bf16_t* gA = g.A; const bf16_t* gB = g.Bt; OPAQUE_S(gA); OPAQUE_S(gB);
    constexpr int ESZ = I8 ? 1 : 2;
    const int K = g.K, nt = K * ESZ / (BK * 2);
    unsigned voffA[2], voffB[2];
#pragma unroll
    for (int i = 0; i < 2; ++i) { int R, C; stage_rc(tid * 16 + i * 8192, R, C); const int Rb = (R & ~31) + perm32(R & 31);
        voffA[i] = (unsigned)(R * g.lda * ESZ + C * 2); voffB[i] = (unsigned)(Rb * g.ldb * ESZ + C * 2); }
    const size_t kstep = (size_t)(BK * 2);
    const size_t hstepA = (size_t)HALF * g.lda * ESZ, hstepB = (size_t)HALF * g.ldb * ESZ;
    const size_t tstepA = 2 * hstepA, tstepB = 2 * hstepB;
    const unsigned ldsbase = (unsigned)(size_t)lds + (unsigned)wid * 1024u;
    const int aoff = lds_byte(wr * 64 + fr, fq * 8), boff = lds_byte(wc * 32 + fr, fq * 8);
#define PG8_SA(b, h) (((b) * 2 + (h)) * HTB)
#define PG8_SB(b, h) ((4 + (b) * 2 + (h)) * HTB)
#define PG8_STAGE(bufoff, gbase, voff) do { _Pragma("unroll") for (int _i = 0; _i < 2; ++_i) glds16_s((const void*)(gbase), (voff)[_i], ldsbase + (unsigned)((bufoff) + _i * 8192)); } while (0)
#define PG8_LDA(dst, b, h) do { _Pragma("unroll") for (int m = 0; m < 4; ++m) _Pragma("unroll") for (int k = 0; k < 2; ++k) dst[m][k] = *(const LAS bf16x8*)(lds + PG8_SA(b, h) + aoff + m * 2048 + k * 1024); } while (0)
#define PG8_LDB(dst, b, h) do { _Pragma("unroll") for (int n = 0; n < 2; ++n) _Pragma("unroll") for (int k = 0; k < 2; ++k) dst[n][k] = *(const LAS bf16x8*)(lds + PG8_SB(b, h) + boff + n * 2048 + k * 1024); } while (0)
#define PG8_MMA(ai, bj, At, Bt) do { __builtin_amdgcn_s_setprio(1); _Pragma("unroll") for (int m = 0; m < 4; ++m) _Pragma("unroll") for (int n = 0; n < 2; ++n) _Pragma("unroll") for (int k = 0; k < 2; ++k) { \
        if constexpr (I8) acc[ai][bj][m][n] = __builtin_bit_cast(f32x4, __builtin_amdgcn_mfma_i32_16x16x64_i8(__builtin_bit_cast(i32x4, Bt[n][k]), __builtin_bit_cast(i32x4, At[m][k]), __builtin_bit_cast(i32x4, acc[ai][bj][m][n]), 0, 0, 0)); \
        else acc[ai][bj][m][n] = __builtin_amdgcn_mfma_f32_16x16x32_bf16(Bt[n][k], At[m][k], acc[ai][bj][m][n], 0, 0, 0); } __builtin_amdgcn_s_setprio(0); } while (0)
#define PG8_WAIT_V(n) asm volatile("s_waitcnt vmcnt(" #n ")" ::: "memory")
#define PG8_WAIT_L(n) asm volatile("s_waitcnt lgkmcnt(" #n ")" ::: "memory")
#define PG8_BAR __builtin_amdgcn_s_barrier()
#define PG8_SCHED __builtin_amdgcn_sched_barrier(0)
    Unit cur, nxt; int ui = 0;
    if (!S.next(0, cur)) return;
    f32x4 acc[2][2][4][2];
#pragma unroll
    for (int a = 0; a < 2; ++a)
#pragma unroll
        for (int b = 0; b < 2; ++b)
#pragma unroll
            for (int m = 0; m < 4; ++m)
#pragma unroll
                for (int n = 0; n < 2; ++n) acc[a][b][m][n] = (f32x4){0.f, 0.f, 0.f, 0.f};
    bf16x8 At[4][2], B0[2][2], B1[2][2];
    const char* cA = (const char*)(gA + (size_t)cur.g * g.gsA) + (size_t)cur.pm * tstepA; const char* cB = (const char*)(gB + (size_t)cur.g * g.gsB) + (size_t)cur.pn * tstepB;
    PG8_STAGE(PG8_SB(0, 0), cB, voffB); PG8_STAGE(PG8_SB(0, 1), cB + hstepB, voffB); PG8_STAGE(PG8_SA(0, 0), cA, voffA); PG8_STAGE(PG8_SA(0, 1), cA + hstepA, voffA);
    if (wr == 1) PG8_BAR;
    PG8_WAIT_V(2); PG8_BAR;
    PG8_STAGE(PG8_SB(1, 0), cB + kstep, voffB); PG8_STAGE(PG8_SA(1, 0), cA + kstep, voffA); PG8_STAGE(PG8_SB(1, 1), cB + hstepB + kstep, voffB);
    PG8_WAIT_V(6); PG8_BAR;
    for (;;) {
        const bool has_next = S.next(ui + 1, nxt);
        const char* nA = has_next ? (const char*)(gA + (size_t)nxt.g * g.gsA) + (size_t)nxt.pm * tstepA : cA; const char* nB = has_next ? (const char*)(gB + (size_t)nxt.g * g.gsB) + (size_t)nxt.pn * tstepB : cB;
        for (int t = 0; t < nt; t += 2) {
            const bool last = (t == nt - 2);
            const char* a1 = cA + (size_t)(t + 1) * kstep;
            const char* a2 = last ? nA : cA + (size_t)(t + 2) * kstep; const char* b2 = last ? nB : cB + (size_t)(t + 2) * kstep;
            const char* a3 = a2 + kstep; const char* b3 = b2 + kstep;
            PG8_LDB(B0, 0, 0); PG8_LDB(B1, 0, 1); PG8_SCHED; PG8_LDA(At, 0, 0); PG8_STAGE(PG8_SA(1, 1), a1 + hstepA, voffA);
            PG8_WAIT_V(8); PG8_WAIT_L(0); PG8_BAR; PG8_MMA(0, 0, At, B0); PG8_MMA(0, 1, At, B1); PG8_BAR; PG8_SCHED;
            PG8_LDA(At, 0, 1); PG8_STAGE(PG8_SB(0, 0), b2, voffB); PG8_STAGE(PG8_SB(0, 1), b2 + hstepB, voffB); PG8_STAGE(PG8_SA(0, 0), a2, voffA);
            PG8_WAIT_V(8); PG8_WAIT_L(0); PG8_BAR; PG8_MMA(1, 0, At, B0); PG8_MMA(1, 1, At, B1); PG8_BAR; PG8_SCHED;
            PG8_LDB(B0, 1, 0); PG8_LDB(B1, 1, 1); PG8_SCHED; PG8_LDA(At, 1, 0); PG8_STAGE(PG8_SA(0, 1), a2 + hstepA, voffA);
            PG8_WAIT_V(8); PG8_WAIT_L(0); PG8_BAR; PG8_MMA(0, 0, At, B0); PG8_MMA(0, 1, At, B1); PG8_BAR; PG8_SCHED;
            PG8_LDA(At, 1, 1); PG8_STAGE(PG8_SB(1, 0), b3, voffB); PG8_STAGE(PG8_SB(1, 1), b3 + hstepB, voffB); PG8_STAGE(PG8_SA(1, 0), a3, voffA);
            PG8_WAIT_V(8); PG8_WAIT_L(0); PG8_BAR; PG8_MMA(1, 0, At, B0); PG8_MMA(1, 1, At, B1); PG8_BAR; PG8_SCHED;
        }
        if (wr == 0) PG8_BAR;
        { const int l2 = lane_id_(); E(acc, cur, wid >> 2, wid & 3, l2 & 15, l2 >> 4); }
        if (!has_next) break;
#pragma unroll
        for (int a = 0; a < 2; ++a)
#pragma unroll
            for (int b = 0; b < 2; ++b)
#pragma unroll
                for (int m = 0; m < 4; ++m)
#pragma unroll
                    for (int n = 0; n < 2; ++n) acc[a][b][m][n] = (f32x4){0.f, 0.f, 0.f, 0.f};
        cur = nxt; cA = nA; cB = nB; ++ui;
        if (wr == 1) PG8_BAR;
    }
    PG8_WAIT_V(0);
    PG8_BAR;
#undef PG8_SA
#undef PG8_SB
#undef PG8_STAGE
#undef PG8_LDA
#undef PG8_LDB
#undef PG8_MMA
#undef PG8_WAIT_V
#undef PG8_WAIT_L
#undef PG8_BAR
#undef PG8_SCHED
}

struct EpiBf16 {
    bf16_t* O; int ldc; size_t gsO; const u64* ss;
    __device__ __forceinline__ void operator()(const f32x4 (&acc)[2][2][4][2], const Unit& u, int wr, int wc, int fr, int fq) const {
        const int row0 = u.pm * BM + wr * 64 + fr, col0 = u.pn * BM + wc * 32 + 8 * fq;
        bf16_t* base = O + (size_t)u.g * gsO;
        u64 sv[2][4];
        if (ss) {
#pragma unroll
            for (int ai = 0; ai < 2; ++ai)
#pragma unroll
                for (int m = 0; m < 4; ++m) sv[ai][m] = *G1(const u64, ss + row0 + ai * HALF + m * 16);
            __builtin_amdgcn_sched_barrier(0); }
#pragma unroll
        for (int ai = 0; ai < 2; ++ai)
#pragma unroll
            for (int m = 0; m < 4; ++m) { const int row = row0 + ai * HALF + m * 16; bf16_t* rowp = base + (size_t)row * ldc + col0;
                const float sc = ss ? ss_rstd(sv[ai][m]) : 1.0f;
#pragma unroll
                for (int bj = 0; bj < 2; ++bj) { const f32x4 v0 = acc[ai][bj][m][0] * sc, v1 = acc[ai][bj][m][1] * sc;
                    u32x4 w; w.x = cvtpk(v0[0], v0[1]); w.y = cvtpk(v0[2], v0[3]); w.z = cvtpk(v1[0], v1[1]); w.w = cvtpk(v1[2], v1[3]);
                    *G1(u32x4, rowp + bj * HALF) = w; } }
    }
};
struct EpiBf16Q {
    bf16_t* O; int ldc; const u64* ss; const float* ascale; u64* kn; int dry;
    __device__ __forceinline__ void operator()(const f32x4 (&acc)[2][2][4][2], const Unit& u, int wr, int wc, int fr, int fq) const {
        const int row0 = u.pm * BM + wr * 64 + fr, col0 = u.pn * BM + wc * 32 + 8 * fq;
        const bool ktile = kn != nullptr && u.pn >= 8 && u.pn < 16;
        if (dry) { float t_ = 0.f;
#pragma unroll
            for (int ai = 0; ai < 2; ++ai)
#pragma unroll
                for (int bj = 0; bj < 2; ++bj)
#pragma unroll
                    for (int m = 0; m < 4; ++m) t_ += acc[ai][bj][m][0][0] + acc[ai][bj][m][1][3];
            if (t_ == 1.2345e38f) *G1(float, (float*)O) = t_; return; }
        u64 sv[2][4]; float av[2][4];
#pragma unroll
        for (int ai = 0; ai < 2; ++ai)
#pragma unroll
            for (int m = 0; m < 4; ++m) { const int row = row0 + ai * HALF + m * 16; sv[ai][m] = *G1(const u64, ss + row); av[ai][m] = *G1(const float, ascale + row); }
        __builtin_amdgcn_sched_barrier(0);
#pragma unroll
        for (int ai = 0; ai < 2; ++ai)
#pragma unroll
            for (int m = 0; m < 4; ++m) { const int row = row0 + ai * HALF + m * 16; bf16_t* rowp = O + (size_t)row * ldc + col0;
                const float sc = ss_rstd(sv[ai][m]) * av[ai][m] * (1.0f / W8_SCALE);
#pragma unroll
                for (int bj = 0; bj < 2; ++bj) { const i32x4 i0 = __builtin_bit_cast(i32x4, acc[ai][bj][m][0]), i1 = __builtin_bit_cast(i32x4, acc[ai][bj][m][1]);
                    const float f0 = (float)i0[0] * sc, f1 = (float)i0[1] * sc, f2 = (float)i0[2] * sc, f3 = (float)i0[3] * sc, f4 = (float)i1[0] * sc, f5 = (float)i1[1] * sc, f6 = (float)i1[2] * sc, f7 = (float)i1[3] * sc;
                    u32x4 w; w.x = cvtpk(f0, f1); w.y = cvtpk(f2, f3); w.z = cvtpk(f4, f5); w.w = cvtpk(f6, f7);
                    *G1(u32x4, rowp + bj * HALF) = w;
                    if (ktile) { float s2 = (f0 * f0 + f1 * f1) + (f2 * f2 + f3 * f3) + (f4 * f4 + f5 * f5) + (f6 * f6 + f7 * f7); s2 += __shfl_xor(s2, 16); s2 += __shfl_xor(s2, 32);
                        if (fq == 0) (void)__hip_atomic_fetch_add(G1(u64, kn + (size_t)((u.pn - 8) * 2 + bj) * M + row), ss_fix(s2), __ATOMIC_RELAXED, __HIP_MEMORY_SCOPE_AGENT); } } }
    }
};
struct EpiResid {
    const bf16_t* Hin; bf16_t* H; signed char* HQ; float* ascale; const u64* ssin; u64* ssout; const float* ascale_y;
    __device__ __forceinline__ void operator()(const f32x4 (&acc)[2][2][4][2], const Unit& u, int wr, int wc, int fr, int fq) const {
        const int row0 = u.pm * BM + wr * 64 + fr, col0 = u.pn * BM + wc * 32 + 8 * fq;
#pragma unroll
        for (int ai = 0; ai < 2; ++ai) {
        u32x4 hv[2][4][2]; u64 sv[2][4]; float yv[2][4];
#pragma unroll
            for (int m = 0; m < 4; ++m) { const int row = row0 + ai * HALF + m * 16; const bf16_t* hi = Hin + (size_t)row * DM + col0;
                sv[ai][m] = *G1(const u64, ssin + row); yv[ai][m] = *G1(const float, ascale_y + row);
#pragma unroll
                for (int bj = 0; bj < 2; ++bj) hv[ai][m][bj] = *G1(const u32x4, hi + bj * HALF); }
        __builtin_amdgcn_sched_barrier(0);
#pragma unroll
            for (int m = 0; m < 4; ++m) { const int row = row0 + ai * HALF + m * 16; bf16_t* hp = H + (size_t)row * DM + col0; signed char* bp = HQ + (size_t)row * DM + col0; float s2 = 0.f;
                const float qs = 15.875f * ss_rstd(sv[ai][m]);
                if (fq == 0 && wc == 0 && u.pn == 0) *G1(float, ascale + row) = 1.0f / qs;
                const float ys = yv[ai][m] * (1.0f / W8_SCALE);
#pragma unroll
                for (int bj = 0; bj < 2; ++bj) { const i32x4 i0 = __builtin_bit_cast(i32x4, acc[ai][bj][m][0]), i1 = __builtin_bit_cast(i32x4, acc[ai][bj][m][1]); const u32x4 hw = hv[ai][m][bj];
                    const f32x4 v0 = (f32x4){bflo(hw.x), bfhi(hw.x), bflo(hw.y), bfhi(hw.y)} + (f32x4){(float)i0[0], (float)i0[1], (float)i0[2], (float)i0[3]} * ys, v1 = (f32x4){bflo(hw.z), bfhi(hw.z), bflo(hw.w), bfhi(hw.w)} + (f32x4){(float)i1[0], (float)i1[1], (float)i1[2], (float)i1[3]} * ys;
                    { u32x4 w; w.x = cvtpk(v0[0], v0[1]); w.y = cvtpk(v0[2], v0[3]); w.z = cvtpk(v1[0], v1[1]); w.w = cvtpk(v1[2], v1[3]); *G1(u32x4, hp + bj * HALF) = w; }
                    s2 += (v0[0] * v0[0] + v0[1] * v0[1]) + (v0[2] * v0[2] + v0[3] * v0[3]) + (v1[0] * v1[0] + v1[1] * v1[1]) + (v1[2] * v1[2] + v1[3] * v1[3]);
                    u32x2 q; q.x = pack4_q8_(v0[0] * qs, v0[1] * qs, v0[2] * qs, v0[3] * qs); q.y = pack4_q8_(v1[0] * qs, v1[1] * qs, v1[2] * qs, v1[3] * qs);
                    *G1(u32x2, bp + bj * HALF) = q; }
                s2 += __shfl_xor(s2, 16); s2 += __shfl_xor(s2, 32);
                if (fq == 0) (void)__hip_atomic_fetch_add(G1(u64, ssout + row), ss_fix(s2), __ATOMIC_RELAXED, __HIP_MEMORY_SCOPE_AGENT); }
        __builtin_amdgcn_sched_barrier(0);
        }
    }
};
struct EpiGate {
    bf16_t* H; const bf16_t* PP; const u64* ssin; u64* ssout; signed char* HQ; float* ascale; const float* ascale_in;
    __device__ __forceinline__ void operator()(const f32x4 (&acc)[2][2][4][2], const Unit& u, int wr, int wc, int fr, int fq) const {
        const int row0 = u.pm * BM + wr * 64 + fr, col0 = u.pn * BM + wc * 32 + 8 * fq;
#pragma unroll
        for (int ai = 0; ai < 2; ++ai) {
            u32x4 hv[4][2], pv[4][2]; u64 sv[4]; float av[4];
#pragma unroll
            for (int m = 0; m < 4; ++m) { const int row = row0 + ai * HALF + m * 16; const bf16_t* hp = H + (size_t)row * DM + col0; const bf16_t* pp = PP + (size_t)row * DM + col0;
                sv[m] = *G1(const u64, ssin + row); av[m] = *G1(const float, ascale_in + row);
#pragma unroll
                for (int bj = 0; bj < 2; ++bj) { pv[m][bj] = *G1(const u32x4, pp + bj * HALF); hv[m][bj] = *G1(const u32x4, hp + bj * HALF); } }
            __builtin_amdgcn_sched_barrier(0);
#pragma unroll
            for (int m = 0; m < 4; ++m) { const int row = row0 + ai * HALF + m * 16; bf16_t* hp = H + (size_t)row * DM + col0;
                const float sc = ss_rstd(sv[m]); float s2 = 0.f;
                const float qs = 15.875f * sc;
                const float scq = sc * av[m] * (1.0f / W8_SCALE);
                if (HQ && fq == 0 && wc == 0 && u.pn == 0) *G1(float, ascale + row) = 1.0f / qs;
#pragma unroll
                for (int bj = 0; bj < 2; ++bj) { const u32x4 pw = pv[m][bj], hw = hv[m][bj];
                    f32x4 v0 = (f32x4){bflo(hw.x), bfhi(hw.x), bflo(hw.y), bfhi(hw.y)}, v1 = (f32x4){bflo(hw.z), bfhi(hw.z), bflo(hw.w), bfhi(hw.w)};
                    const i32x4 i0 = __builtin_bit_cast(i32x4, acc[ai][bj][m][0]), i1 = __builtin_bit_cast(i32x4, acc[ai][bj][m][1]);
                    const f32x4 a0 = (f32x4){(float)i0[0], (float)i0[1], (float)i0[2], (float)i0[3]} * scq, a1 = (f32x4){(float)i1[0], (float)i1[1], (float)i1[2], (float)i1[3]} * scq;
                    v0[0] += sigmoidf_(a0[0]) * bflo(pw.x); v0[1] += sigmoidf_(a0[1]) * bfhi(pw.x); v0[2] += sigmoidf_(a0[2]) * bflo(pw.y); v0[3] += sigmoidf_(a0[3]) * bfhi(pw.y);
                    v1[0] += sigmoidf_(a1[0]) * bflo(pw.z); v1[1] += sigmoidf_(a1[1]) * bfhi(pw.z); v1[2] += sigmoidf_(a1[2]) * bflo(pw.w); v1[3] += sigmoidf_(a1[3]) * bfhi(pw.w);
                    { u32x4 w; w.x = cvtpk(v0[0], v0[1]); w.y = cvtpk(v0[2], v0[3]); w.z = cvtpk(v1[0], v1[1]); w.w = cvtpk(v1[2], v1[3]); *G1(u32x4, hp + bj * HALF) = w; }
                    s2 += (v0[0] * v0[0] + v0[1] * v0[1]) + (v0[2] * v0[2] + v0[3] * v0[3]) + (v1[0] * v1[0] + v1[1] * v1[1]) + (v1[2] * v1[2] + v1[3] * v1[3]);
                    if (HQ) { u32x2 q; q.x = pack4_q8_(v0[0] * qs, v0[1] * qs, v0[2] * qs, v0[3] * qs); q.y = pack4_q8_(v1[0] * qs, v1[1] * qs, v1[2] * qs, v1[3] * qs); *G1(u32x2, HQ + (size_t)row * DM + col0 + bj * HALF) = q; } }
                s2 += __shfl_xor(s2, 16); s2 += __shfl_xor(s2, 32);
                if (fq == 0) (void)__hip_atomic_fetch_add(G1(u64, ssout + row), ss_fix(s2), __ATOMIC_RELAXED, __HIP_MEMORY_SCOPE_AGENT); }
            __builtin_amdgcn_sched_barrier(0);
        }
    }
};
struct EpiOGate {
    bf16_t* Y; const bf16_t* GC; int ldg;
    __device__ __forceinline__ void operator()(const f32x4 (&acc)[2][2][4][2], const Unit& u, int wr, int wc, int fr, int fq) const {
        const int row0 = u.pm * BM + wr * 64 + fr, col0 = u.g * 256 + wc * 32 + 8 * fq;
        u32x4 gv[2][4][2];
#pragma unroll
        for (int ai = 0; ai < 2; ++ai)
#pragma unroll
            for (int m = 0; m < 4; ++m) { const int row = row0 + ai * HALF + m * 16; const bf16_t* gp = GC + (size_t)row * ldg + col0;
#pragma unroll
                for (int bj = 0; bj < 2; ++bj) gv[ai][m][bj] = *G1(const u32x4, gp + bj * HALF); }
        __builtin_amdgcn_sched_barrier(0);
#pragma unroll
        for (int ai = 0; ai < 2; ++ai)
#pragma unroll
            for (int m = 0; m < 4; ++m) { const int row = row0 + ai * HALF + m * 16; bf16_t* yp = Y + (size_t)row * DM + col0;
#pragma unroll
                for (int bj = 0; bj < 2; ++bj) { const u32x4 gw = gv[ai][m][bj]; const f32x4 a0 = acc[ai][bj][m][0], a1 = acc[ai][bj][m][1];
                    u32x4 w; w.x = cvtpk(a0[0] * siluf_(bflo(gw.x)), a0[1] * siluf_(bfhi(gw.x))); w.y = cvtpk(a0[2] * siluf_(bflo(gw.y)), a0[3] * siluf_(bfhi(gw.y)));
                    w.z = cvtpk(a1[0] * siluf_(bflo(gw.z)), a1[1] * siluf_(bfhi(gw.z))); w.w = cvtpk(a1[2] * siluf_(bflo(gw.w)), a1[3] * siluf_(bfhi(gw.w)));
                    *G1(u32x4, yp + bj * HALF) = w; } }
    }
};
}

struct Args { const float* in[22]; float* out; unsigned char* ws; int ph_lo, ph_hi; };
enum { I_X = 0, I_P, I_T5, I_NORMG, I_EWIN, I_EBF, I_ESINK, I_EWOUT, I_OWIN, I_OQNG, I_OKVNG, I_OWUQ, I_OWUQI, I_OLNG, I_OLNB, I_OWUK, I_OWUV, I_OWOUT, I_PWPROJ, I_PNORMG, I_PWGATE, I_FINALG };


__device__ __forceinline__ unsigned off_b(unsigned row, unsigned ch) { return 256u * row + 16u * (ch ^ (((row & 3) << 2) | ((row >> 2) & 3))); }
__device__ __forceinline__ s16x4 vtr(LAS const unsigned char* p) { return __builtin_bit_cast(s16x4, __builtin_amdgcn_ds_read_tr16_b64_v4i16((LAS v4i16_t*)p)); }
__device__ __forceinline__ bf16x8 pack8(const f32x16& s, int o) {
    u32x4 w; w.x = cvtpk(s[o + 0], s[o + 1]); w.y = cvtpk(s[o + 2], s[o + 3]); w.z = cvtpk(s[o + 4], s[o + 5]); w.w = cvtpk(s[o + 6], s[o + 7]);
    return __builtin_bit_cast(bf16x8, w);
}
template <int NSB, int NOB>
__device__ __forceinline__ void sm_step(f32x16 (&s)[NSB], float& m, float& l, f32x16 (&o)[NOB], bf16x8 (&p)[NSB][2]) {
    float mx = s[0][0];
#pragma unroll
    for (int b = 0; b < NSB; ++b)
#pragma unroll
        for (int r = 0; r < 16; ++r) mx = fmaxf(mx, s[b][r]);
    mx = xhalf_max(mx);
    if (__any(mx > m + 8.0f)) {
        const float mn = fmaxf(m, mx), alpha = fast_exp2(m - mn);
        l *= alpha; m = mn;
#pragma unroll
        for (int c = 0; c < NOB; ++c) o[c] = o[c] * alpha;
    }
    float sum = 0.f;
#pragma unroll
    for (int b = 0; b < NSB; ++b)
#pragma unroll
        for (int r = 0; r < 16; ++r) { s[b][r] = fast_exp2(s[b][r] - m); sum += s[b][r]; }
    sum = xhalf_sum(sum);
    l += sum;
#pragma unroll
    for (int b = 0; b < NSB; ++b) { p[b][0] = pack8(s[b], 0); p[b][1] = pack8(s[b], 8); }
}
__device__ __forceinline__ unsigned vt_addr(int lane, int krow0, int c, int t) {
    const unsigned h = lane >> 5, blk = (lane >> 4) & 1, q = (lane & 15) >> 2, p = lane & 3;
    return off_b(krow0 + 8 * t + 4 * h + q, 4 * c + 2 * blk + (p >> 1)) + 8 * (p & 1);
}
__device__ __forceinline__ bf16x8 vfrag(LAS const unsigned char* img, int lane, int krow0, int c) {
    const s16x4 lo = vtr(img + vt_addr(lane, krow0, c, 0)), hi = vtr(img + vt_addr(lane, krow0, c, 1));
    return (bf16x8){lo[0], lo[1], lo[2], lo[3], hi[0], hi[1], hi[2], hi[3]};
}
__device__ __forceinline__ unsigned krow_base(int lane) { const unsigned r = lane & 31, h = lane >> 5, x = ((r & 3) << 2) | ((r >> 2) & 3); return 256u * r + 16u * ((x & 14u) | (h ^ (x & 1u))); }
__device__ __forceinline__ unsigned vt_base(int lane) { const unsigned h = lane >> 5, blk = (lane >> 4) & 1, q = (lane & 15) >> 2, p = lane & 3; const unsigned low0 = (2 * blk + (p >> 1)) ^ h;
    return 256u * (4 * h + q) + 64u * q + 16u * low0 + 8u * (p & 1); }
__device__ __forceinline__ bf16x8 vfrag2(LAS const unsigned char* img, unsigned vb, int c, int imm) {
    const unsigned a0 = vb ^ (unsigned)(c << 6);
    const s16x4 lo = vtr(img + a0 + imm), hi = vtr(img + (a0 ^ 32u) + imm + 2048);
    return (bf16x8){lo[0], lo[1], lo[2], lo[3], hi[0], hi[1], hi[2], hi[3]};
}
__device__ __forceinline__ float log_sigmoid_(float x) { return x > 0.f ? -log1pf(expf(-x)) : x - log1pf(expf(x)); }

constexpr int FOX_KV = 0, FOX_CUM = 65536, FOX_SCAN = FOX_CUM + 16384, FOX_KMAX = FOX_SCAN + 64, FOX_FLAGS = FOX_SCAN + 128;
constexpr float FOX_SKIP_LOG2 = 64.0f;
template <int CTRL> __device__ __forceinline__ float dpp_(float v) { return __int_as_float(__builtin_amdgcn_update_dpp(0, __float_as_int(v), CTRL, 0xF, 0xF, true)); }
__device__ __forceinline__ float row16_sum(float s) { s += dpp_<0xB1>(s); s += dpp_<0x4E>(s); s += dpp_<0x141>(s); s += dpp_<0x140>(s); return s; }
__device__ __forceinline__ float wave_max_u(float v) {
    v = fmaxf(v, dpp_<0xB1>(v)); v = fmaxf(v, dpp_<0x4E>(v)); v = fmaxf(v, dpp_<0x141>(v)); v = fmaxf(v, dpp_<0x140>(v));
    const float a0 = __int_as_float(__builtin_amdgcn_readlane(__float_as_int(v), 0)), a1 = __int_as_float(__builtin_amdgcn_readlane(__float_as_int(v), 16));
    const float a2 = __int_as_float(__builtin_amdgcn_readlane(__float_as_int(v), 32)), a3 = __int_as_float(__builtin_amdgcn_readlane(__float_as_int(v), 48));
    return fmaxf(fmaxf(a0, a1), fmaxf(a2, a3));
}
__device__ __forceinline__ void fox_scan(const GAS bf16_t* proj, const GAS u64* kn, const GAS float* bfp, int b, int hd, LAS unsigned char* lds, int tid, int lane, int wave) {
    LAS float* cumL = (LAS float*)(lds + FOX_CUM); LAS float* scanL = (LAS float*)(lds + FOX_SCAN); LAS float* kmaxL = (LAS float*)(lds + FOX_KMAX);
    const float bias = bfp[hd]; float v[8]; float run = 0.f;
#pragma unroll
    for (int i = 0; i < 8; ++i) { const float f = bf2f(proj[(size_t)(b * SEQ + 8 * tid + i) * EN + E_FA + hd]); run += log_sigmoid_(f + bias); v[i] = run; }
    float inc = run;
#pragma unroll
    for (int o = 1; o < 64; o <<= 1) { const float t = __shfl_up(inc, o); if (lane >= o) inc += t; }
    float kq = 0.f;
    { const GAS u64* kp = kn + (size_t)hd * M + (size_t)b * SEQ + 8 * tid;
#pragma unroll
      for (int i = 0; i < 8; ++i) kq = fmaxf(kq, (float)kp[i] * (1.0f / 16777216.0f)); }
    kq = wave_max_u(kq);
    if (lane == 63) scanL[wave] = inc;
    if (lane == 0) scanL[8 + wave] = kq;
    __syncthreads();
    float wbase = 0.f, km = 0.f;
#pragma unroll
    for (int w = 0; w < 8; ++w) { const float t = scanL[w]; if (w < wave) wbase += t; km = fmaxf(km, scanL[8 + w]); }
    const float excl = wbase + inc - run;
#pragma unroll
    for (int i = 0; i < 8; ++i) cumL[8 * tid + i] = -(excl + v[i]) * LOG2E;
    if (tid == 0) kmaxL[0] = sqrtf(km) * 1.005f;
    __syncthreads();
}
__device__ __forceinline__ void fox_unit(const GAS bf16_t* proj, GAS bf16_t* yin, int b, int hd, int qb, LAS unsigned char* lds, int tid, int lane, int wave) {
    const LAS float* cumL = (const LAS float*)(lds + FOX_CUM); volatile LAS int* flags = (volatile LAS int*)(lds + FOX_FLAGS);
    const int t0 = 256 * qb, q0 = t0 + 32 * wave, qme = q0 + (lane & 31), h = lane >> 5;
    const size_t rowb = (size_t)b * SEQ;
    const float cs = 0.08838834764831845f * LOG2E;
    const unsigned kbase = krow_base(lane), vbase = vt_base(lane);
    bf16x8 qf[8];
    { const GAS bf16_t* qp = proj + (rowb + qme) * EN + E_QA + hd * 128 + 8 * h;
#pragma unroll
      for (int s = 0; s < 8; ++s) qf[s] = *(const GAS bf16x8*)(qp + 16 * s); }
    float qn2 = 0.f;
#pragma unroll
    for (int s = 0; s < 8; ++s)
#pragma unroll
        for (int e = 0; e < 8; ++e) { const float x = bf2f((unsigned short)qf[s][e]); qn2 += x * x; }
    qn2 = xhalf_sum(qn2);
    const float cbound = sqrtf(qn2) * 1.0001f * ((const LAS float*)(lds + FOX_KMAX))[0] * cs;
    f32x16 o[4];
#pragma unroll
    for (int c = 0; c < 4; ++c)
#pragma unroll
        for (int r = 0; r < 16; ++r) o[c][r] = 0.f;
    float m = -1e30f, l = 0.f;
    const int ntile = 4 * (qb + 1);
    const int r0 = tid >> 4, c0 = tid & 15;
    const GAS bf16_t* kg = proj + (rowb + r0) * EN + E_KA + hd * 128 + c0 * 8;
    const GAS bf16_t* vg = proj + (rowb + r0) * EN + E_VA + hd * 128 + c0 * 8;
    const unsigned so0 = off_b(r0, c0), so1 = off_b(r0 + 32, c0);
    u32x4 sk0, sk1, sv0, sv1;
    { const size_t adv = (size_t)64 * (ntile - 1) * EN; sk0 = *(const GAS u32x4*)(kg + adv); sk1 = *(const GAS u32x4*)(kg + adv + (size_t)32 * EN); sv0 = *(const GAS u32x4*)(vg + adv); sv1 = *(const GAS u32x4*)(vg + adv + (size_t)32 * EN); }
    __syncthreads();
    { LAS unsigned char* kb = lds + FOX_KV; *(LAS u32x4*)(kb + so0) = sk0; *(LAS u32x4*)(kb + so1) = sk1; *(LAS u32x4*)(kb + 16384 + so0) = sv0; *(LAS u32x4*)(kb + 16384 + so1) = sv1; }
    __syncthreads();
    bool done_w = false;
    for (int it = 0; it < ntile; ++it) {
        const int kt = ntile - 1 - it, cur = it & 1; const LAS unsigned char* Kt = lds + FOX_KV + cur * 32768; const LAS unsigned char* Vt = Kt + 16384;
        const bool more = kt > 0;
        if (more) { const size_t adv = (size_t)64 * (kt - 1) * EN; sk0 = *(const GAS u32x4*)(kg + adv); sk1 = *(const GAS u32x4*)(kg + adv + (size_t)32 * EN); sv0 = *(const GAS u32x4*)(vg + adv); sv1 = *(const GAS u32x4*)(vg + adv + (size_t)32 * EN); }
        const int k0 = 64 * kt;
        if (k0 <= q0 + 31 && !done_w) {
            f32x16 sc[2];
#pragma unroll
            for (int kb = 0; kb < 2; ++kb) {
#pragma unroll
                for (int r = 0; r < 16; ++r) sc[kb][r] = 0.f;
#pragma unroll
                for (int s = 0; s < 8; ++s) { const bf16x8 a = *(const LAS bf16x8*)(Kt + (kbase ^ (unsigned)(s << 5)) + 8192 * kb); sc[kb] = __builtin_amdgcn_mfma_f32_32x32x16_bf16(a, qf[s], sc[kb], 0, 0, 0); }
            }
            const bool diag = (k0 + 63 > q0);
#pragma unroll
            for (int kb = 0; kb < 2; ++kb)
#pragma unroll
                for (int g4 = 0; g4 < 4; ++g4) { const int key0 = k0 + 32 * kb + 8 * g4 + 4 * h; const f32x4 nb = *(const LAS f32x4*)(cumL + key0);
#pragma unroll
                    for (int e = 0; e < 4; ++e) { float v = sc[kb][4 * g4 + e] * cs + nb[e]; if (diag && (key0 + e > qme)) v = -1e30f; sc[kb][4 * g4 + e] = v; } }
            bf16x8 p[2][2];
            sm_step<2, 4>(sc, m, l, o, p);
#pragma unroll
            for (int c = 0; c < 4; ++c)
#pragma unroll
                for (int kb = 0; kb < 2; ++kb)
#pragma unroll
                    for (int s = 0; s < 2; ++s) { const bf16x8 a = vfrag2(Vt, vbase, c, 256 * (32 * kb + 16 * s)); o[c] = __builtin_amdgcn_mfma_f32_32x32x16_bf16(a, p[kb][s], o[c], 0, 0, 0); }
            if (more) { const float amax = wave_max_u(cbound - m); done_w = (amax + cumL[k0 - 1] < -FOX_SKIP_LOG2); }
        }
        if (lane == 0) flags[cur * 8 + wave] = done_w ? 1 : 0;
        if (more) { LAS unsigned char* kb = lds + FOX_KV + (cur ^ 1) * 32768; *(LAS u32x4*)(kb + so0) = sk0; *(LAS u32x4*)(kb + so1) = sk1; *(LAS u32x4*)(kb + 16384 + so0) = sv0; *(LAS u32x4*)(kb + 16384 + so1) = sv1; }
        __syncthreads();
        int alld = 1;
#pragma unroll
        for (int w = 0; w < 8; ++w) alld &= flags[cur * 8 + w];
        if (alld) break;
    }
    const float il = 1.0f / l;
    const GAS bf16_t* gp = proj + (rowb + qme) * EN + E_GA + hd * 128 + 4 * h; GAS bf16_t* yp = yin + (rowb + qme) * DM + hd * 128 + 4 * h;
#pragma unroll
    for (int c = 0; c < 4; ++c)
#pragma unroll
        for (int g4 = 0; g4 < 4; ++g4) { const u32x2 gw = *(const GAS u32x2*)(gp + 32 * c + 8 * g4);
            u32x2 w; w.x = cvtpk(o[c][4 * g4 + 0] * il * siluf_(bflo(gw.x)), o[c][4 * g4 + 1] * il * siluf_(bfhi(gw.x))); w.y = cvtpk(o[c][4 * g4 + 2] * il * siluf_(bflo(gw.y)), o[c][4 * g4 + 3] * il * siluf_(bfhi(gw.y)));
            *(GAS u32x2*)(yp + 32 * c + 8 * g4) = w; }
}

constexpr int SWA_K = 0, SWA_V = 65536, SWA_TB = 131072;
__device__ __forceinline__ int t5_bucket_(int rel) {
    if (rel < 16) return rel;
    if (rel >= 128) return 31;
    const int v = 16 + (int)(logf((float)rel * (1.0f / 16.0f)) / 2.0794415416798357f * 16.0f);
    return v < 31 ? v : 31;
}
__device__ __forceinline__ void swa_unit(const GAS bf16_t* proj, GAS bf16_t* yin, const GAS float* t5, const GAS float* sinks, int b, int nb, int kvh, LAS unsigned char* lds, int tid, int lane, int wave) {
    const size_t rowb = (size_t)b * SEQ; const int hq = kvh * 8 + wave, h = lane >> 5;
    __syncthreads();
#pragma unroll
    for (int i = 0; i < 4; ++i) { const int c = tid + 512 * i, row = c >> 3, ch = c & 7; const int key = 128 * (nb - 1) + row;
        u32x4 kv = zero4_(), vv = kv;
        if (key >= 0) { const GAS bf16_t* src = proj + (rowb + key) * EN + kvh * 64 + ch * 8; kv = *(const GAS u32x4*)(src + E_KB); vv = *(const GAS u32x4*)(src + E_VB); }
        *(LAS u32x4*)(lds + SWA_K + off_b(row, ch)) = kv; *(LAS u32x4*)(lds + SWA_V + off_b(row, ch)) = vv; }
    LAS float* tb = (LAS float*)(lds + SWA_TB + wave * 512);
#pragma unroll
    for (int i = 0; i < 2; ++i) { const int rel = lane + 64 * i; tb[rel] = t5[t5_bucket_(rel) * 64 + hq] * LOG2E; }
    __syncthreads();
    const float cs = 0.125f * LOG2E, sink2 = sinks[hq] * LOG2E;
    const unsigned kbase = krow_base(lane), vbase = vt_base(lane);
    for (int cg = 0; cg < 4; ++cg) {
        const int qi = 32 * cg + (lane & 31); const size_t row = rowb + 128 * nb + qi;
        bf16x8 qf[4];
        { const GAS bf16_t* qp = proj + row * EN + E_QB + hq * 64 + 8 * h;
#pragma unroll
          for (int s = 0; s < 4; ++s) qf[s] = *(const GAS bf16x8*)(qp + 16 * s); }
        f32x16 o[2];
#pragma unroll
        for (int c = 0; c < 2; ++c)
#pragma unroll
            for (int r = 0; r < 16; ++r) o[c][r] = 0.f;
        float m = sink2, l = 1.0f;
        for (int kb = cg; kb < cg + 5; ++kb) {
            f32x16 sc[1];
#pragma unroll
            for (int r = 0; r < 16; ++r) sc[0][r] = 0.f;
#pragma unroll
            for (int s = 0; s < 4; ++s) { const bf16x8 a = *(const LAS bf16x8*)(lds + SWA_K + (kbase ^ (unsigned)(s << 5)) + 8192 * kb); sc[0] = __builtin_amdgcn_mfma_f32_32x32x16_bf16(a, qf[s], sc[0], 0, 0, 0); }
#pragma unroll
            for (int r = 0; r < 16; ++r) { const int kj = 32 * kb + (r & 3) + 8 * (r >> 2) + 4 * h, rel = qi + 128 - kj;
                const bool valid = (rel >= 0) && (rel < 128) && (nb > 0 || kj >= 128);
                const float bias = tb[rel & 127];
                sc[0][r] = sc[0][r] * cs + bias + (valid ? 0.f : -1e30f); }
            bf16x8 p[1][2];
            sm_step<1, 2>(sc, m, l, o, p);
#pragma unroll
            for (int c = 0; c < 2; ++c)
#pragma unroll
                for (int s = 0; s < 2; ++s) { const bf16x8 a = vfrag2(lds + SWA_V + 8192 * kb, vbase, c, 4096 * s); o[c] = __builtin_amdgcn_mfma_f32_32x32x16_bf16(a, p[0][s], o[c], 0, 0, 0); }
        }
        const float il = 1.0f / l;
        const GAS bf16_t* gp = proj + row * EN + E_GB + hq * 64 + 4 * h; GAS bf16_t* yp = yin + row * DM + 2048 + hq * 64 + 4 * h;
#pragma unroll
        for (int c = 0; c < 2; ++c)
#pragma unroll
            for (int g4 = 0; g4 < 4; ++g4) { const u32x2 gw = *(const GAS u32x2*)(gp + 32 * c + 8 * g4);
                u32x2 w; w.x = cvtpk(o[c][4 * g4 + 0] * il * siluf_(bflo(gw.x)), o[c][4 * g4 + 1] * il * siluf_(bfhi(gw.x))); w.y = cvtpk(o[c][4 * g4 + 2] * il * siluf_(bflo(gw.y)), o[c][4 * g4 + 3] * il * siluf_(bfhi(gw.y)));
                *(GAS u32x2*)(yp + 32 * c + 8 * g4) = w; }
    }
}
__device__ __forceinline__ void phase_even_attn(const Args& a, int j, LAS unsigned char* lds, int G, int bx, const int wave, const int which) {
    const int lane = lane_id_(), tid = wave * 64 + lane;
    unsigned char* ws_ = a.ws; OPAQUE_S(ws_); GAS unsigned char* ws = (GAS unsigned char*)ws_;
    const GAS bf16_t* proj = (const GAS bf16_t*)(ws + WS_PROJ); GAS bf16_t* yin = (GAS bf16_t*)(ws + WS_YIN);
    if (which & 1) for (int u = bx; u < 256; u += G) {
        const int b = u >> 7, hd = (u >> 3) & 15, i = u & 7;
        __syncthreads();
        fox_scan(proj, (const GAS u64*)(ws + WS_KN) + (size_t)j * 16 * M, ((const GAS float*)karg_in(I_EBF)) + j * 16, b, hd, lds, tid, lane, wave);
        fox_unit(proj, yin, b, hd, 15 - i, lds, tid, lane, wave);
        fox_unit(proj, yin, b, hd, i, lds, tid, lane, wave);
    }
    if (which & 2) for (int u = bx; u < 256; u += G) {
        const int b = u >> 7, nb = (u >> 2) & 31, kvh = u & 3;
        swa_unit(proj, yin, ((const GAS float*)karg_in(I_T5)), ((const GAS float*)karg_in(I_ESINK)) + j * 32, b, nb, kvh, lds, tid, lane, wave);
    }
    __syncthreads();
}

#define BAR_LDS() asm volatile("s_waitcnt lgkmcnt(0)\n\ts_barrier" ::: "memory")
__device__ __forceinline__ void phase_odd_norms(const Args& a, int j, int gw, int NGW) {
    const int lane = lane_id_();
    unsigned char* ws_ = a.ws; OPAQUE_S(ws_); GAS unsigned char* ws = (GAS unsigned char*)ws_;
    const GAS bf16_t* proj = (const GAS bf16_t*)(ws + WS_PROJ); GAS bf16_t* cqn = (GAS bf16_t*)(ws + WS_CQN); GAS bf16_t* lat = (GAS bf16_t*)(ws + WS_LAT); GAS bf16_t* kidx = (GAS bf16_t*)(ws + WS_KIDX); GAS float* widx = (GAS float*)(ws + WS_WIDX);
    const GAS float* qg = ((const GAS float*)karg_in(I_OQNG)) + j * 1024; const GAS float* kvg = ((const GAS float*)karg_in(I_OKVNG)) + j * 512; const GAS float* lng = ((const GAS float*)karg_in(I_OLNG)) + j * 64; const GAS float* lnb = ((const GAS float*)karg_in(I_OLNB)) + j * 64;
    for (int row = gw; row < M; row += NGW) {
        const GAS bf16_t* pr = proj + (size_t)row * ON;
        {
            const u32x4 w0 = *(const GAS u32x4*)(pr + O_CQ + lane * 8), w1 = *(const GAS u32x4*)(pr + O_CQ + 512 + lane * 8);
            float v[16] = {bflo(w0.x), bfhi(w0.x), bflo(w0.y), bfhi(w0.y), bflo(w0.z), bfhi(w0.z), bflo(w0.w), bfhi(w0.w), bflo(w1.x), bfhi(w1.x), bflo(w1.y), bfhi(w1.y), bflo(w1.z), bfhi(w1.z), bflo(w1.w), bfhi(w1.w)};
            float ss = 0.f;
#pragma unroll
            for (int i = 0; i < 16; ++i) ss += v[i] * v[i];
            ss = wave_sum(ss); const float r = 1.0f / sqrtf(ss * (1.0f / 1024.0f) + EPS);
            const f32x4 g0 = *(const GAS f32x4*)(qg + lane * 8), g1 = *(const GAS f32x4*)(qg + lane * 8 + 4), g2 = *(const GAS f32x4*)(qg + 512 + lane * 8), g3 = *(const GAS f32x4*)(qg + 512 + lane * 8 + 4);
            u32x4 o0, o1;
            o0.x = cvtpk(v[0] * r * g0[0], v[1] * r * g0[1]); o0.y = cvtpk(v[2] * r * g0[2], v[3] * r * g0[3]); o0.z = cvtpk(v[4] * r * g1[0], v[5] * r * g1[1]); o0.w = cvtpk(v[6] * r * g1[2], v[7] * r * g1[3]);
            o1.x = cvtpk(v[8] * r * g2[0], v[9] * r * g2[1]); o1.y = cvtpk(v[10] * r * g2[2], v[11] * r * g2[3]); o1.z = cvtpk(v[12] * r * g3[0], v[13] * r * g3[1]); o1.w = cvtpk(v[14] * r * g3[2], v[15] * r * g3[3]);
            *(GAS u32x4*)(cqn + (size_t)row * 1024 + lane * 8) = o0; *(GAS u32x4*)(cqn + (size_t)row * 1024 + 512 + lane * 8) = o1;
        }
        {
            const u32x4 w0 = *(const GAS u32x4*)(pr + O_CKV + lane * 8);
            float v[8] = {bflo(w0.x), bfhi(w0.x), bflo(w0.y), bfhi(w0.y), bflo(w0.z), bfhi(w0.z), bflo(w0.w), bfhi(w0.w)};
            float ss = 0.f;
#pragma unroll
            for (int i = 0; i < 8; ++i) ss += v[i] * v[i];
            ss = wave_sum(ss); const float r = 1.0f / sqrtf(ss * (1.0f / 512.0f) + EPS);
            const f32x4 g0 = *(const GAS f32x4*)(kvg + lane * 8), g1 = *(const GAS f32x4*)(kvg + lane * 8 + 4);
            u32x4 o0; o0.x = cvtpk(v[0] * r * g0[0], v[1] * r * g0[1]); o0.y = cvtpk(v[2] * r * g0[2], v[3] * r * g0[3]); o0.z = cvtpk(v[4] * r * g1[0], v[5] * r * g1[1]); o0.w = cvtpk(v[6] * r * g1[2], v[7] * r * g1[3]);
            *(GAS u32x4*)(lat + (size_t)row * 512 + lane * 8) = o0;
        }
        {
            const float x = bf2f(pr[O_KIDX + lane]); const float mu = wave_sum(x) * (1.0f / 64.0f); const float xc = x - mu; const float var = wave_sum(xc * xc) * (1.0f / 64.0f);
            const float y = xc * (1.0f / sqrtf(var + EPS)) * lng[lane] + lnb[lane];
            kidx[(size_t)row * 64 + lane] = (bf16_t)(cvtpk(y, 0.f) & 0xffffu);
        }
        if (lane < 32) widx[(size_t)row * 32 + lane] = bf2f(pr[O_WIDX + lane]) * 0.022097086912079608f;
    }
}

__device__ __forceinline__ unsigned sortable_(float f) { const unsigned u = __float_as_uint(f); return (u & 0x80000000u) ? ~u : (u | 0x80000000u); }
__device__ __forceinline__ int wave_isum(int v) {
#pragma unroll
    for (int o = 1; o < 64; o <<= 1) v += __shfl_xor(v, o);
    return v;
}
__device__ __forceinline__ void topk_row(const GAS float* srow, GAS int* sel, int t, int lane) {
    const int nvalid = t + 1;
    if (nvalid <= 256) {
#pragma unroll
        for (int i = 0; i < 4; ++i) sel[64 * i + lane] = (64 * i + lane < nvalid) ? 64 * i + lane : 0;
        return;
    }
    unsigned key[64];
    const int ngrp = (nvalid + 511) >> 9;
#pragma unroll
    for (int g = 0; g < 8; ++g) {
        if (g < ngrp) {
#pragma unroll
            for (int i = 8 * g; i < 8 * g + 8; ++i) key[i] = __float_as_uint(srow[64 * i + lane]);
        }
    }
    __builtin_amdgcn_sched_barrier(0);
#pragma unroll
    for (int g = 0; g < 8; ++g) {
        if (g < ngrp) {
#pragma unroll
            for (int i = 8 * g; i < 8 * g + 8; ++i) { const int e = 64 * i + lane; key[i] = (e < nvalid) ? sortable_(__uint_as_float(key[i])) : 0u; }
        } else {
#pragma unroll
            for (int i = 8 * g; i < 8 * g + 8; ++i) key[i] = 0u;
        }
    }
    unsigned kmx = 0u, kmn1 = 0xFFFFFFFFu;
#pragma unroll
    for (int g = 0; g < 8; ++g) {
        if (g < ngrp) {
#pragma unroll
            for (int i = 8 * g; i < 8 * g + 8; ++i) { kmx = kmx > key[i] ? kmx : key[i]; const unsigned k1 = key[i] - 1u; kmn1 = kmn1 < k1 ? kmn1 : k1; }
        }
    }
#pragma unroll
    for (int o = 1; o < 64; o <<= 1) { const unsigned a_ = (unsigned)__shfl_xor((int)kmx, o), b_ = (unsigned)__shfl_xor((int)kmn1, o); kmx = kmx > a_ ? kmx : a_; kmn1 = kmn1 < b_ ? kmn1 : b_; }
    unsigned lo = (unsigned)__builtin_amdgcn_readfirstlane((int)(kmn1 + 1u)), hi = (unsigned)__builtin_amdgcn_readfirstlane((int)kmx); hi = hi == 0xFFFFFFFFu ? hi : hi + 1u;
    int clo = nvalid, chi = 0; bool interp = true;
#pragma unroll 1
    while (clo != 256 && hi - lo > 1u) {
        unsigned cand;
        if (interp) { const float f = ((float)(clo - 256) + 0.5f) / (float)(clo - chi); cand = lo + (unsigned)((float)(hi - lo) * f); }
        else cand = lo + ((hi - lo) >> 1);
        cand = cand <= lo ? lo + 1u : cand; cand = cand >= hi ? hi - 1u : cand;
        cand = (unsigned)__builtin_amdgcn_readfirstlane((int)cand);
        int cnt = 0;
#pragma unroll
        for (int g = 0; g < 8; ++g) {
            if (g < ngrp) {
#pragma unroll
                for (int i = 0; i < 8; ++i) cnt += __builtin_popcountll(__ballot(key[8 * g + i] >= cand));
            }
            __builtin_amdgcn_sched_barrier(0);
        }
        if (cnt >= 256) { lo = cand; clo = cnt; } else { hi = cand; chi = cnt; }
        interp = !interp;
    }
    const unsigned T = lo;
    int cgt = 0;
#pragma unroll
    for (int g = 0; g < 8; ++g) {
        if (g < ngrp) {
#pragma unroll
            for (int i = 0; i < 8; ++i) cgt += __builtin_popcountll(__ballot(key[8 * g + i] > T));
        }
        __builtin_amdgcn_sched_barrier(0);
    }
    const int need = 256 - cgt; int pos = 0, eqseen = 0;
#pragma unroll
    for (int g = 0; g < 8; ++g) {
        if (g < ngrp) {
#pragma unroll
            for (int i = 8 * g; i < 8 * g + 8; ++i) {
                const bool gt = key[i] > T, eq = key[i] == T;
                const unsigned long long meq = __ballot(eq);
                const int rank = eqseen + (int)__builtin_amdgcn_mbcnt_hi((unsigned)(meq >> 32), __builtin_amdgcn_mbcnt_lo((unsigned)meq, 0u));
                const bool take = gt || (eq && rank < need);
                const unsigned long long mt = __ballot(take);
                const int p = pos + (int)__builtin_amdgcn_mbcnt_hi((unsigned)(mt >> 32), __builtin_amdgcn_mbcnt_lo((unsigned)mt, 0u));
                if (take && p < 256) sel[p] = 64 * i + lane;
                pos += __builtin_popcountll(mt); eqseen += __builtin_popcountll(meq);
            }
        }
    }
}
__device__ __forceinline__ void phase_indexer(const Args& a, LAS unsigned char* lds, int G, int bx, const int wave, const bool do_topk) {
    unsigned char* ws_ = a.ws; OPAQUE_S(ws_); GAS unsigned char* ws = (GAS unsigned char*)ws_;
    const GAS bf16_t* qbuf = (const GAS bf16_t*)(ws + WS_QBUF); const GAS bf16_t* kidx = (const GAS bf16_t*)(ws + WS_KIDX); const GAS float* widx = (const GAS float*)(ws + WS_WIDX);
    GAS float* score = (GAS float*)(ws + WS_SCORE) + (size_t)bx * 16 * 4096; GAS int* sel = (GAS int*)(ws + WS_SEL);
    for (int u = bx; u < 256; u += G) {
        const int b = u >> 7, i0 = u & 127;
        for (int half = 0; half < 2; ++half) {
            const int lane = lane_id_(), tid = wave * 64 + lane, h = lane >> 5;
            const unsigned key = lane & 31, x = (key >> 1) & 7;
            const unsigned bbase = 128u * key + 16u * ((x & 6u) | ((unsigned)h ^ (x & 1u)));
            const int qg = half ? 255 - i0 : i0;
            const int tq = 16 * qg + 2 * wave; const size_t rowb = (size_t)b * SEQ;
            bf16x8 qa[2][4]; f32x4 wv[2][4];
#pragma unroll
            for (int q = 0; q < 2; ++q) { const GAS bf16_t* qp = qbuf + (rowb + tq + q) * QW + 4096 + (lane & 31) * 64 + 8 * h; const GAS float* wp = widx + (rowb + tq + q) * 32 + 4 * h;
#pragma unroll
                for (int s = 0; s < 4; ++s) qa[q][s] = *(const GAS bf16x8*)(qp + 16 * s);
#pragma unroll
                for (int g4 = 0; g4 < 4; ++g4) wv[q][g4] = *(const GAS f32x4*)(wp + 8 * g4); }
            const int kmax = 16 * qg + 15, ntile = kmax / 256 + 1;
            const GAS bf16_t* kg = kidx + rowb * 64 + tid * 8;
            u32x4 st[4];
#pragma unroll
            for (int i = 0; i < 4; ++i) st[i] = *(const GAS u32x4*)(kg + i * 4096);
            __syncthreads();
#pragma unroll
            for (int i = 0; i < 4; ++i) { const int c = tid + 512 * i, row = c >> 3, ch = c & 7; *(LAS u32x4*)(lds + row * 128 + ((ch ^ ((row >> 1) & 7)) << 4)) = st[i]; }
            __syncthreads();
            for (int kt = 0; kt < ntile; ++kt) {
                const int cur = kt & 1; const bool more = kt + 1 < ntile;
                if (more) {
#pragma unroll
                    for (int i = 0; i < 4; ++i) st[i] = *(const GAS u32x4*)(kg + (size_t)(kt + 1) * 16384 + i * 4096); }
                const LAS unsigned char* Kt = lds + cur * 32768;
                const int nkb = (kmax - 256 * kt) / 32 + 1 < 8 ? (kmax - 256 * kt) / 32 + 1 : 8;
#define IDX_LOAD(B, kb_) do { _Pragma("unroll") for (int s_ = 0; s_ < 4; ++s_) B[s_] = *(const LAS bf16x8*)(Kt + (bbase ^ (unsigned)(s_ << 5)) + 4096 * (kb_)); } while (0)
#define IDX_BLOCK(B, kb_) do { f32x16 acc0, acc1; \
                    _Pragma("unroll") for (int r = 0; r < 16; ++r) { acc0[r] = 0.f; acc1[r] = 0.f; } \
                    _Pragma("unroll") for (int s_ = 0; s_ < 4; ++s_) acc0 = __builtin_amdgcn_mfma_f32_32x32x16_bf16(qa[0][s_], B[s_], acc0, 0, 0, 0); \
                    _Pragma("unroll") for (int s_ = 0; s_ < 4; ++s_) acc1 = __builtin_amdgcn_mfma_f32_32x32x16_bf16(qa[1][s_], B[s_], acc1, 0, 0, 0); \
                    float sc0 = 0.f, sc1 = 0.f; \
                    _Pragma("unroll") for (int r = 0; r < 16; ++r) sc0 += wv[0][r >> 2][r & 3] * fmaxf(acc0[r], 0.f); \
                    _Pragma("unroll") for (int r = 0; r < 16; ++r) sc1 += wv[1][r >> 2][r & 3] * fmaxf(acc1[r], 0.f); \
                    sc0 = xhalf_sum(sc0); sc1 = xhalf_sum(sc1); \
                    if (lane < 32) { score[(size_t)(2 * wave) * 4096 + 256 * kt + 32 * (kb_) + lane] = sc0; score[(size_t)(2 * wave + 1) * 4096 + 256 * kt + 32 * (kb_) + lane] = sc1; } } while (0)
                { bf16x8 fa[4], fb[4];
                  IDX_LOAD(fa, 0);
                  for (int kb = 0; kb < nkb; kb += 2) {
                      if (kb + 1 < nkb) IDX_LOAD(fb, kb + 1);
                      IDX_BLOCK(fa, kb);
                      if (kb + 1 < nkb) { if (kb + 2 < nkb) IDX_LOAD(fa, kb + 2); IDX_BLOCK(fb, kb + 1); }
                  } }
#undef IDX_LOAD
#undef IDX_BLOCK
                if (more) {
#pragma unroll
                    for (int i = 0; i < 4; ++i) { const int c = tid + 512 * i, row = c >> 3, ch = c & 7; *(LAS u32x4*)(lds + (cur ^ 1) * 32768 + row * 128 + ((ch ^ ((row >> 1) & 7)) << 4)) = st[i]; } }
                __syncthreads();
            }
            VM_WAIT();
            __builtin_amdgcn_fence(__ATOMIC_ACQUIRE, "agent");
            VM_WAIT();
            if (do_topk) { const int lane2 = lane_id_();
#pragma unroll 1
              for (int q = 0; q < 2; ++q) topk_row(score + (size_t)(2 * wave + q) * 4096, sel + (rowb + tq + q) * 256, tq + q, lane2); }
        }
    }
    __syncthreads();
}

constexpr int DSA_LAT = 0, DSA_XCH = 65536, DSA_TAB = 131072, DSA_T5 = 143360, DSA_TCNT = 147456, DSA_MASKROW = 4352;
__device__ __forceinline__ void phase_dsa(const Args& a, LAS unsigned char* lds, int G, int bx, const int wave, const int mode) {
    (void)mode;
    const int lane = lane_id_(), tid = wave * 64 + lane, h = lane >> 5, team = wave >> 2, wq = wave & 3, ttid = tid & 255;
    unsigned char* ws_ = a.ws; OPAQUE_S(ws_); GAS unsigned char* ws = (GAS unsigned char*)ws_;
    const GAS bf16_t* qabs = (const GAS bf16_t*)(ws + WS_QABS); const GAS bf16_t* lat = (const GAS bf16_t*)(ws + WS_LAT); const GAS int* sel = (const GAS int*)(ws + WS_SEL); GAS bf16_t* olat = (GAS bf16_t*)(ws + WS_OLAT);
    LAS float* t5c = (LAS float*)(lds + DSA_T5);
    volatile LAS unsigned* tcnt = (volatile LAS unsigned*)(lds + DSA_TCNT + team * 64);
    __syncthreads();
    for (int i = tid; i < 1024; i += 512) t5c[i] = ((const GAS float*)karg_in(I_T5))[(i >> 5) * 64 + 32 + (i & 31)] * LOG2E;
    if (tid < 32) ((volatile LAS unsigned*)(lds + DSA_TCNT))[tid] = 0u;
    if (tid >= 64 && tid < 96) ((LAS float*)((LAS unsigned char*)t5c + DSA_MASKROW))[tid - 64] = -1e30f;
    __syncthreads();
    LAS unsigned char* latw = lds + DSA_LAT + wave * 8192; LAS unsigned char* xch = lds + DSA_XCH + team * 32768;
    LAS unsigned char* pbuf = xch + 16384; LAS unsigned char* mbuf = xch + 18432; LAS unsigned char* lbuf = xch + 18944;
    const unsigned qoff = (unsigned)(((wq >> 1) * 64 + lane) * 16 + (wq & 1) * 8);
    LAS unsigned char* tabs = lds + DSA_TAB + team * 6144;
#define TAB_SEL(p) ((LAS int*)(tabs + (p) * 3072))
#define TAB_BKT(p) ((LAS int*)(tabs + (p) * 3072 + 1024))
    const unsigned kbase = krow_base(lane), vbase = vt_base(lane);
    const float cs = 0.08838834764831845f * LOG2E;
    unsigned tepoch = 0u;
#define TEAM_BAR() do { asm volatile("s_waitcnt lgkmcnt(0)" ::: "memory"); ++tepoch; if (lane == 0) __hip_atomic_fetch_add((LAS unsigned*)tcnt, 1u, __ATOMIC_RELAXED, __HIP_MEMORY_SCOPE_WORKGROUP); \
        while (__builtin_amdgcn_readfirstlane((int)*tcnt) < (int)(4u * tepoch)) __builtin_amdgcn_s_sleep(1); asm volatile("" ::: "memory"); } while (0)
    const int gr = lane >> 4, gc = lane & 15;
    const unsigned wbase = 256u * gr + 16u * (gc ^ (gr << 2));
#define DSA_TABLES(p, qq, idxv) do { const int t_ = (qq) & 4095, ns_ = t_ + 1 < 256 ? t_ + 1 : 256; const bool valid_ = ttid < ns_; const int id_ = valid_ ? (idxv) : 0; \
        TAB_SEL(p)[ttid] = id_; TAB_BKT(p)[ttid] = valid_ ? 128 * t5_bucket_(t_ - id_) : DSA_MASKROW; } while (0)
#define DSA_SELLOAD(qq) ((ttid < ((((qq) & 4095) + 1 < 256) ? ((qq) & 4095) + 1 : 256)) ? sel[(size_t)(qq) * 256 + ttid] : 0)
#define DSA_QLOAD(qq) do { const GAS bf16_t* qp_ = qabs + (size_t)(qq) * 16384 + (lane & 31) * 512 + 128 * wq + 8 * h; _Pragma("unroll") for (int s_ = 0; s_ < 8; ++s_) qf[s_] = *(const GAS bf16x8*)(qp_ + 16 * s_); } while (0)
#define DSA_GATHER(ST, lr, tab, cc) do { _Pragma("unroll") for (int i = 0; i < 8; ++i) ST[i] = *(const GAS u32x4*)((lr) + (size_t)(tab)[32 * (cc) + gr + 4 * i] * 512); } while (0)
    int qp = bx, par = 0;
    bf16x8 qf[8]; u32x4 stA[8], stB[8];
    int nxt_idx = 0;
    { const int q0 = 2 * qp + team;
      DSA_TABLES(0, q0, sel[(size_t)q0 * 256 + ttid]);
      if (qp + G < 4096) nxt_idx = DSA_SELLOAD(q0 + 2 * G);
      DSA_QLOAD(q0);
      TEAM_BAR();
      const GAS bf16_t* lr0 = lat + (size_t)(q0 >> 12) * SEQ * 512 + 128 * wq + gc * 8;
      DSA_GATHER(stA, lr0, TAB_SEL(0), 0); DSA_GATHER(stB, lr0, TAB_SEL(0), 1); }
    for (; qp < 4096; qp += G, par ^= 1) {
        const int q = 2 * qp + team, b = q >> 12;
        const bool has_next = qp + G < 4096; const int qn = q + 2 * G;
        const LAS int* selP = TAB_SEL(par); const LAS int* bktP = TAB_BKT(par); const LAS int* selN = TAB_SEL(par ^ 1);
        const GAS bf16_t* lrow = lat + (size_t)b * SEQ * 512 + 128 * wq + gc * 8;
        const GAS bf16_t* lrowN = lat + (size_t)(qn >> 12) * SEQ * 512 + 128 * wq + gc * 8;
        f32x16 o[4];
#pragma unroll
        for (int c = 0; c < 4; ++c)
#pragma unroll
            for (int r = 0; r < 16; ++r) o[c][r] = 0.f;
        float m = -1e30f, l = 0.f;
#define DSA_CHUNK(ST, c) do { \
            _Pragma("unroll") for (int i = 0; i < 8; ++i) *(LAS u32x4*)(latw + (wbase ^ (unsigned)((i & 3) << 4)) + 1024 * i) = ST[i];        \
            if ((c) + 2 < 8) DSA_GATHER(ST, lrow, selP, (c) + 2); else if (has_next) DSA_GATHER(ST, lrowN, selN, (c) + 2 - 8);        \
            f32x16 sc[1]; \
            _Pragma("unroll") for (int r = 0; r < 16; ++r) sc[0][r] = 0.f; \
            _Pragma("unroll") for (int s_ = 0; s_ < 8; ++s_) { const bf16x8 af = *(const LAS bf16x8*)(latw + (kbase ^ (unsigned)(s_ << 5))); sc[0] = __builtin_amdgcn_mfma_f32_32x32x16_bf16(af, qf[s_], sc[0], 0, 0, 0); } \
            if ((c) == 7 && has_next) DSA_QLOAD(qn);            \
            LAS unsigned char* xc = xch + ((c) & 1) * 8192; \
            _Pragma("unroll") for (int g8 = 0; g8 < 2; ++g8) *(LAS bf16x8*)(xc + wq * 2048 + (g8 * 64 + lane) * 16) = pack8(sc[0], 8 * g8);        \
            TEAM_BAR();                                        \
              \
            float lg[4]; float mx; \
            { f32x4 v = {0.f, 0.f, 0.f, 0.f}; \
              _Pragma("unroll") for (int w = 0; w < 4; ++w) { const u32x2 pw = *(const LAS u32x2*)(xc + w * 2048 + qoff); v = v + (f32x4){bflo(pw.x), bfhi(pw.x), bflo(pw.y), bfhi(pw.y)}; } \
              const u32x4 bk4 = *(const LAS u32x4*)(bktP + 32 * (c) + 8 * wq + 4 * h); \
              _Pragma("unroll") for (int e = 0; e < 4; ++e) { const float bias = *(const LAS float*)((const LAS unsigned char*)t5c + bk4[e] + 4 * (lane & 31)); lg[e] = v[e] * cs + bias; } \
              mx = xhalf_max(fmaxf(fmaxf(lg[0], lg[1]), fmaxf(lg[2], lg[3]))); } \
            if ((c) == 0) {                                    \
                *(LAS float*)(mbuf + (lane & 31) * 16 + wq * 4) = mx; \
                TEAM_BAR(); \
                const f32x4 m4 = *(const LAS f32x4*)(mbuf + (lane & 31) * 16); m = fmaxf(fmaxf(m4[0], m4[1]), fmaxf(m4[2], m4[3])); \
            } \
              \
            { const float p0 = fast_exp2(fminf(lg[0] - m, 100.f)), p1 = fast_exp2(fminf(lg[1] - m, 100.f)), p2 = fast_exp2(fminf(lg[2] - m, 100.f)), p3 = fast_exp2(fminf(lg[3] - m, 100.f)); \
              l += (p0 + p1) + (p2 + p3); \
              *(LAS u32x2*)(pbuf + qoff) = (u32x2){cvtpk(p0, p1), cvtpk(p2, p3)}; \
              if ((c) != 0) *(LAS float*)(mbuf + (lane & 31) * 16 + wq * 4) = mx; } \
            TEAM_BAR();                                        \
            bf16x8 p[1][2]; \
            p[0][0] = *(const LAS bf16x8*)(pbuf + lane * 16); p[0][1] = *(const LAS bf16x8*)(pbuf + (64 + lane) * 16); \
            _Pragma("unroll") for (int cc = 0; cc < 4; ++cc) \
                _Pragma("unroll") for (int s_ = 0; s_ < 2; ++s_) { const bf16x8 af = vfrag2(latw, vbase, cc, 4096 * s_); o[cc] = __builtin_amdgcn_mfma_f32_32x32x16_bf16(af, p[0][s_], o[cc], 0, 0, 0); } \
            if ((c) != 0) {                                    \
                const f32x4 m4 = *(const LAS f32x4*)(mbuf + (lane & 31) * 16); const float mxa = fmaxf(fmaxf(m4[0], m4[1]), fmaxf(m4[2], m4[3])); \
                if (__any(mxa > m + 8.0f)) { const float mn = fmaxf(m, mxa), alpha = fast_exp2(m - mn); l *= alpha; m = mn; \
                    _Pragma("unroll") for (int cc = 0; cc < 4; ++cc) o[cc] = o[cc] * alpha; } \
            } \
            if ((c) == 3 && has_next) { DSA_TABLES(par ^ 1, qn, nxt_idx);        \
                if (qp + 2 * G < 4096) nxt_idx = DSA_SELLOAD(qn + 2 * G); } \
        } while (0)
        for (int c2 = 0; c2 < 8; c2 += 2) { DSA_CHUNK(stA, c2); DSA_CHUNK(stB, c2 + 1); }
#undef DSA_CHUNK
        l = xhalf_sum(l);
        *(LAS float*)(lbuf + (lane & 31) * 16 + wq * 4) = l;
        TEAM_BAR();
        const f32x4 l4 = *(const LAS f32x4*)(lbuf + (lane & 31) * 16);
        const float il = 1.0f / ((l4[0] + l4[1]) + (l4[2] + l4[3]));
        GAS bf16_t* op = olat + (size_t)q * 16384 + (lane & 31) * 512 + 128 * wq + 4 * h;
#pragma unroll
        for (int cc = 0; cc < 4; ++cc)
#pragma unroll
            for (int g4 = 0; g4 < 4; ++g4) { u32x2 w; w.x = cvtpk(o[cc][4 * g4] * il, o[cc][4 * g4 + 1] * il); w.y = cvtpk(o[cc][4 * g4 + 2] * il, o[cc][4 * g4 + 3] * il); *(GAS u32x2*)(op + 32 * cc + 8 * g4) = w; }
    }
    __syncthreads();
#undef TEAM_BAR
#undef TAB_SEL
#undef TAB_BKT
#undef DSA_TABLES
#undef DSA_SELLOAD
#undef DSA_QLOAD
#undef DSA_GATHER
}

constexpr int PH_FINAL = 50, NPH = PH_FINAL + 1;

struct TJob { int in_id; long src_lstride; int ldsrc, K, src_col0, ncols; long dst_off  ; int ldt, dst_row0, gain_id; long gain_lstride, gain_off0; int lsel, flags; };
constexpr int NTJ_E = 12, NTJ_O = 11;
__constant__ TJob g_tj_even[NTJ_E] = {
#define EWIN_JOB(c0, n, r0) {I_EWIN, (long)4096 * 12816, 12816, 4096, c0, n, (long)WS_EWIN, 4096, r0, I_NORMG, (long)2 * 4096, 0, 0, 2}
    EWIN_JOB(0, 2048, E_QA), EWIN_JOB(2048, 2048, E_KA), EWIN_JOB(4096, 2048, E_VA), EWIN_JOB(6160, 2048, E_GA), EWIN_JOB(8208, 2048, E_QB),
    EWIN_JOB(10768, 2048, E_GB), EWIN_JOB(10256, 256, E_KB), EWIN_JOB(10512, 256, E_VB), EWIN_JOB(6144, 16, E_FA),
    {I_EWOUT, (long)4096 * 4096, 4096, 4096, 0, 4096, (long)WS_EWOUT, 4096, 0, -1, 0, 0, 0, 2},
    {I_PWGATE, (long)4096 * 4096, 4096, 4096, 0, 4096, (long)WS_EGATE, 4096, 0, I_PNORMG, (long)4096, 0, 1, 2},
    {I_PWPROJ, (long)256 * 4096, 4096, 256, 0, 4096, (long)WS_EPROJ, 256, 0, -1, 0, 0, 1, 0},
};
__constant__ TJob g_tj_odd[NTJ_O] = {
#define OWIN_JOB(c0, n, r0) {I_OWIN, (long)4096 * 5728, 5728, 4096, c0, n, (long)WS_OWIN, 4096, r0, I_NORMG, (long)2 * 4096, 4096, 0, 0}
    {I_OWIN, (long)4096 * 5728, 5728, 4096, 1632, 4096, (long)WS_OWIN8, 4096, 0, I_NORMG, (long)2 * 4096, 4096, 0, 2},
    OWIN_JOB(0, 1024, 0), OWIN_JOB(1024, 512, 1024), OWIN_JOB(1536, 64, 1536), OWIN_JOB(1600, 32, 1600),
    {I_OWOUT, (long)4096 * 4096, 4096, 4096, 0, 4096, (long)WS_OWOUT, 4096, 0, -1, 0, 0, 0, 2},
    {I_PWGATE, (long)4096 * 4096, 4096, 4096, 0, 4096, (long)WS_OGATE, 4096, 0, I_PNORMG, (long)4096, 0, 1, 2},
    {I_PWPROJ, (long)256 * 4096, 4096, 256, 0, 4096, (long)WS_OPROJ, 256, 0, -1, 0, 0, 1, 0},
    {I_OWUQ,  (long)1024 * 4096, 4096, 1024, 0, 4096, (long)WS_OWUQ, 1024, 0,    -1, 0, 0, 0, 0},
    {I_OWUQI, (long)1024 * 2048, 2048, 1024, 0, 2048, (long)WS_OWUQ, 1024, 4096, -1, 0, 0, 0, 0},
    {I_OWUV, (long)512 * 4096, 4096, 512, 0, 4096, (long)WS_OWUV, 1024, 0, -1, 0, 0, 0, 1},
};

__device__ __forceinline__ void transpose_item(const Args& a, GAS unsigned char* ws, const TJob& jb, int L, int item, LAS float* scr, int lane) {
    const int ncb = (jb.ncols + 31) >> 5, kb = item / ncb, nb = item % ncb, k0 = 64 * kb, n0 = 32 * nb;
    const int li = jb.lsel ? L : (L >> 1);
    const GAS float* W = (const GAS float*)karg_in(jb.in_id) + (size_t)li * jb.src_lstride;
    const GAS float* gain = jb.gain_id >= 0 ? (const GAS float*)karg_in(jb.gain_id) + (size_t)li * jb.gain_lstride + jb.gain_off0 : nullptr;
    const int r8 = lane >> 3, c4 = lane & 7; const bool cv = (n0 + 4 * c4) < jb.ncols;
    f32x4 v[8];
    const GAS float* src = W + (size_t)(k0 + r8) * jb.ldsrc + jb.src_col0 + n0 + 4 * c4;
#pragma unroll
    for (int i = 0; i < 8; ++i) v[i] = cv ? __builtin_nontemporal_load((const GAS f32x4*)(src + (size_t)(8 * i) * jb.ldsrc)) : (f32x4){0.f, 0.f, 0.f, 0.f};
    const int c = lane & 7;
    f32x4 g0 = {1.f, 1.f, 1.f, 1.f}, g1 = g0;
    if (gain) { g0 = *(const GAS f32x4*)(gain + k0 + 8 * c); g1 = *(const GAS f32x4*)(gain + k0 + 8 * c + 4); }
#pragma unroll
    for (int i = 0; i < 8; ++i) { LAS float* d = scr + (8 * i + r8) * 33 + 4 * c4; d[0] = v[i][0]; d[1] = v[i][1]; d[2] = v[i][2]; d[3] = v[i][3]; }
    LDS_WAIT(); asm volatile("" ::: "memory");
    GAS bf16_t* WT = (GAS bf16_t*)(ws + jb.dst_off);
#pragma unroll
    for (int j = 0; j < 4; ++j) { const int n = (lane >> 3) + 8 * j; const LAS float* s = scr + (8 * c) * 33 + n;
        int drow = jb.dst_row0 + n0 + n, dk = k0 + 8 * c;
        if (jb.flags & 2) {
            u32x2 q; q.x = pack4_q8_(s[0 * 33] * g0[0] * W8_SCALE, s[1 * 33] * g0[1] * W8_SCALE, s[2 * 33] * g0[2] * W8_SCALE, s[3 * 33] * g0[3] * W8_SCALE);
            q.y = pack4_q8_(s[4 * 33] * g1[0] * W8_SCALE, s[5 * 33] * g1[1] * W8_SCALE, s[6 * 33] * g1[2] * W8_SCALE, s[7 * 33] * g1[3] * W8_SCALE);
            *(GAS u32x2*)((GAS unsigned char*)ws + jb.dst_off + (size_t)drow * jb.ldt + dk) = q; continue; }
        u32x4 o; o.x = cvtpk(s[0 * 33] * g0[0], s[1 * 33] * g0[1]); o.y = cvtpk(s[2 * 33] * g0[2], s[3 * 33] * g0[3]); o.z = cvtpk(s[4 * 33] * g1[0], s[5 * 33] * g1[1]); o.w = cvtpk(s[6 * 33] * g1[2], s[7 * 33] * g1[3]);
        if (jb.flags & 1) { const int col = n0 + n, h = col >> 7, d = col & 127; drow = (h >> 1) * 256 + (h & 1) * 128 + d; dk = (h & 1) * 512 + k0 + 8 * c; }
        *(GAS u32x4*)(WT + (size_t)drow * jb.ldt + dk) = o; }
    LDS_WAIT(); asm volatile("" ::: "memory");
}

__device__ __forceinline__ void convert_layer_weights(const Args& a, int L, LAS unsigned char* lds, int gw, int NGW, int wave, int part) {
    const int lane = lane_id_();
    unsigned char* ws_ = a.ws; OPAQUE_S(ws_); GAS unsigned char* ws = (GAS unsigned char*)ws_;
    LAS float* scr = (LAS float*)(lds + wave * 16384);
    const bool odd = (L & 1) != 0; const int nj = odd ? NTJ_O : NTJ_E;
    int jstart = 0;
    for (int j = 0; j < nj; ++j) {
        const TJob jb = odd ? g_tj_odd[j] : g_tj_even[j];
        if (part != 0 && ((part == 1) != (jb.in_id == I_OWIN))) continue;
        const int nitems = (jb.K >> 6) * ((jb.ncols + 31) >> 5);
        const int first = (gw - (jstart % NGW) + NGW) % NGW;
        for (int it = first; it < nitems; it += NGW) transpose_item(a, ws, jb, L, it, scr, lane);
        jstart += nitems;
    }
    if (part == 1) return;
    if (!odd) {
        GAS u32x4* z = (GAS u32x4*)(ws + WS_EWIN + (size_t)12832 * 4096); const int n = 224 * 4096 / 16;
        for (int i = gw * 64 + lane; i < n; i += NGW * 64) z[i] = zero4_();
    } else {
        GAS u32x4* z2 = (GAS u32x4*)(ws + WS_OWIN + (size_t)1632 * 4096 * 2); const int n2 = 160 * 4096 * 2 / 16;
        for (int i = gw * 64 + lane; i < n2; i += NGW * 64) z2[i] = zero4_();
        GAS u32x4* z3 = (GAS u32x4*)(ws + WS_OWUV);
        for (int i = gw * 64 + lane; i < 4096 * 64; i += NGW * 64) { const int r = i >> 6, c16 = i & 63; const int zh = ((r >> 7) & 1) ^ 1; z3[(size_t)r * 128 + zh * 64 + c16] = zero4_(); }
        const GAS f32x4* s = (const GAS f32x4*)(((const GAS float*)karg_in(I_OWUK)) + (size_t)(L >> 1) * 512 * 4096); GAS u32x2* d = (GAS u32x2*)(ws + WS_OWUK); const int n = 512 * 4096 / 4;
        for (int i = gw * 64 + lane; i < n; i += NGW * 64) { const f32x4 v = __builtin_nontemporal_load(s + i); d[i] = (u32x2){cvtpk(v[0], v[1]), cvtpk(v[2], v[3])}; }
    }
}

__device__ __forceinline__ void phase_convert(const Args& a, LAS unsigned char* lds, int gw, int NGW, int wave) {
    const int lane = lane_id_();
    unsigned char* ws_ = a.ws; OPAQUE_S(ws_); GAS unsigned char* ws = (GAS unsigned char*)ws_;
    {
        const GAS f32x4* s2 = (const GAS f32x4*)((const GAS float*)karg_in(I_P)); GAS u32x2* d2 = (GAS u32x2*)(ws + WS_PB); const int n2 = 4 * M * 256 / 4;
        for (int i = gw * 64 + lane; i < n2; i += NGW * 64) { const f32x4 v = __builtin_nontemporal_load(s2 + i); d2[i] = (u32x2){cvtpk(v[0], v[1]), cvtpk(v[2], v[3])}; }
    }
    {
        const GAS float* x = ((const GAS float*)karg_in(I_X)); GAS unsigned char* HQ = ws + WS_HQ; GAS float* asc = (GAS float*)(ws + WS_ASCALE); GAS u64* ss = (GAS u64*)(ws + WS_SUMSQ);
        for (int row = gw; row < M; row += NGW) {
            const GAS f32x4* xr = (const GAS f32x4*)(x + (size_t)row * DM); GAS unsigned* qr = (GAS unsigned*)(HQ + (size_t)row * DM); GAS u32x2* hr = (GAS u32x2*)(ws + WS_H + (size_t)row * DM * 2);
            f32x4 v[16]; float s = 0.f, am = 0.f;
#pragma unroll
            for (int j = 0; j < 16; ++j) { v[j] = xr[lane + 64 * j]; s += (v[j][0] * v[j][0] + v[j][1] * v[j][1]) + (v[j][2] * v[j][2] + v[j][3] * v[j][3]); am = fmaxf(fmaxf(am, fmaxf(fabsf(v[j][0]), fabsf(v[j][1]))), fmaxf(fabsf(v[j][2]), fabsf(v[j][3]))); }
            s = wave_sum(s);
#pragma unroll
            for (int o = 1; o < 64; o <<= 1) am = fmaxf(am, __shfl_xor(am, o));
            am = fmaxf(am, 1e-20f); const float qs = 127.0f / am;
#pragma unroll
            for (int j = 0; j < 16; ++j) { qr[lane + 64 * j] = pack4_q8_(v[j][0] * qs, v[j][1] * qs, v[j][2] * qs, v[j][3] * qs); hr[lane + 64 * j] = (u32x2){cvtpk(v[j][0], v[j][1]), cvtpk(v[j][2], v[j][3])}; }
            if (lane == 0) { ss[row] = ss_fix(s); asc[row] = am * (1.0f / 127.0f); }
        }
    }
}

__device__ __forceinline__ void phase_quant_yin(const Args& a, int gw, int NGW) {
    const int lane = lane_id_();
    unsigned char* ws_ = a.ws; OPAQUE_S(ws_); GAS unsigned char* ws = (GAS unsigned char*)ws_;
    const GAS bf16_t* yin = (const GAS bf16_t*)(ws + WS_YIN); GAS unsigned char* yq = ws + WS_YQ; GAS float* asc = (GAS float*)(ws + WS_ASCALEY);
    for (int row = gw; row < M; row += NGW) {
        const GAS u32x4* yr = (const GAS u32x4*)(yin + (size_t)row * DM); GAS u32x2* qr = (GAS u32x2*)(yq + (size_t)row * DM);
        u32x4 w[8]; float am = 0.f;
#pragma unroll
        for (int j = 0; j < 8; ++j) { w[j] = yr[lane + 64 * j];
            am = fmaxf(am, fmaxf(fmaxf(fmaxf(fabsf(bflo(w[j].x)), fabsf(bfhi(w[j].x))), fmaxf(fabsf(bflo(w[j].y)), fabsf(bfhi(w[j].y)))), fmaxf(fmaxf(fabsf(bflo(w[j].z)), fabsf(bfhi(w[j].z))), fmaxf(fabsf(bflo(w[j].w)), fabsf(bfhi(w[j].w)))))); }
#pragma unroll
        for (int o = 1; o < 64; o <<= 1) am = fmaxf(am, __shfl_xor(am, o));
        am = fmaxf(am, 1e-20f); const float qs = 127.0f / am;
#pragma unroll
        for (int j = 0; j < 8; ++j) { u32x2 q; q.x = pack4_q8_(bflo(w[j].x) * qs, bfhi(w[j].x) * qs, bflo(w[j].y) * qs, bfhi(w[j].y) * qs); q.y = pack4_q8_(bflo(w[j].z) * qs, bfhi(w[j].z) * qs, bflo(w[j].w) * qs, bfhi(w[j].w) * qs); qr[lane + 64 * j] = q; }
        if (lane == 0) asc[row] = am * (1.0f / 127.0f);
    }
}
__device__ __forceinline__ void phase_final(const Args& a, int gw, int NGW) {
    const int lane = lane_id_();
    unsigned char* ws_ = a.ws; OPAQUE_S(ws_); GAS unsigned char* ws = (GAS unsigned char*)ws_;
    const GAS bf16_t* H = (const GAS bf16_t*)(ws + WS_H); const GAS u64* ss = (const GAS u64*)(ws + WS_SUMSQ) + 4 * M; const GAS f32x4* g = (const GAS f32x4*)((const GAS float*)karg_in(I_FINALG));
    for (int row = gw; row < M; row += NGW) {
        const float r = 1.0f / sqrtf((float)ss[row] * (1.0f / 16777216.0f) * (1.0f / 4096.0f) + EPS);
        const GAS u32x2* hr = (const GAS u32x2*)(H + (size_t)row * DM); GAS f32x4* orow = (GAS f32x4*)(a.out + (size_t)row * DM);
#pragma unroll 4
        for (int j = 0; j < 16; ++j) { const u32x2 hw = hr[lane + 64 * j]; const f32x4 v = (f32x4){bflo(hw.x), bfhi(hw.x), bflo(hw.y), bfhi(hw.y)}, gg = g[lane + 64 * j]; orow[lane + 64 * j] = v * r * gg; }
    }
}

__global__ void __launch_bounds__(512, 2) fwd(Args args) {
    extern __shared__ __attribute__((aligned(16))) unsigned char lds_raw[];
    LAS unsigned char* lds = (LAS unsigned char*)lds_raw;
    volatile LAS unsigned* MISC = (volatile LAS unsigned*)(lds + MISC_OFF);
    int wave0_ = __builtin_amdgcn_readfirstlane((int)threadIdx.x >> 6);
    asm volatile("" : "+s"(wave0_));
    const int wave0 = wave0_;
    if (wave0 == 0) { const int l_ = lane_id_(); MISC[l_] = (l_ == 16) ? (unsigned)gridDim.x : (l_ == 17) ? (unsigned)blockIdx.x : (l_ == 18) ? (unsigned)args.ph_lo : (l_ == 19) ? (unsigned)args.ph_hi : 0u; }
    __syncthreads();
#define KS_RD(i) ((int)__builtin_amdgcn_readfirstlane((int)*(volatile LAS unsigned*)(size_t)(opaque_vu_((unsigned)MISC_OFF) + 4u * (i))))
#define KS_G0 KS_RD(16)
#define KS_BX0 KS_RD(17)
#define KS_LO KS_RD(18)
#define KS_HI KS_RD(19)
    if (KS_HI - KS_LO > 1) (void)xcd_barrier_post((unsigned*)(args.ws + WS_CTL), MISC + 8, wave0);
#define IN(k) (KS_LO <= (k) && (k) < KS_HI)
#define PHASE_LOCALS() int wave = wave0, G = KS_G0, bx = KS_BX0; asm volatile("" : "+s"(wave), "+s"(G), "+s"(bx)); const int gw = bx * 8 + wave, NGW = G * 8; (void)gw; (void)NGW; \
        unsigned char* ws = args.ws; OPAQUE_S(ws); u64* sumsq = (u64*)(ws + WS_SUMSQ); (void)sumsq; \
        bf16_t* hb_cur = (bf16_t*)(ws + (hbswap ? WS_HBB : WS_HBA)); bf16_t* hb_oth = (bf16_t*)(ws + (hbswap ? WS_HBA : WS_HBB)); (void)hb_cur; (void)hb_oth
#undef SEAM
#define SEAM(k) do { if (IN(k) && IN((k) + 1)) { int wave = wave0; asm volatile("" : "+s"(wave)); unsigned char* _w = args.ws; OPAQUE_S(_w); XcdBarrier _b; _b.bar = (unsigned*)(_w + WS_CTL); _b.x = xb_xcc_id(); _b.st = (volatile LAS unsigned*)(lds + MISC_OFF) + 8; xcd_barrier(_b, wave); } } while (0)
    for (int LL = -2; LL < 8; ++LL) {
        const int L = LL >> 1, st_ = LL & 1;
        const int base = 10 * (L + 1); const bool odd = L >= 0 && (L & 1) != 0;
        const bool mixed = MK_STAGE >= (odd ? 3 : 2);
        const bool hbswap = (MK_STAGE < 3) && ((MK_STAGE == 1 && (L & 1)) || (MK_STAGE == 2 && L >= 2));
        if (st_ == 0) {
        if (IN(base + 0) && mixed && L >= 0)
#pragma unroll 1
        for (int rep_ = 0; rep_ < (((MK_DUP & (1024 | (1 << 26))) && !odd) || ((MK_DUP & 2048) && odd) ? 2 : 1); ++rep_) {
            PHASE_LOCALS();
            if (odd) {
                {
                    pg8::Gemm g{(const bf16_t*)(ws + WS_HQ), (const bf16_t*)(ws + WS_OWIN8), DM, DM, DM, 32, 16, 1, 0, 0};
                    pg8::Sched S; S.init(g, G, bx);
                    pg8::EpiBf16Q E{(bf16_t*)(ws + WS_PROJ), ON, sumsq + L * M, (const float*)(ws + WS_ASCALE), nullptr, 0};
                    pg8::gemm_phase<pg8::EpiBf16Q, true>(lds, g, S, E, wave); }
                {
                    PHASE_LOCALS();
                    pg8::Gemm g{(const bf16_t*)(ws + WS_H), (const bf16_t*)(ws + WS_OWIN), DM, DM, DM, 32, 7, 1, 0, 0};
                    pg8::Sched S; S.init(g, G, bx);
                    pg8::EpiBf16 E{(bf16_t*)(ws + WS_PROJ) + 4096, ON, 0, sumsq + L * M};
                    pg8::gemm_phase(lds, g, S, E, wave); }
            } else {
                pg8::Gemm g{(const bf16_t*)(ws + WS_HQ), (const bf16_t*)(ws + WS_EWIN), DM, DM, DM, 32, EN / 256, 1, 0, 0};
                pg8::Sched S; S.init(g, G, bx);
                pg8::EpiBf16Q E{(bf16_t*)(ws + WS_PROJ), EN, sumsq + L * M, (const float*)(ws + WS_ASCALE), (u64*)(ws + WS_KN) + (size_t)(L >> 1) * 16 * M, ((MK_DUP & (1 << 26)) && rep_ == 0) ? 1 : 0};
                pg8::gemm_phase<pg8::EpiBf16Q, true>(lds, g, S, E, wave);
            }
        }
        } else if (IN(base + 1)) {
            PHASE_LOCALS();
            if (mixed && !odd && L >= 0) { phase_even_attn(args, L >> 1, lds, G, bx, wave, 3); if (MK_DUP & 1) phase_even_attn(args, L >> 1, lds, G, bx, wave, 3); if (MK_DUP & 32) phase_even_attn(args, L >> 1, lds, G, bx, wave, 1); if (MK_DUP & 64) phase_even_attn(args, L >> 1, lds, G, bx, wave, 2); }
            if (mixed && odd) for (int rep_ = 0; rep_ < ((MK_DUP & 65536) ? 2 : 1); ++rep_) phase_odd_norms(args, L >> 1, gw, NGW);
            __syncthreads();
            if (L < 0) for (int rep_ = 0; rep_ < ((MK_DUP & 262144) ? 2 : 1); ++rep_) phase_convert(args, lds, gw, NGW, wave);
        }
        { const bool go_ = st_ == 0 ? (IN(base + 0) && mixed && L >= 0 && !odd && L < 3) : (IN(base + 1) && L < 3);
          if (go_) {
            PHASE_LOCALS();
            const int tail_ = (L >= 0 && !odd) ? (32 * (EN / 256)) % G : 0;
            int cgw_ = gw, cn_ = NGW, part_ = tail_ > 0 ? 2 : 0;
            if (st_ == 0) { part_ = (tail_ > 0 && bx >= tail_) ? 1 : -1; cgw_ = (bx - tail_) * 8 + wave; cn_ = (G - tail_) * 8; }
            asm volatile("" : "+s"(cgw_), "+s"(cn_), "+s"(part_));
            if (part_ >= 0) { __syncthreads(); convert_layer_weights(args, L + 1, lds, cgw_, cn_, wave, part_); __syncthreads(); }
          } }
        if (st_ == 0) { if (L >= 0) SEAM(base + 0); continue; }
        SEAM(base + 1);
        if (mixed && odd) {
            if (IN(base + 2))
#pragma unroll 1
            for (int rep_ = 0; rep_ < ((MK_DUP & 4096) ? 2 : 1); ++rep_) {
                PHASE_LOCALS();
                pg8::Gemm g{(const bf16_t*)(ws + WS_CQN), (const bf16_t*)(ws + WS_OWUQ), 1024, 1024, 1024, 32, QW / 256, 1, 0, 0};
                pg8::Sched S; S.init(g, G, bx);
                pg8::EpiBf16 E{(bf16_t*)(ws + WS_QBUF), QW, 0, nullptr};
                pg8::gemm_phase(lds, g, S, E, wave);
            }
            SEAM(base + 2);
            if (IN(base + 3)) {
#pragma unroll 1
                for (int rep_ = 0; rep_ < ((MK_DUP & 8192) ? 2 : 1); ++rep_) { PHASE_LOCALS();
                  pg8::Gemm g{(const bf16_t*)(ws + WS_QBUF), (const bf16_t*)(ws + WS_OWUK), QW, 4096, 128, 32, 2, 32, 128, 128};
                  pg8::Sched S; S.init(g, G, bx);
                  pg8::EpiBf16 E{(bf16_t*)(ws + WS_QABS), 16384, 512, nullptr};
                  pg8::gemm_phase(lds, g, S, E, wave); }
                { PHASE_LOCALS(); if (MK_DUP & 128) phase_indexer(args, lds, G, bx, wave, false); phase_indexer(args, lds, G, bx, wave, true); if (MK_DUP & 2) phase_indexer(args, lds, G, bx, wave, true); }
            }
            SEAM(base + 3);
            if (IN(base + 4)) { PHASE_LOCALS(); phase_dsa(args, lds, G, bx, wave, 0); if (MK_DUP & 4) phase_dsa(args, lds, G, bx, wave, 0); }
            SEAM(base + 4);
            if (IN(base + 5))
#pragma unroll 1
            for (int rep_ = 0; rep_ < ((MK_DUP & 16384) ? 2 : 1); ++rep_) {
                PHASE_LOCALS();
                pg8::Gemm g{(const bf16_t*)(ws + WS_OLAT), (const bf16_t*)(ws + WS_OWUV), 16384, 1024, 1024, 32, 1, 16, 1024, (size_t)256 * 1024};
                pg8::Sched S; S.init(g, G, bx);
                pg8::EpiOGate E{(bf16_t*)(ws + WS_YIN), (const bf16_t*)(ws + WS_PROJ) + O_GC, ON};
                pg8::gemm_phase(lds, g, S, E, wave);
            }
            SEAM(base + 5);
        }
        const int phq = odd ? base + 6 : base + 2, ph5 = phq + 1, ph6 = ph5 + 1;
        if (IN(phq) && L >= 0) for (int rep_ = 0; rep_ < ((MK_DUP & 32768) ? 2 : 1); ++rep_) { PHASE_LOCALS(); phase_quant_yin(args, gw, NGW); }
        if (L >= 0) SEAM(phq);
        if (IN(ph5) && L >= 0) {
            if (mixed) {
                PHASE_LOCALS();
                pg8::Gemm g{(const bf16_t*)(ws + WS_YQ), (const bf16_t*)(ws + (odd ? WS_OWOUT : WS_EWOUT)), DM, DM, DM, 32, 16, 1, 0, 0};
                pg8::Sched S; S.init(g, G, bx);
                pg8::EpiResid E{(const bf16_t*)(ws + WS_H), (bf16_t*)(ws + WS_H), (signed char*)(ws + WS_HBB), (float*)(ws + WS_ASCALE1), sumsq + L * M, sumsq + (5 + L) * M, (const float*)(ws + WS_ASCALEY)};
                pg8::gemm_phase<pg8::EpiResid, true>(lds, g, S, E, wave);
            }
#pragma unroll 1
            for (int rep_ = 0; rep_ < ((MK_DUP & 131072) ? 2 : 1); ++rep_) {
                PHASE_LOCALS();
                pg8::Gemm g{(const bf16_t*)(ws + WS_PB) + (size_t)L * M * 256, (const bf16_t*)(ws + (odd ? WS_OPROJ : WS_EPROJ)), 256, 256, 256, 32, 16, 1, 0, 0};
                pg8::Sched S; S.init(g, G, bx);
                pg8::EpiBf16 E{(bf16_t*)(ws + WS_PP), DM, 0, nullptr};
                pg8::gemm_phase(lds, g, S, E, wave);
            }
        }
        if (L >= 0) SEAM(ph5);
        if (IN(ph6) && L >= 0) {
            PHASE_LOCALS();
            pg8::Gemm g{(const bf16_t*)(ws + WS_HBB), (const bf16_t*)(ws + (odd ? WS_OGATE : WS_EGATE)), DM, DM, DM, 32, 16, 1, 0, 0};
            pg8::Sched S; S.init(g, G, bx);
            pg8::EpiGate E{(bf16_t*)(ws + WS_H), (const bf16_t*)(ws + WS_PP), sumsq + (mixed ? (5 + L) : L) * M, sumsq + (L + 1) * M, (L < 3) ? (signed char*)(ws + WS_HQ) : nullptr, (float*)(ws + WS_ASCALE), (const float*)(ws + WS_ASCALE1)};
            pg8::gemm_phase<pg8::EpiGate, true>(lds, g, S, E, wave);
        }
        if (L >= 0) SEAM(ph6);
    }
    if (IN(PH_FINAL)) for (int rep_ = 0; rep_ < ((MK_DUP & 524288) ? 2 : 1); ++rep_) phase_final(args, KS_BX0 * 8 + wave0, KS_G0 * 8);
#undef IN
#undef SEAM
}

extern "C" void kernel_launch(void* const* d_in, const int* in_sizes, int n_in, void* d_out, int out_size, void* d_ws, size_t ws_size, hipStream_t stream) {
    static int grid = 0;
    if (grid == 0) {
        if (n_in != 22 || out_size != M * DM || ws_size < WS_END) { fprintf(stderr, "kernel_launch: unexpected shapes (n_in %d out %d ws %zu, need %zu)\n", n_in, out_size, ws_size, (size_t)WS_END); grid = -1; return; }
        int dev = 0, cus = 0, per_cu = 0;
        if (hipGetDevice(&dev) != hipSuccess || hipDeviceGetAttribute(&cus, hipDeviceAttributeMultiprocessorCount, dev) != hipSuccess) { grid = -1; return; }
        if (hipFuncSetAttribute((const void*)fwd, hipFuncAttributeMaxDynamicSharedMemorySize, LDS_BYTES) != hipSuccess) { fprintf(stderr, "kernel_launch: hipFuncSetAttribute failed\n"); grid = -1; return; }
        if (hipOccupancyMaxActiveBlocksPerMultiprocessor(&per_cu, (const void*)fwd, 512, LDS_BYTES) != hipSuccess || per_cu < 1) { fprintf(stderr, "kernel_launch: occupancy query says %d\n", per_cu); }
        (void)hipGetLastError();
        grid = cus;
    }
    if (grid < 0) return;
    if (hipMemsetAsync((char*)d_ws + WS_CTL, 0, WS_ZERO_BYTES, stream) != hipSuccess) return;
    Args a{};
    for (int i = 0; i < 22; ++i) a.in[i] = (const float*)d_in[i];
    a.out = (float*)d_out; a.ws = (unsigned char*)d_ws;
#if MK_ONE_LAUNCH
    a.ph_lo = 0; a.ph_hi = NPH;
    hipLaunchKernelGGL(fwd, dim3(grid), dim3(512), LDS_BYTES, stream, a);
#else
    for (int ph = 0; ph < NPH; ++ph) {
        if (ph < PH_FINAL) { const int L = ph / 10 - 1, k = ph % 10; if (L < 0 && k != 1) continue; if (L >= 0 && !(L & 1) && k >= 5) continue; if (L >= 0 && (L & 1) && k >= 9) continue; }
        a.ph_lo = ph; a.ph_hi = ph + 1;
        hipLaunchKernelGGL(fwd, dim3(grid), dim3(512), LDS_BYTES, stream, a);
    }
#endif
}
```

```cpp
#include <hip/hip_runtime.h>
#include <cstdio>
#include <cstdint>

#define LAS __attribute__((address_space(3)))
#define GAS __attribute__((address_space(1)))
typedef unsigned short bf16_t;
typedef short bf16x8 __attribute__((ext_vector_type(8)));
typedef short s16x4 __attribute__((ext_vector_type(4)));
typedef short v4i16_t __attribute__((ext_vector_type(4)));
typedef float f32x2 __attribute__((ext_vector_type(2)));
typedef float f32x4 __attribute__((ext_vector_type(4)));
typedef float f32x16 __attribute__((ext_vector_type(16)));
typedef unsigned u32x2 __attribute__((ext_vector_type(2)));
typedef unsigned u32x4 __attribute__((ext_vector_type(4)));
typedef __bf16 bf16x2_t __attribute__((ext_vector_type(2)));
typedef GAS unsigned gu32;

#ifndef MK_STAGE
#define MK_STAGE 3
#endif
#ifndef MK_DUP
#define MK_DUP 0
#endif
#ifndef MK_ONE_LAUNCH
#define MK_ONE_LAUNCH 1
#endif

constexpr int M = 8192, DM = 4096, SEQ = 4096;
constexpr float EPS = 1e-6f;
constexpr float LOG2E = 1.4426950408889634f;
constexpr int EN = 13056;
constexpr int ON = 5888;
constexpr int E_QA = 0, E_KA = 2048, E_VA = 4096, E_GA = 6144, E_QB = 8192, E_GB = 10240, E_KB = 12288, E_VB = 12544, E_FA = 12800;
constexpr int O_GC = 0, O_CQ = 4096, O_CKV = 5120, O_KIDX = 5632, O_WIDX = 5696;
constexpr int QW = 6144;

constexpr size_t MiB = 1u << 20;
constexpr size_t WS_CTL = 0;
constexpr size_t WS_SUMSQ = 1 * MiB;
constexpr size_t WS_KN = 2 * MiB;
constexpr size_t WS_ZERO_BYTES = 4 * MiB;
constexpr size_t SZ_SQ = (size_t)4096 * 4096 * 2;
constexpr size_t SZ_WPROJ = (size_t)4096 * 256 * 2;
constexpr size_t WS_EWIN = 4 * MiB;
constexpr size_t WS_EWOUT = WS_EWIN + (size_t)EN * 4096 * 2;
constexpr size_t WS_EGATE = WS_EWOUT + SZ_SQ;
constexpr size_t WS_EPROJ = WS_EGATE + SZ_SQ;
constexpr size_t WS_OWIN = WS_EPROJ + SZ_WPROJ;
constexpr size_t WS_OWIN8 = WS_OWIN + (size_t)1792 * 4096 * 2;
constexpr size_t WS_OWUQ = WS_OWIN + (size_t)ON * 4096 * 2;
constexpr size_t WS_OWUK = WS_OWUQ + (size_t)QW * 1024 * 2;
constexpr size_t WS_OWUV = WS_OWUK + (size_t)512 * 4096 * 2;
constexpr size_t WS_OWOUT = WS_OWUV + (size_t)16 * 256 * 1024 * 2;
constexpr size_t WS_OGATE = WS_OWOUT + SZ_SQ;
constexpr size_t WS_OPROJ = WS_OGATE + SZ_SQ;
constexpr size_t WS_H = WS_OPROJ + SZ_WPROJ;
constexpr size_t WS_HBA = WS_H + (size_t)M * 4096 * 4;
constexpr size_t SZ_ACT = (size_t)M * 4096 * 2;
constexpr size_t WS_HBB = WS_HBA + SZ_ACT;
constexpr size_t WS_YIN = WS_HBB + SZ_ACT;
constexpr size_t WS_SCORE = WS_YIN;
constexpr size_t WS_PP = WS_YIN + SZ_ACT;
constexpr size_t WS_PB = WS_PP + SZ_ACT;
constexpr size_t WS_PROJ = WS_PB + (size_t)4 * M * 256 * 2;
constexpr size_t WS_CQN = WS_PROJ + (size_t)M * EN * 2;
constexpr size_t WS_LAT = WS_CQN + (size_t)M * 1024 * 2;
constexpr size_t WS_KIDX = WS_LAT + (size_t)M * 512 * 2;
constexpr size_t WS_WIDX = WS_KIDX + (size_t)M * 64 * 2;
constexpr size_t WS_SEL = WS_WIDX + (size_t)M * 32 * 4;
constexpr size_t WS_QBUF = WS_SEL + (size_t)M * 256 * 4;
constexpr size_t WS_QABS = WS_QBUF + (size_t)M * QW * 2;
constexpr size_t WS_OLAT = WS_QABS + (size_t)M * 16384 * 2;
constexpr size_t WS_HQ = WS_OLAT + (size_t)M * 16384 * 2;
constexpr size_t WS_ASCALE = WS_HQ + (size_t)M * 4096;
constexpr size_t WS_ASCALE1 = WS_ASCALE + (size_t)M * 4;
constexpr size_t WS_ASCALEY = WS_ASCALE1 + (size_t)M * 4;
constexpr size_t WS_YQ = WS_PROJ;
constexpr size_t WS_END = WS_ASCALEY + (size_t)M * 4;
static_assert(WS_END <= (size_t)4 * 2 * 4096 * 12816 * 4, "workspace map exceeds the guaranteed size (4 x the largest input)");

constexpr int LDS_BYTES = 155648;
constexpr int MISC_OFF = LDS_BYTES - 256;

__device__ __forceinline__ unsigned cvtpk(float lo, float hi) { f32x2 v = {lo, hi}; bf16x2_t b = __builtin_convertvector(v, bf16x2_t); return __builtin_bit_cast(unsigned, b); }
__device__ __forceinline__ float bf2f(unsigned short b) { return __uint_as_float(((unsigned)b) << 16); }
__device__ __forceinline__ float bflo(unsigned w) { return __uint_as_float(w << 16); }
__device__ __forceinline__ float bfhi(unsigned w) { return __uint_as_float(w & 0xffff0000u); }
__device__ __forceinline__ float wave_sum(float v) {
#pragma unroll
    for (int o = 1; o < 64; o <<= 1) v += __shfl_xor(v, o);
    return v;
}
__device__ __forceinline__ float xhalf_max(float m) { auto rr = __builtin_amdgcn_permlane32_swap(__float_as_uint(m), __float_as_uint(m), false, false); return fmaxf(__uint_as_float(rr[0]), __uint_as_float(rr[1])); }
__device__ __forceinline__ float xhalf_sum(float m) { auto rr = __builtin_amdgcn_permlane32_swap(__float_as_uint(m), __float_as_uint(m), false, false); return __uint_as_float(rr[0]) + __uint_as_float(rr[1]); }
__device__ __forceinline__ int lane_id_() { int l = (int)__builtin_amdgcn_mbcnt_hi(~0u, __builtin_amdgcn_mbcnt_lo(~0u, 0u)); asm volatile("" : "+v"(l)); return l; }
typedef unsigned long long u64;
__device__ __forceinline__ u64 ss_fix(float s2) { return (u64)(s2 * 16777216.0f); }
__device__ __forceinline__ float ss_rstd(u64 v) { return __builtin_amdgcn_rsqf((float)v * (1.0f / 16777216.0f) * (1.0f / 4096.0f) + EPS); }
__device__ __forceinline__ unsigned opaque_vu_(unsigned v) { asm volatile("" : "+v"(v)); return v; }
__device__ __forceinline__ u32x4 zero4_() { unsigned z = 0u; asm volatile("" : "+v"(z)); return (u32x4){z, z, z, z}; }
typedef int i32x4 __attribute__((ext_vector_type(4)));
constexpr float W8_SCALE = 1354.0f;
__device__ __forceinline__ int q8_(float v) { const int q = (int)__builtin_rintf(v); return q < -127 ? -127 : (q > 127 ? 127 : q); }
__device__ __forceinline__ unsigned pack4_q8_(float a, float b, float c, float d) { return (unsigned)(q8_(a) & 255) | ((unsigned)(q8_(b) & 255) << 8) | ((unsigned)(q8_(c) & 255) << 16) | ((unsigned)(q8_(d) & 255) << 24); }
__device__ __forceinline__ float fast_exp2(float x) { return __builtin_amdgcn_exp2f(x); }
__device__ __forceinline__ float sigmoidf_(float x) { return 1.0f / (1.0f + __expf(-x)); }
__device__ __forceinline__ float siluf_(float x) { return x / (1.0f + __expf(-x)); }
#define OPAQUE_S(p) do { unsigned long long _v = (unsigned long long)(p); unsigned _lo = (unsigned)_v, _hi = (unsigned)(_v >> 32); asm volatile("" : "+v"(_lo), "+v"(_hi)); \
    _lo = __builtin_amdgcn_readfirstlane(_lo); _hi = __builtin_amdgcn_readfirstlane(_hi); (p) = (decltype(p))(((unsigned long long)_hi << 32) | _lo); } while (0)
#define G1(T, p) ((GAS T*)(p))
#define CAS __attribute__((address_space(4)))
__device__ __forceinline__ const float* karg_in(int id) {
    const CAS char* kp = (const CAS char*)__builtin_amdgcn_kernarg_segment_ptr();
    asm volatile("" : "+s"(kp));
    return *(const float* const CAS*)(kp + 8 * id);
}
#define LDS_WAIT() asm volatile("s_waitcnt lgkmcnt(0)" ::: "memory")
#define VM_WAIT() asm volatile("s_waitcnt vmcnt(0)" ::: "memory")

#define XB_TMO      128
#define XB_XCNT(j)  (256  + 64 * (j))
#define XB_XSUB(j)  (1280 + 64 * (j))
#define XB_XGEN(j)  (2304 + 64 * (j))
#define XB_TOP      3328
#define XB_TOPGEN   3392
#define XCD_BAR_WORDS 3456
#define XB_SPIN_CAP (1u << 22)
__device__ __forceinline__ unsigned xb_ld(unsigned* p)              { return __hip_atomic_load((gu32*)p, __ATOMIC_RELAXED, __HIP_MEMORY_SCOPE_AGENT); }
__device__ __forceinline__ unsigned xb_add(unsigned* p, unsigned v) { return __hip_atomic_fetch_add((gu32*)p, v, __ATOMIC_RELAXED, __HIP_MEMORY_SCOPE_AGENT); }
__device__ __forceinline__ unsigned xb_xcc_id() { return (unsigned)__builtin_amdgcn_s_getreg((3 << 11) | 20) & 0xFu; }
#define XB_SPIN(cond, bar) do { unsigned _sp = 0; while (cond) { __builtin_amdgcn_s_sleep(1); \
    if ((++_sp & 255u) == 0u) { if (xb_ld(&(bar)[XB_TMO])) break; if (_sp > XB_SPIN_CAP) { (void)xb_add(&(bar)[XB_TMO], 1u); break; } } } } while (0)
struct XcdBarrier { unsigned* bar; unsigned x; volatile LAS unsigned* st; };
__device__ __forceinline__ XcdBarrier xcd_barrier_post(unsigned* bar, volatile LAS unsigned* st, const int wave) {
    XcdBarrier b; b.bar = bar; b.x = xb_xcc_id(); b.st = st;
    if (wave == 0 && lane_id_() == 0) (void)xb_add(&bar[XB_XCNT(b.x)], 1u);
    return b;
}
__device__ __forceinline__ void xcd_barrier_complete(unsigned* bar, unsigned x, unsigned& nloc, unsigned& nx) {
    const unsigned G = gridDim.x * gridDim.y * gridDim.z;
    unsigned sum, cnt, mine, sp = 0u;
    for (;;) {
        sum = 0u; cnt = 0u; mine = 0u;
#pragma unroll 1
        for (unsigned j = 0; j < 16; ++j) { const unsigned c = xb_ld(&bar[XB_XCNT(j)]); sum += c; cnt += (c > 0u) ? 1u : 0u; mine = (j == x) ? c : mine; }
        if (sum == G) break;
        __builtin_amdgcn_s_sleep(1);
        if ((++sp & 255u) == 0u) { if (xb_ld(&bar[XB_TMO])) break; if (sp > XB_SPIN_CAP) { (void)xb_add(&bar[XB_TMO], 1u); break; } }
    }
    nloc = mine > 0u ? mine : 1u; nx = cnt > 0u ? cnt : 1u;
}
__device__ __forceinline__ void xcd_barrier(const XcdBarrier& b, const int wave) {
    asm volatile("s_waitcnt vmcnt(0)" ::: "memory");
    __syncthreads();
    if (wave == 0 && lane_id_() == 0) {
        unsigned* bar = b.bar;
        __builtin_amdgcn_s_waitcnt(0);
        unsigned nloc = b.st[0], nx = b.st[1];
        if (nloc == 0u) { xcd_barrier_complete(bar, b.x, nloc, nx); b.st[0] = nloc; b.st[1] = nx; }
        const unsigned old = xb_add(&bar[XB_XSUB(b.x)], 1u);
        const unsigned gen = old / nloc;
        if (old + 1u == (gen + 1u) * nloc) {
            __builtin_amdgcn_fence(__ATOMIC_RELEASE, "agent");
            asm volatile("s_waitcnt vmcnt(0)" ::: "memory");
            const unsigned og = xb_add(&bar[XB_TOP], 1u);
            const unsigned tg = og / nx;
            if (og + 1u == (tg + 1u) * nx) xb_add(&bar[XB_TOPGEN], 1u);
            else XB_SPIN(xb_ld(&bar[XB_TOPGEN]) == tg, bar);
            __builtin_amdgcn_fence(__ATOMIC_ACQUIRE, "agent");
            xb_add(&bar[XB_XGEN(b.x)], 1u);
            asm volatile("s_waitcnt vmcnt(0)" ::: "memory");
        } else {
            XB_SPIN(xb_ld(&bar[XB_XGEN(b.x)]) == gen, bar);
            __builtin_amdgcn_fence(__ATOMIC_ACQUIRE, "agent");
            asm volatile("s_waitcnt vmcnt(0)" ::: "memory");
        }
    }
    __syncthreads();
}

namespace pg8 {
__device__ __forceinline__ void glds16_s(const void* sbase, unsigned voff, unsigned lds_dst) {
    unsigned keep;
    asm volatile("s_mov_b32 %0, m0\n\ts_mov_b32 m0, %3\n\ts_nop 0\n\tglobal_load_lds_dwordx4 %1, %2\n\ts_mov_b32 m0, %0" : "=&s"(keep) : "v"(voff), "s"(sbase), "s"(lds_dst) : "memory");
}
constexpr int BM = 256, BK = 64, HALF = 128, HTB = HALF * BK * 2, STAGE_BYTES = 8 * HTB, NXCD = 8, WGM = 8;
__host__ __device__ __forceinline__ int lds_byte(int r, int c) { const int st = (r >> 4) * 2 + (c >> 5), rr = r & 15, cc = c & 31, ob = rr * 64 + cc * 2; return st * 1024 + (ob ^ (((ob >> 9) & 1) << 5)); }
__host__ __device__ __forceinline__ void stage_rc(int b, int& R, int& C) { const int st = b / 1024, sb = b % 1024, swz = sb ^ (((sb >> 9) & 1) << 5); R = (st >> 1) * 16 + swz / 64; C = (st & 1) * 32 + (swz % 64) / 2; }
__host__ __device__ __forceinline__ int perm32(int rho) { const int n = rho >> 4, i = rho & 15; return 8 * (i >> 2) + 4 * n + (i & 3); }

struct Unit { int pm, pn, g; };
struct Gemm { const bf16_t* A; const bf16_t* Bt; int lda, ldb, K, nM, nN, ng; size_t gsA, gsB; };

struct Sched {
    int nM, nN, nwg, total, G, c;
    __device__ void init(const Gemm& g, int G_, int c_) { nM = g.nM; nN = g.nN; nwg = nM * nN; total = nwg * g.ng; G = G_; c = c_; }
    __device__ bool next(int i, Unit& u) const {
        const long L = (long)i * G + c; if (L >= total) return false;
        u.g = (int)(L / nwg); int wgid = (int)(L % nwg);
        { const int q = nwg / NXCD, r = nwg % NXCD, xcd = wgid % NXCD, off = wgid / NXCD; wgid = (xcd < r ? xcd * (q + 1) : r * (q + 1) + (xcd - r) * q) + off; }
        const int nig = WGM * nN, gid = wgid / nig, fm = gid * WGM, gsz = (nM - fm) < WGM ? (nM - fm) : WGM;
        u.pm = fm + ((wgid % nig) % gsz); u.pn = (wgid % nig) / gsz; return true;
    }
};

template <class Epi, bool I8 = false>
__device__ __forceinline__ void gemm_phase(LAS unsigned char* lds, const Gemm g, const Sched& S, const Epi& E, const int wid) {
    const int lane = lane_id_(), tid = wid * 64 + lane;
    const int wr = wid >> 2, wc = wid & 3, fr = lane & 15, fq = lane >> 4;
    const bf16_t* gA = g.A; const bf16_t* gB = g.Bt; OPAQUE_S(gA); OPAQUE_S(gB);
    constexpr int ESZ = I8 ? 1 : 2;
    const int K = g.K, nt = K * ESZ / (BK * 2);
    unsigned voffA[2], voffB[2];
#pragma unroll
    for (int i = 0; i < 2; ++i) { int R, C; stage_rc(tid * 16 + i * 8192, R, C); const int Rb = (R & ~31) + perm32(R & 31);
        voffA[i] = (unsigned)(R * g.lda * ESZ + C * 2); voffB[i] = (unsigned)(Rb * g.ldb * ESZ + C * 2); }
    const size_t kstep = (size_t)(BK * 2);
    const size_t hstepA = (size_t)HALF * g.lda * ESZ, hstepB = (size_t)HALF * g.ldb * ESZ;
    const size_t tstepA = 2 * hstepA, tstepB = 2 * hstepB;
    const unsigned ldsbase = (unsigned)(size_t)lds + (unsigned)wid * 1024u;
    const int aoff = lds_byte(wr * 64 + fr, fq * 8), boff = lds_byte(wc * 32 + fr, fq * 8);
#define PG8_SA(b, h) (((b) * 2 + (h)) * HTB)
#define PG8_SB(b, h) ((4 + (b) * 2 + (h)) * HTB)
#define PG8_STAGE(bufoff, gbase, voff) do { _Pragma("unroll") for (int _i = 0; _i < 2; ++_i) glds16_s((const void*)(gbase), (voff)[_i], ldsbase + (unsigned)((bufoff) + _i * 8192)); } while (0)
#define PG8_LDA(dst, b, h) do { _Pragma("unroll") for (int m = 0; m < 4; ++m) _Pragma("unroll") for (int k = 0; k < 2; ++k) dst[m][k] = *(const LAS bf16x8*)(lds + PG8_SA(b, h) + aoff + m * 2048 + k * 1024); } while (0)
#define PG8_LDB(dst, b, h) do { _Pragma("unroll") for (int n = 0; n < 2; ++n) _Pragma("unroll") for (int k = 0; k < 2; ++k) dst[n][k] = *(const LAS bf16x8*)(lds + PG8_SB(b, h) + boff + n * 2048 + k * 1024); } while (0)
#define PG8_MMA(ai, bj, At, Bt) do { __builtin_amdgcn_s_setprio(1); _Pragma("unroll") for (int m = 0; m < 4; ++m) _Pragma("unroll") for (int n = 0; n < 2; ++n) _Pragma("unroll") for (int k = 0; k < 2; ++k) { \
        if constexpr (I8) acc[ai][bj][m][n] = __builtin_bit_cast(f32x4, __builtin_amdgcn_mfma_i32_16x16x64_i8(__builtin_bit_cast(i32x4, Bt[n][k]), __builtin_bit_cast(i32x4, At[m][k]), __builtin_bit_cast(i32x4, acc[ai][bj][m][n]), 0, 0, 0)); \
        else acc[ai][bj][m][n] = __builtin_amdgcn_mfma_f32_16x16x32_bf16(Bt[n][k], At[m][k], acc[ai][bj][m][n], 0, 0, 0); } __builtin_amdgcn_s_setprio(0); } while (0)
#define PG8_WAIT_V(n) asm volatile("s_waitcnt vmcnt(" #n ")" ::: "memory")
#define PG8_WAIT_L(n) asm volatile("s_waitcnt lgkmcnt(" #n ")" ::: "memory")
#define PG8_BAR __builtin_amdgcn_s_barrier()
#define PG8_SCHED __builtin_amdgcn_sched_barrier(0)
    Unit cur, nxt; int ui = 0;
    if (!S.next(0, cur)) return;
    f32x4 acc[2][2][4][2];
#pragma unroll
    for (int a = 0; a < 2; ++a)
#pragma unroll
        for (int b = 0; b < 2; ++b)
#pragma unroll
            for (int m = 0; m < 4; ++m)
#pragma unroll
                for (int n = 0; n < 2; ++n) acc[a][b][m][n] = (f32x4){0.f, 0.f, 0.f, 0.f};
    bf16x8 At[4][2], B0[2][2], B1[2][2];
    const char* cA = (const char*)(gA + (size_t)cur.g * g.gsA) + (size_t)cur.pm * tstepA; const char* cB = (const char*)(gB + (size_t)cur.g * g.gsB) + (size_t)cur.pn * tstepB;
    PG8_STAGE(PG8_SB(0, 0), cB, voffB); PG8_STAGE(PG8_SB(0, 1), cB + hstepB, voffB); PG8_STAGE(PG8_SA(0, 0), cA, voffA); PG8_STAGE(PG8_SA(0, 1), cA + hstepA, voffA);
    if (wr == 1) PG8_BAR;
    PG8_WAIT_V(2); PG8_BAR;
    PG8_STAGE(PG8_SB(1, 0), cB + kstep, voffB); PG8_STAGE(PG8_SA(1, 0), cA + kstep, voffA); PG8_STAGE(PG8_SB(1, 1), cB + hstepB + kstep, voffB);
    PG8_WAIT_V(6); PG8_BAR;
    for (;;) {
        const bool has_next = S.next(ui + 1, nxt);
        const char* nA = has_next ? (const char*)(gA + (size_t)nxt.g * g.gsA) + (size_t)nxt.pm * tstepA : cA; const char* nB = has_next ? (const char*)(gB + (size_t)nxt.g * g.gsB) + (size_t)nxt.pn * tstepB : cB;
        for (int t = 0; t < nt; t += 2) {
            const bool last = (t == nt - 2);
            const char* a1 = cA + (size_t)(t + 1) * kstep;
            const char* a2 = last ? nA : cA + (size_t)(t + 2) * kstep; const char* b2 = last ? nB : cB + (size_t)(t + 2) * kstep;
            const char* a3 = a2 + kstep; const char* b3 = b2 + kstep;
            PG8_LDB(B0, 0, 0); PG8_LDB(B1, 0, 1); PG8_SCHED; PG8_LDA(At, 0, 0); PG8_STAGE(PG8_SA(1, 1), a1 + hstepA, voffA);
            PG8_WAIT_V(8); PG8_WAIT_L(0); PG8_BAR; PG8_MMA(0, 0, At, B0); PG8_MMA(0, 1, At, B1); PG8_BAR; PG8_SCHED;
            PG8_LDA(At, 0, 1); PG8_STAGE(PG8_SB(0, 0), b2, voffB); PG8_STAGE(PG8_SB(0, 1), b2 + hstepB, voffB); PG8_STAGE(PG8_SA(0, 0), a2, voffA);
            PG8_WAIT_V(8); PG8_WAIT_L(0); PG8_BAR; PG8_MMA(1, 0, At, B0); PG8_MMA(1, 1, At, B1); PG8_BAR; PG8_SCHED;
            PG8_LDB(B0, 1, 0); PG8_LDB(B1, 1, 1); PG8_SCHED; PG8_LDA(At, 1, 0); PG8_STAGE(PG8_SA(0, 1), a2 + hstepA, voffA);
            PG8_WAIT_V(8); PG8_WAIT_L(0); PG8_BAR; PG8_MMA(0, 0, At, B0); PG8_MMA(0, 1, At, B1); PG8_BAR; PG8_SCHED;
            PG8_LDA(At, 1, 1); PG8_STAGE(PG8_SB(1, 0), b3, voffB); PG8_STAGE(PG8_SB(1, 1), b3 + hstepB, voffB); PG8_STAGE(PG8_SA(1, 0), a3, voffA);
            PG8_WAIT_V(8); PG8_WAIT_L(0); PG8_BAR; PG8_MMA(1, 0, At, B0); PG8_MMA(1, 1, At, B1); PG8_BAR; PG8_SCHED;
        }
        if (wr == 0) PG8_BAR;
        { const int l2 = lane_id_(); E(acc, cur, wid >> 2, wid & 3, l2 & 15, l2 >> 4); }
        if (!has_next) break;
#pragma unroll
        for (int a = 0; a < 2; ++a)
#pragma unroll
            for (int b = 0; b < 2; ++b)
#pragma unroll
                for (int m = 0; m < 4; ++m)
#pragma unroll
                    for (int n = 0; n < 2; ++n) acc[a][b][m][n] = (f32x4){0.f, 0.f, 0.f, 0.f};
        cur = nxt; cA = nA; cB = nB; ++ui;
        if (wr == 1) PG8_BAR;
    }
    PG8_WAIT_V(0);
    PG8_BAR;
#undef PG8_SA
#undef PG8_SB
#undef PG8_STAGE
#undef PG8_LDA
#undef PG8_LDB
#undef PG8_MMA
#undef PG8_WAIT_V
#undef PG8_WAIT_L
#undef PG8_BAR
#undef PG8_SCHED
}

struct EpiBf16 {
    bf16_t* O; int ldc; size_t gsO; const u64* ss;
    __device__ __forceinline__ void operator()(const f32x4 (&acc)[2][2][4][2], const Unit& u, int wr, int wc, int fr, int fq) const {
        const int row0 = u.pm * BM + wr * 64 + fr, col0 = u.pn * BM + wc * 32 + 8 * fq;
        bf16_t* base = O + (size_t)u.g * gsO;
        u64 sv[2][4];
        if (ss) {
#pragma unroll
            for (int ai = 0; ai < 2; ++ai)
#pragma unroll
                for (int m = 0; m < 4; ++m) sv[ai][m] = *G1(const u64, ss + row0 + ai * HALF + m * 16);
            __builtin_amdgcn_sched_barrier(0); }
#pragma unroll
        for (int ai = 0; ai < 2; ++ai)
#pragma unroll
            for (int m = 0; m < 4; ++m) { const int row = row0 + ai * HALF + m * 16; bf16_t* rowp = base + (size_t)row * ldc + col0;
                const float sc = ss ? ss_rstd(sv[ai][m]) : 1.0f;
#pragma unroll
                for (int bj = 0; bj < 2; ++bj) { const f32x4 v0 = acc[ai][bj][m][0] * sc, v1 = acc[ai][bj][m][1] * sc;
                    u32x4 w; w.x = cvtpk(v0[0], v0[1]); w.y = cvtpk(v0[2], v0[3]); w.z = cvtpk(v1[0], v1[1]); w.w = cvtpk(v1[2], v1[3]);
                    *G1(u32x4, rowp + bj * HALF) = w; } }
    }
};
struct EpiBf16Q {
    bf16_t* O; int ldc; const u64* ss; const float* ascale; u64* kn; int dry;
    __device__ __forceinline__ void operator()(const f32x4 (&acc)[2][2][4][2], const Unit& u, int wr, int wc, int fr, int fq) const {
        const int row0 = u.pm * BM + wr * 64 + fr, col0 = u.pn * BM + wc * 32 + 8 * fq;
        const bool ktile = kn != nullptr && u.pn >= 8 && u.pn < 16;
        if (dry) { float t_ = 0.f;
#pragma unroll
            for (int ai = 0; ai < 2; ++ai)
#pragma unroll
                for (int bj = 0; bj < 2; ++bj)
#pragma unroll
                    for (int m = 0; m < 4; ++m) t_ += acc[ai][bj][m][0][0] + acc[ai][bj][m][1][3];
            if (t_ == 1.2345e38f) *G1(float, (float*)O) = t_; return; }
        u64 sv[2][4]; float av[2][4];
#pragma unroll
        for (int ai = 0; ai < 2; ++ai)
#pragma unroll
            for (int m = 0; m < 4; ++m) { const int row = row0 + ai * HALF + m * 16; sv[ai][m] = *G1(const u64, ss + row); av[ai][m] = *G1(const float, ascale + row); }
        __builtin_amdgcn_sched_barrier(0);
#pragma unroll
        for (int ai = 0; ai < 2; ++ai)
#pragma unroll
            for (int m = 0; m < 4; ++m) { const int row = row0 + ai * HALF + m * 16; bf16_t* rowp = O + (size_t)row * ldc + col0;
                const float sc = ss_rstd(sv[ai][m]) * av[ai][m] * (1.0f / W8_SCALE);
#pragma unroll
                for (int bj = 0; bj < 2; ++bj) { const i32x4 i0 = __builtin_bit_cast(i32x4, acc[ai][bj][m][0]), i1 = __builtin_bit_cast(i32x4, acc[ai][bj][m][1]);
                    const float f0 = (float)i0[0] * sc, f1 = (float)i0[1] * sc, f2 = (float)i0[2] * sc, f3 = (float)i0[3] * sc, f4 = (float)i1[0] * sc, f5 = (float)i1[1] * sc, f6 = (float)i1[2] * sc, f7 = (float)i1[3] * sc;
                    u32x4 w; w.x = cvtpk(f0, f1); w.y = cvtpk(f2, f3); w.z = cvtpk(f4, f5); w.w = cvtpk(f6, f7);
                    *G1(u32x4, rowp + bj * HALF) = w;
                    if (ktile) { float s2 = (f0 * f0 + f1 * f1) + (f2 * f2 + f3 * f3) + (f4 * f4 + f5 * f5) + (f6 * f6 + f7 * f7); s2 += __shfl_xor(s2, 16); s2 += __shfl_xor(s2, 32);
                        if (fq == 0) (void)__hip_atomic_fetch_add(G1(u64, kn + (size_t)((u.pn - 8) * 2 + bj) * M + row), ss_fix(s2), __ATOMIC_RELAXED, __HIP_MEMORY_SCOPE_AGENT); } } }
    }
};
struct EpiResid {
    const bf16_t* Hin; bf16_t* H; signed char* HQ; float* ascale; const u64* ssin; u64* ssout; const float* ascale_y;
    __device__ __forceinline__ void operator()(const f32x4 (&acc)[2][2][4][2], const Unit& u, int wr, int wc, int fr, int fq) const {
        const int row0 = u.pm * BM + wr * 64 + fr, col0 = u.pn * BM + wc * 32 + 8 * fq;
#pragma unroll
        for (int ai = 0; ai < 2; ++ai) {
        u32x4 hv[2][4][2]; u64 sv[2][4]; float yv[2][4];
#pragma unroll
            for (int m = 0; m < 4; ++m) { const int row = row0 + ai * HALF + m * 16; const bf16_t* hi = Hin + (size_t)row * DM + col0;
                sv[ai][m] = *G1(const u64, ssin + row); yv[ai][m] = *G1(const float, ascale_y + row);
#pragma unroll
                for (int bj = 0; bj < 2; ++bj) hv[ai][m][bj] = *G1(const u32x4, hi + bj * HALF); }
        __builtin_amdgcn_sched_barrier(0);
#pragma unroll
            for (int m = 0; m < 4; ++m) { const int row = row0 + ai * HALF + m * 16; bf16_t* hp = H + (size_t)row * DM + col0; signed char* bp = HQ + (size_t)row * DM + col0; float s2 = 0.f;
                const float qs = 15.875f * ss_rstd(sv[ai][m]);
                if (fq == 0 && wc == 0 && u.pn == 0) *G1(float, ascale + row) = 1.0f / qs;
                const float ys = yv[ai][m] * (1.0f / W8_SCALE);
#pragma unroll
                for (int bj = 0; bj < 2; ++bj) { const i32x4 i0 = __builtin_bit_cast(i32x4, acc[ai][bj][m][0]), i1 = __builtin_bit_cast(i32x4, acc[ai][bj][m][1]); const u32x4 hw = hv[ai][m][bj];
                    const f32x4 v0 = (f32x4){bflo(hw.x), bfhi(hw.x), bflo(hw.y), bfhi(hw.y)} + (f32x4){(float)i0[0], (float)i0[1], (float)i0[2], (float)i0[3]} * ys, v1 = (f32x4){bflo(hw.z), bfhi(hw.z), bflo(hw.w), bfhi(hw.w)} + (f32x4){(float)i1[0], (float)i1[1], (float)i1[2], (float)i1[3]} * ys;
                    { u32x4 w; w.x = cvtpk(v0[0], v0[1]); w.y = cvtpk(v0[2], v0[3]); w.z = cvtpk(v1[0], v1[1]); w.w = cvtpk(v1[2], v1[3]); *G1(u32x4, hp + bj * HALF) = w; }
                    s2 += (v0[0] * v0[0] + v0[1] * v0[1]) + (v0[2] * v0[2] + v0[3] * v0[3]) + (v1[0] * v1[0] + v1[1] * v1[1]) + (v1[2] * v1[2] + v1[3] * v1[3]);
                    u32x2 q; q.x = pack4_q8_(v0[0] * qs, v0[1] * qs, v0[2] * qs, v0[3] * qs); q.y = pack4_q8_(v1[0] * qs, v1[1] * qs, v1[2] * qs, v1[3] * qs);
                    *G1(u32x2, bp + bj * HALF) = q; }
                s2 += __shfl_xor(s2, 16); s2 += __shfl_xor(s2, 32);
                if (fq == 0) (void)__hip_atomic_fetch_add(G1(u64, ssout + row), ss_fix(s2), __ATOMIC_RELAXED, __HIP_MEMORY_SCOPE_AGENT); }
        __builtin_amdgcn_sched_barrier(0);
        }
    }
};
struct EpiGate {
    bf16_t* H; const bf16_t* PP; const u64* ssin; u64* ssout; signed char* HQ; float* ascale; const float* ascale_in;
    __device__ __forceinline__ void operator()(const f32x4 (&acc)[2][2][4][2], const Unit& u, int wr, int wc, int fr, int fq) const {
        const int row0 = u.pm * BM + wr * 64 + fr, col0 = u.pn * BM + wc * 32 + 8 * fq;
#pragma unroll
        for (int ai = 0; ai < 2; ++ai) {
            u32x4 hv[4][2], pv[4][2]; u64 sv[4]; float av[4];
#pragma unroll
            for (int m = 0; m < 4; ++m) { const int row = row0 + ai * HALF + m * 16; const bf16_t* hp = H + (size_t)row * DM + col0; const bf16_t* pp = PP + (size_t)row * DM + col0;
                sv[m] = *G1(const u64, ssin + row); av[m] = *G1(const float, ascale_in + row);
#pragma unroll
                for (int bj = 0; bj < 2; ++bj) { pv[m][bj] = *G1(const u32x4, pp + bj * HALF); hv[m][bj] = *G1(const u32x4, hp + bj * HALF); } }
            __builtin_amdgcn_sched_barrier(0);
#pragma unroll
            for (int m = 0; m < 4; ++m) { const int row = row0 + ai * HALF + m * 16; bf16_t* hp = H + (size_t)row * DM + col0;
                const float sc = ss_rstd(sv[m]); float s2 = 0.f;
                const float qs = 15.875f * sc;
                const float scq = sc * av[m] * (1.0f / W8_SCALE);
                if (HQ && fq == 0 && wc == 0 && u.pn == 0) *G1(float, ascale + row) = 1.0f / qs;
#pragma unroll
                for (int bj = 0; bj < 2; ++bj) { const u32x4 pw = pv[m][bj], hw = hv[m][bj];
                    f32x4 v0 = (f32x4){bflo(hw.x), bfhi(hw.x), bflo(hw.y), bfhi(hw.y)}, v1 = (f32x4){bflo(hw.z), bfhi(hw.z), bflo(hw.w), bfhi(hw.w)};
                    const i32x4 i0 = __builtin_bit_cast(i32x4, acc[ai][bj][m][0]), i1 = __builtin_bit_cast(i32x4, acc[ai][bj][m][1]);
                    const f32x4 a0 = (f32x4){(float)i0[0], (float)i0[1], (float)i0[2], (float)i0[3]} * scq, a1 = (f32x4){(float)i1[0], (float)i1[1], (float)i1[2], (float)i1[3]} * scq;
                    v0[0] += sigmoidf_(a0[0]) * bflo(pw.x); v0[1] += sigmoidf_(a0[1]) * bfhi(pw.x); v0[2] += sigmoidf_(a0[2]) * bflo(pw.y); v0[3] += sigmoidf_(a0[3]) * bfhi(pw.y);
                    v1[0] += sigmoidf_(a1[0]) * bflo(pw.z); v1[1] += sigmoidf_(a1[1]) * bfhi(pw.z); v1[2] += sigmoidf_(a1[2]) * bflo(pw.w); v1[3] += sigmoidf_(a1[3]) * bfhi(pw.w);
                    { u32x4 w; w.x = cvtpk(v0[0], v0[1]); w.y = cvtpk(v0[2], v0[3]); w.z = cvtpk(v1[0], v1[1]); w.w = cvtpk(v1[2], v1[3]); *G1(u32x4, hp + bj * HALF) = w; }
                    s2 += (v0[0] * v0[0] + v0[1] * v0[1]) + (v0[2] * v0[2] + v0[3] * v0[3]) + (v1[0] * v1[0] + v1[1] * v1[1]) + (v1[2] * v1[2] + v1[3] * v1[3]);
                    if (HQ) { u32x2 q; q.x = pack4_q8_(v0[0] * qs, v0[1] * qs, v0[2] * qs, v0[3] * qs); q.y = pack4_q8_(v1[0] * qs, v1[1] * qs, v1[2] * qs, v1[3] * qs); *G1(u32x2, HQ + (size_t)row * DM + col0 + bj * HALF) = q; } }
                s2 += __shfl_xor(s2, 16); s2 += __shfl_xor(s2, 32);
                if (fq == 0) (void)__hip_atomic_fetch_add(G1(u64, ssout + row), ss_fix(s2), __ATOMIC_RELAXED, __HIP_MEMORY_SCOPE_AGENT); }
            __builtin_amdgcn_sched_barrier(0);
        }
    }
};
struct EpiOGate {
    bf16_t* Y; const bf16_t* GC; int ldg;
    __device__ __forceinline__ void operator()(const f32x4 (&acc)[2][2][4][2], const Unit& u, int wr, int wc, int fr, int fq) const {
        const int row0 = u.pm * BM + wr * 64 + fr, col0 = u.g * 256 + wc * 32 + 8 * fq;
        u32x4 gv[2][4][2];
#pragma unroll
        for (int ai = 0; ai < 2; ++ai)
#pragma unroll
            for (int m = 0; m < 4; ++m) { const int row = row0 + ai * HALF + m * 16; const bf16_t* gp = GC + (size_t)row * ldg + col0;
#pragma unroll
                for (int bj = 0; bj < 2; ++bj) gv[ai][m][bj] = *G1(const u32x4, gp + bj * HALF); }
        __builtin_amdgcn_sched_barrier(0);
#pragma unroll
        for (int ai = 0; ai < 2; ++ai)
#pragma unroll
            for (int m = 0; m < 4; ++m) { const int row = row0 + ai * HALF + m * 16; bf16_t* yp = Y + (size_t)row * DM + col0;
#pragma unroll
                for (int bj = 0; bj < 2; ++bj) { const u32x4 gw = gv[ai][m][bj]; const f32x4 a0 = acc[ai][bj][m][0], a1 = acc[ai][bj][m][1];
                    u32x4 w; w.x = cvtpk(a0[0] * siluf_(bflo(gw.x)), a0[1] * siluf_(bfhi(gw.x))); w.y = cvtpk(a0[2] * siluf_(bflo(gw.y)), a0[3] * siluf_(bfhi(gw.y)));
                    w.z = cvtpk(a1[0] * siluf_(bflo(gw.z)), a1[1] * siluf_(bfhi(gw.z))); w.w = cvtpk(a1[2] * siluf_(bflo(gw.w)), a1[3] * siluf_(bfhi(gw.w)));
                    *G1(u32x4, yp + bj * HALF) = w; } }
    }
};
}

struct Args { const float* in[22]; float* out; unsigned char* ws; int ph_lo, ph_hi; };
enum { I_X = 0, I_P, I_T5, I_NORMG, I_EWIN, I_EBF, I_ESINK, I_EWOUT, I_OWIN, I_OQNG, I_OKVNG, I_OWUQ, I_OWUQI, I_OLNG, I_OLNB, I_OWUK, I_OWUV, I_OWOUT, I_PWPROJ, I_PNORMG, I_PWGATE, I_FINALG };


__device__ __forceinline__ unsigned off_b(unsigned row, unsigned ch) { return 256u * row + 16u * (ch ^ (((row & 3) << 2) | ((row >> 2) & 3))); }
__device__ __forceinline__ s16x4 vtr(LAS const unsigned char* p) { return __builtin_bit_cast(s16x4, __builtin_amdgcn_ds_read_tr16_b64_v4i16((LAS v4i16_t*)p)); }
__device__ __forceinline__ bf16x8 pack8(const f32x16& s, int o) {
    u32x4 w; w.x = cvtpk(s[o + 0], s[o + 1]); w.y = cvtpk(s[o + 2], s[o + 3]); w.z = cvtpk(s[o + 4], s[o + 5]); w.w = cvtpk(s[o + 6], s[o + 7]);
    return __builtin_bit_cast(bf16x8, w);
}
template <int NSB, int NOB>
__device__ __forceinline__ void sm_step(f32x16 (&s)[NSB], float& m, float& l, f32x16 (&o)[NOB], bf16x8 (&p)[NSB][2]) {
    float mx = s[0][0];
#pragma unroll
    for (int b = 0; b < NSB; ++b)
#pragma unroll
        for (int r = 0; r < 16; ++r) mx = fmaxf(mx, s[b][r]);
    mx = xhalf_max(mx);
    if (__any(mx > m + 8.0f)) {
        const float mn = fmaxf(m, mx), alpha = fast_exp2(m - mn);
        l *= alpha; m = mn;
#pragma unroll
        for (int c = 0; c < NOB; ++c) o[c] = o[c] * alpha;
    }
    float sum = 0.f;
#pragma unroll
    for (int b = 0; b < NSB; ++b)
#pragma unroll
        for (int r = 0; r < 16; ++r) { s[b][r] = fast_exp2(s[b][r] - m); sum += s[b][r]; }
    sum = xhalf_sum(sum);
    l += sum;
#pragma unroll
    for (int b = 0; b < NSB; ++b) { p[b][0] = pack8(s[b], 0); p[b][1] = pack8(s[b], 8); }
}
__device__ __forceinline__ unsigned vt_addr(int lane, int krow0, int c, int t) {
    const unsigned h = lane >> 5, blk = (lane >> 4) & 1, q = (lane & 15) >> 2, p = lane & 3;
    return off_b(krow0 + 8 * t + 4 * h + q, 4 * c + 2 * blk + (p >> 1)) + 8 * (p & 1);
}
__device__ __forceinline__ bf16x8 vfrag(LAS const unsigned char* img, int lane, int krow0, int c) {
    const s16x4 lo = vtr(img + vt_addr(lane, krow0, c, 0)), hi = vtr(img + vt_addr(lane, krow0, c, 1));
    return (bf16x8){lo[0], lo[1], lo[2], lo[3], hi[0], hi[1], hi[2], hi[3]};
}
__device__ __forceinline__ unsigned krow_base(int lane) { const unsigned r = lane & 31, h = lane >> 5, x = ((r & 3) << 2) | ((r >> 2) & 3); return 256u * r + 16u * ((x & 14u) | (h ^ (x & 1u))); }
__device__ __forceinline__ unsigned vt_base(int lane) { const unsigned h = lane >> 5, blk = (lane >> 4) & 1, q = (lane & 15) >> 2, p = lane & 3; const unsigned low0 = (2 * blk + (p >> 1)) ^ h;
    return 256u * (4 * h + q) + 64u * q + 16u * low0 + 8u * (p & 1); }
__device__ __forceinline__ bf16x8 vfrag2(LAS const unsigned char* img, unsigned vb, int c, int imm) {
    const unsigned a0 = vb ^ (unsigned)(c << 6);
    const s16x4 lo = vtr(img + a0 + imm), hi = vtr(img + (a0 ^ 32u) + imm + 2048);
    return (bf16x8){lo[0], lo[1], lo[2], lo[3], hi[0], hi[1], hi[2], hi[3]};
}
__device__ __forceinline__ float log_sigmoid_(float x) { return x > 0.f ? -log1pf(expf(-x)) : x - log1pf(expf(x)); }

constexpr int FOX_KV = 0, FOX_CUM = 65536, FOX_SCAN = FOX_CUM + 16384, FOX_KMAX = FOX_SCAN + 64, FOX_FLAGS = FOX_SCAN + 128;
constexpr float FOX_SKIP_LOG2 = 64.0f;
template <int CTRL> __device__ __forceinline__ float dpp_(float v) { return __int_as_float(__builtin_amdgcn_update_dpp(0, __float_as_int(v), CTRL, 0xF, 0xF, true)); }
__device__ __forceinline__ float row16_sum(float s) { s += dpp_<0xB1>(s); s += dpp_<0x4E>(s); s += dpp_<0x141>(s); s += dpp_<0x140>(s); return s; }
__device__ __forceinline__ float wave_max_u(float v) {
    v = fmaxf(v, dpp_<0xB1>(v)); v = fmaxf(v, dpp_<0x4E>(v)); v = fmaxf(v, dpp_<0x141>(v)); v = fmaxf(v, dpp_<0x140>(v));
    const float a0 = __int_as_float(__builtin_amdgcn_readlane(__float_as_int(v), 0)), a1 = __int_as_float(__builtin_amdgcn_readlane(__float_as_int(v), 16));
    const float a2 = __int_as_float(__builtin_amdgcn_readlane(__float_as_int(v), 32)), a3 = __int_as_float(__builtin_amdgcn_readlane(__float_as_int(v), 48));
    return fmaxf(fmaxf(a0, a1), fmaxf(a2, a3));
}
__device__ __forceinline__ void fox_scan(const GAS bf16_t* proj, const GAS u64* kn, const GAS float* bfp, int b, int hd, LAS unsigned char* lds, int tid, int lane, int wave) {
    LAS float* cumL = (LAS float*)(lds + FOX_CUM); LAS float* scanL = (LAS float*)(lds + FOX_SCAN); LAS float* kmaxL = (LAS float*)(lds + FOX_KMAX);
    const float bias = bfp[hd]; float v[8]; float run = 0.f;
#pragma unroll
    for (int i = 0; i < 8; ++i) { const float f = bf2f(proj[(size_t)(b * SEQ + 8 * tid + i) * EN + E_FA + hd]); run += log_sigmoid_(f + bias); v[i] = run; }
    float inc = run;
#pragma unroll
    for (int o = 1; o < 64; o <<= 1) { const float t = __shfl_up(inc, o); if (lane >= o) inc += t; }
    float kq = 0.f;
    { const GAS u64* kp = kn + (size_t)hd * M + (size_t)b * SEQ + 8 * tid;
#pragma unroll
      for (int i = 0; i < 8; ++i) kq = fmaxf(kq, (float)kp[i] * (1.0f / 16777216.0f)); }
    kq = wave_max_u(kq);
    if (lane == 63) scanL[wave] = inc;
    if (lane == 0) scanL[8 + wave] = kq;
    __syncthreads();
    float wbase = 0.f, km = 0.f;
#pragma unroll
    for (int w = 0; w < 8; ++w) { const float t = scanL[w]; if (w < wave) wbase += t; km = fmaxf(km, scanL[8 + w]); }
    const float excl = wbase + inc - run;
#pragma unroll
    for (int i = 0; i < 8; ++i) cumL[8 * tid + i] = -(excl + v[i]) * LOG2E;
    if (tid == 0) kmaxL[0] = sqrtf(km) * 1.005f;
    __syncthreads();
}
__device__ __forceinline__ void fox_unit(const GAS bf16_t* proj, GAS bf16_t* yin, int b, int hd, int qb, LAS unsigned char* lds, int tid, int lane, int wave) {
    const LAS float* cumL = (const LAS float*)(lds + FOX_CUM); volatile LAS int* flags = (volatile LAS int*)(lds + FOX_FLAGS);
    const int t0 = 256 * qb, q0 = t0 + 32 * wave, qme = q0 + (lane & 31), h = lane >> 5;
    const size_t rowb = (size_t)b * SEQ;
    const float cs = 0.08838834764831845f * LOG2E;
    const unsigned kbase = krow_base(lane), vbase = vt_base(lane);
    bf16x8 qf[8];
    { const GAS bf16_t* qp = proj + (rowb + qme) * EN + E_QA + hd * 128 + 8 * h;
#pragma unroll
      for (int s = 0; s < 8; ++s) qf[s] = *(const GAS bf16x8*)(qp + 16 * s); }
    float qn2 = 0.f;
#pragma unroll
    for (int s = 0; s < 8; ++s)
#pragma unroll
        for (int e = 0; e < 8; ++e) { const float x = bf2f((unsigned short)qf[s][e]); qn2 += x * x; }
    qn2 = xhalf_sum(qn2);
    const float cbound = sqrtf(qn2) * 1.0001f * ((const LAS float*)(lds + FOX_KMAX))[0] * cs;
    f32x16 o[4];
#pragma unroll
    for (int c = 0; c < 4; ++c)
#pragma unroll
        for (int r = 0; r < 16; ++r) o[c][r] = 0.f;
    float m = -1e30f, l = 0.f;
    const int ntile = 4 * (qb + 1);
    const int r0 = tid >> 4, c0 = tid & 15;
    const GAS bf16_t* kg = proj + (rowb + r0) * EN + E_KA + hd * 128 + c0 * 8;
    const GAS bf16_t* vg = proj + (rowb + r0) * EN + E_VA + hd * 128 + c0 * 8;
    const unsigned so0 = off_b(r0, c0), so1 = off_b(r0 + 32, c0);
    u32x4 sk0, sk1, sv0, sv1;
    { const size_t adv = (size_t)64 * (ntile - 1) * EN; sk0 = *(const GAS u32x4*)(kg + adv); sk1 = *(const GAS u32x4*)(kg + adv + (size_t)32 * EN); sv0 = *(const GAS u32x4*)(vg + adv); sv1 = *(const GAS u32x4*)(vg + adv + (size_t)32 * EN); }
    __syncthreads();
    { LAS unsigned char* kb = lds + FOX_KV; *(LAS u32x4*)(kb + so0) = sk0; *(LAS u32x4*)(kb + so1) = sk1; *(LAS u32x4*)(kb + 16384 + so0) = sv0; *(LAS u32x4*)(kb + 16384 + so1) = sv1; }
    __syncthreads();
    bool done_w = false;
    for (int it = 0; it < ntile; ++it) {
        const int kt = ntile - 1 - it, cur = it & 1; const LAS unsigned char* Kt = lds + FOX_KV + cur * 32768; const LAS unsigned char* Vt = Kt + 16384;
        const bool more = kt > 0;
        if (more) { const size_t adv = (size_t)64 * (kt - 1) * EN; sk0 = *(const GAS u32x4*)(kg + adv); sk1 = *(const GAS u32x4*)(kg + adv + (size_t)32 * EN); sv0 = *(const GAS u32x4*)(vg + adv); sv1 = *(const GAS u32x4*)(vg + adv + (size_t)32 * EN); }
        const int k0 = 64 * kt;
        if (k0 <= q0 + 31 && !done_w) {
            f32x16 sc[2];
#pragma unroll
            for (int kb = 0; kb < 2; ++kb) {
#pragma unroll
                for (int r = 0; r < 16; ++r) sc[kb][r] = 0.f;
#pragma unroll
                for (int s = 0; s < 8; ++s) { const bf16x8 a = *(const LAS bf16x8*)(Kt + (kbase ^ (unsigned)(s << 5)) + 8192 * kb); sc[kb] = __builtin_amdgcn_mfma_f32_32x32x16_bf16(a, qf[s], sc[kb], 0, 0, 0); }
            }
            const bool diag = (k0 + 63 > q0);
#pragma unroll
            for (int kb = 0; kb < 2; ++kb)
#pragma unroll
                for (int g4 = 0; g4 < 4; ++g4) { const int key0 = k0 + 32 * kb + 8 * g4 + 4 * h; const f32x4 nb = *(const LAS f32x4*)(cumL + key0);
#pragma unroll
                    for (int e = 0; e < 4; ++e) { float v = sc[kb][4 * g4 + e] * cs + nb[e]; if (diag && (key0 + e > qme)) v = -1e30f; sc[kb][4 * g4 + e] = v; } }
            bf16x8 p[2][2];
            sm_step<2, 4>(sc, m, l, o, p);
#pragma unroll
            for (int c = 0; c < 4; ++c)
#pragma unroll
                for (int kb = 0; kb < 2; ++kb)
#pragma unroll
                    for (int s = 0; s < 2; ++s) { const bf16x8 a = vfrag2(Vt, vbase, c, 256 * (32 * kb + 16 * s)); o[c] = __builtin_amdgcn_mfma_f32_32x32x16_bf16(a, p[kb][s], o[c], 0, 0, 0); }
            if (more) { const float amax = wave_max_u(cbound - m); done_w = (amax + cumL[k0 - 1] < -FOX_SKIP_LOG2); }
        }
        if (lane == 0) flags[cur * 8 + wave] = done_w ? 1 : 0;
        if (more) { LAS unsigned char* kb = lds + FOX_KV + (cur ^ 1) * 32768; *(LAS u32x4*)(kb + so0) = sk0; *(LAS u32x4*)(kb + so1) = sk1; *(LAS u32x4*)(kb + 16384 + so0) = sv0; *(LAS u32x4*)(kb + 16384 + so1) = sv1; }
        __syncthreads();
        int alld = 1;
#pragma unroll
        for (int w = 0; w < 8; ++w) alld &= flags[cur * 8 + w];
        if (alld) break;
    }
    const float il = 1.0f / l;
    const GAS bf16_t* gp = proj + (rowb + qme) * EN + E_GA + hd * 128 + 4 * h; GAS bf16_t* yp = yin + (rowb + qme) * DM + hd * 128 + 4 * h;
#pragma unroll
    for (int c = 0; c < 4; ++c)
#pragma unroll
        for (int g4 = 0; g4 < 4; ++g4) { const u32x2 gw = *(const GAS u32x2*)(gp + 32 * c + 8 * g4);
            u32x2 w; w.x = cvtpk(o[c][4 * g4 + 0] * il * siluf_(bflo(gw.x)), o[c][4 * g4 + 1] * il * siluf_(bfhi(gw.x))); w.y = cvtpk(o[c][4 * g4 + 2] * il * siluf_(bflo(gw.y)), o[c][4 * g4 + 3] * il * siluf_(bfhi(gw.y)));
            *(GAS u32x2*)(yp + 32 * c + 8 * g4) = w; }
}

constexpr int SWA_K = 0, SWA_V = 65536, SWA_TB = 131072;
__device__ __forceinline__ int t5_bucket_(int rel) {
    if (rel < 16) return rel;
    if (rel >= 128) return 31;
    const int v = 16 + (int)(logf((float)rel * (1.0f / 16.0f)) / 2.0794415416798357f * 16.0f);
    return v < 31 ? v : 31;
}
__device__ __forceinline__ void swa_unit(const GAS bf16_t* proj, GAS bf16_t* yin, const GAS float* t5, const GAS float* sinks, int b, int nb, int kvh, LAS unsigned char* lds, int tid, int lane, int wave) {
    const size_t rowb = (size_t)b * SEQ; const int hq = kvh * 8 + wave, h = lane >> 5;
    __syncthreads();
#pragma unroll
    for (int i = 0; i < 4; ++i) { const int c = tid + 512 * i, row = c >> 3, ch = c & 7; const int key = 128 * (nb - 1) + row;
        u32x4 kv = zero4_(), vv = kv;
        if (key >= 0) { const GAS bf16_t* src = proj + (rowb + key) * EN + kvh * 64 + ch * 8; kv = *(const GAS u32x4*)(src + E_KB); vv = *(const GAS u32x4*)(src + E_VB); }
        *(LAS u32x4*)(lds + SWA_K + off_b(row, ch)) = kv; *(LAS u32x4*)(lds + SWA_V + off_b(row, ch)) = vv; }
    LAS float* tb = (LAS float*)(lds + SWA_TB + wave * 512);
#pragma unroll
    for (int i = 0; i < 2; ++i) { const int rel = lane + 64 * i; tb[rel] = t5[t5_bucket_(rel) * 64 + hq] * LOG2E; }
    __syncthreads();
    const float cs = 0.125f * LOG2E, sink2 = sinks[hq] * LOG2E;
    const unsigned kbase = krow_base(lane), vbase = vt_base(lane);
    bf16x8 qf[4], qn[4];
    { const GAS bf16_t* qp = proj + (rowb + 128 * nb + (lane & 31)) * EN + E_QB + hq * 64 + 8 * h;
#pragma unroll
      for (int s = 0; s < 4; ++s) qf[s] = *(const GAS bf16x8*)(qp + 16 * s); }
    for (int cg = 0; cg < 4; ++cg) {
        const int qi = 32 * cg + (lane & 31); const size_t row = rowb + 128 * nb + qi;
        u32x2 gwv[2][4];
        { const GAS bf16_t* gp_ = proj + row * EN + E_GB + hq * 64 + 4 * h;
#pragma unroll
          for (int c = 0; c < 2; ++c)
#pragma unroll
              for (int g4 = 0; g4 < 4; ++g4) gwv[c][g4] = *(const GAS u32x2*)(gp_ + 32 * c + 8 * g4); }
        if (cg < 3) { const GAS bf16_t* qp = proj + (row + 32) * EN + E_QB + hq * 64 + 8 * h;
#pragma unroll
          for (int s = 0; s < 4; ++s) qn[s] = *(const GAS bf16x8*)(qp + 16 * s); }
        f32x16 o[2];
#pragma unroll
        for (int c = 0; c < 2; ++c)
#pragma unroll
            for (int r = 0; r < 16; ++r) o[c][r] = 0.f;
        float m = sink2, l = 1.0f;
        for (int kb = cg; kb < cg + 5; ++kb) {
            f32x16 sc[1];
#pragma unroll
            for (int r = 0; r < 16; ++r) sc[0][r] = 0.f;
#pragma unroll
            for (int s = 0; s < 4; ++s) { const bf16x8 a = *(const LAS bf16x8*)(lds + SWA_K + (kbase ^ (unsigned)(s << 5)) + 8192 * kb); sc[0] = __builtin_amdgcn_mfma_f32_32x32x16_bf16(a, qf[s], sc[0], 0, 0, 0); }
#pragma unroll
            for (int r = 0; r < 16; ++r) { const int kj = 32 * kb + (r & 3) + 8 * (r >> 2) + 4 * h, rel = qi + 128 - kj;
                const bool valid = (rel >= 0) && (rel < 128) && (nb > 0 || kj >= 128);
                const float bias = tb[rel & 127];
                sc[0][r] = sc[0][r] * cs + bias + (valid ? 0.f : -1e30f); }
            bf16x8 p[1][2];
            sm_step<1, 2>(sc, m, l, o, p);
#pragma unroll
            for (int c = 0; c < 2; ++c)
#pragma unroll
                for (int s = 0; s < 2; ++s) { const bf16x8 a = vfrag2(lds + SWA_V + 8192 * kb, vbase, c, 4096 * s); o[c] = __builtin_amdgcn_mfma_f32_32x32x16_bf16(a, p[0][s], o[c], 0, 0, 0); }
        }
        const float il = 1.0f / l;
        GAS bf16_t* yp = yin + row * DM + 2048 + hq * 64 + 4 * h;
#pragma unroll
        for (int c = 0; c < 2; ++c)
#pragma unroll
            for (int g4 = 0; g4 < 4; ++g4) { const u32x2 gw = gwv[c][g4];
                u32x2 w; w.x = cvtpk(o[c][4 * g4 + 0] * il * siluf_(bflo(gw.x)), o[c][4 * g4 + 1] * il * siluf_(bfhi(gw.x))); w.y = cvtpk(o[c][4 * g4 + 2] * il * siluf_(bflo(gw.y)), o[c][4 * g4 + 3] * il * siluf_(bfhi(gw.y)));
                *(GAS u32x2*)(yp + 32 * c + 8 * g4) = w; }
#pragma unroll
        for (int s = 0; s < 4; ++s) qf[s] = qn[s];
    }
}
__device__ __forceinline__ void phase_even_attn(const Args& a, int j, LAS unsigned char* lds, int G, int bx, const int wave, const int which) {
    const int lane = lane_id_(), tid = wave * 64 + lane;
    unsigned char* ws_ = a.ws; OPAQUE_S(ws_); GAS unsigned char* ws = (GAS unsigned char*)ws_;
    const GAS bf16_t* proj = (const GAS bf16_t*)(ws + WS_PROJ); GAS bf16_t* yin = (GAS bf16_t*)(ws + WS_YIN);
    if (which & 1) for (int u = bx; u < 256; u += G) {
        const int b = u >> 7, hd = (u >> 3) & 15, i = u & 7;
        __syncthreads();
        fox_scan(proj, (const GAS u64*)(ws + WS_KN) + (size_t)j * 16 * M, ((const GAS float*)karg_in(I_EBF)) + j * 16, b, hd, lds, tid, lane, wave);
        fox_unit(proj, yin, b, hd, 15 - i, lds, tid, lane, wave);
        fox_unit(proj, yin, b, hd, i, lds, tid, lane, wave);
    }
    if (which & 2) for (int u = bx; u < 256; u += G) {
        const int b = u >> 7, nb = (u >> 2) & 31, kvh = u & 3;
        swa_unit(proj, yin, ((const GAS float*)karg_in(I_T5)), ((const GAS float*)karg_in(I_ESINK)) + j * 32, b, nb, kvh, lds, tid, lane, wave);
    }
    __syncthreads();
}

#define BAR_LDS() asm volatile("s_waitcnt lgkmcnt(0)\n\ts_barrier" ::: "memory")
__device__ __forceinline__ void phase_odd_norms(const Args& a, int j, int gw, int NGW) {
    const int lane = lane_id_();
    unsigned char* ws_ = a.ws; OPAQUE_S(ws_); GAS unsigned char* ws = (GAS unsigned char*)ws_;
    const GAS bf16_t* proj = (const GAS bf16_t*)(ws + WS_PROJ); GAS bf16_t* cqn = (GAS bf16_t*)(ws + WS_CQN); GAS bf16_t* lat = (GAS bf16_t*)(ws + WS_LAT); GAS bf16_t* kidx = (GAS bf16_t*)(ws + WS_KIDX); GAS float* widx = (GAS float*)(ws + WS_WIDX);
    const GAS float* qg = ((const GAS float*)karg_in(I_OQNG)) + j * 1024; const GAS float* kvg = ((const GAS float*)karg_in(I_OKVNG)) + j * 512; const GAS float* lng = ((const GAS float*)karg_in(I_OLNG)) + j * 64; const GAS float* lnb = ((const GAS float*)karg_in(I_OLNB)) + j * 64;
    for (int row = gw; row < M; row += NGW) {
        const GAS bf16_t* pr = proj + (size_t)row * ON;
        {
            const u32x4 w0 = *(const GAS u32x4*)(pr + O_CQ + lane * 8), w1 = *(const GAS u32x4*)(pr + O_CQ + 512 + lane * 8);
            float v[16] = {bflo(w0.x), bfhi(w0.x), bflo(w0.y), bfhi(w0.y), bflo(w0.z), bfhi(w0.z), bflo(w0.w), bfhi(w0.w), bflo(w1.x), bfhi(w1.x), bflo(w1.y), bfhi(w1.y), bflo(w1.z), bfhi(w1.z), bflo(w1.w), bfhi(w1.w)};
            float ss = 0.f;
#pragma unroll
            for (int i = 0; i < 16; ++i) ss += v[i] * v[i];
            ss = wave_sum(ss); const float r = 1.0f / sqrtf(ss * (1.0f / 1024.0f) + EPS);
            const f32x4 g0 = *(const GAS f32x4*)(qg + lane * 8), g1 = *(const GAS f32x4*)(qg + lane * 8 + 4), g2 = *(const GAS f32x4*)(qg + 512 + lane * 8), g3 = *(const GAS f32x4*)(qg + 512 + lane * 8 + 4);
            u32x4 o0, o1;
            o0.x = cvtpk(v[0] * r * g0[0], v[1] * r * g0[1]); o0.y = cvtpk(v[2] * r * g0[2], v[3] * r * g0[3]); o0.z = cvtpk(v[4] * r * g1[0], v[5] * r * g1[1]); o0.w = cvtpk(v[6] * r * g1[2], v[7] * r * g1[3]);
            o1.x = cvtpk(v[8] * r * g2[0], v[9] * r * g2[1]); o1.y = cvtpk(v[10] * r * g2[2], v[11] * r * g2[3]); o1.z = cvtpk(v[12] * r * g3[0], v[13] * r * g3[1]); o1.w = cvtpk(v[14] * r * g3[2], v[15] * r * g3[3]);
            *(GAS u32x4*)(cqn + (size_t)row * 1024 + lane * 8) = o0; *(GAS u32x4*)(cqn + (size_t)row * 1024 + 512 + lane * 8) = o1;
        }
        {
            const u32x4 w0 = *(const GAS u32x4*)(pr + O_CKV + lane * 8);
            float v[8] = {bflo(w0.x), bfhi(w0.x), bflo(w0.y), bfhi(w0.y), bflo(w0.z), bfhi(w0.z), bflo(w0.w), bfhi(w0.w)};
            float ss = 0.f;
#pragma unroll
            for (int i = 0; i < 8; ++i) ss += v[i] * v[i];
            ss = wave_sum(ss); const float r = 1.0f / sqrtf(ss * (1.0f / 512.0f) + EPS);
            const f32x4 g0 = *(const GAS f32x4*)(kvg + lane * 8), g1 = *(const GAS f32x4*)(kvg + lane * 8 + 4);
            u32x4 o0; o0.x = cvtpk(v[0] * r * g0[0], v[1] * r * g0[1]); o0.y = cvtpk(v[2] * r * g0[2], v[3] * r * g0[3]); o0.z = cvtpk(v[4] * r * g1[0], v[5] * r * g1[1]); o0.w = cvtpk(v[6] * r * g1[2], v[7] * r * g1[3]);
            *(GAS u32x4*)(lat + (size_t)row * 512 + lane * 8) = o0;
        }
        {
            const float x = bf2f(pr[O_KIDX + lane]); const float mu = wave_sum(x) * (1.0f / 64.0f); const float xc = x - mu; const float var = wave_sum(xc * xc) * (1.0f / 64.0f);
            const float y = xc * (1.0f / sqrtf(var + EPS)) * lng[lane] + lnb[lane];
            kidx[(size_t)row * 64 + lane] = (bf16_t)(cvtpk(y, 0.f) & 0xffffu);
        }
        if (lane < 32) widx[(size_t)row * 32 + lane] = bf2f(pr[O_WIDX + lane]) * 0.022097086912079608f;
    }
}

__device__ __forceinline__ unsigned sortable_(float f) { const unsigned u = __float_as_uint(f); return (u & 0x80000000u) ? ~u : (u | 0x80000000u); }
__device__ __forceinline__ int wave_isum(int v) {
#pragma unroll
    for (int o = 1; o < 64; o <<= 1) v += __shfl_xor(v, o);
    return v;
}
__device__ __forceinline__ void topk_row(const GAS float* srow, GAS int* sel, int t, int lane) {
    const int nvalid = t + 1;
    if (nvalid <= 256) {
#pragma unroll
        for (int i = 0; i < 4; ++i) sel[64 * i + lane] = (64 * i + lane < nvalid) ? 64 * i + lane : 0;
        return;
    }
    unsigned key[64];
    const int ngrp = (nvalid + 511) >> 9;
#pragma unroll
    for (int g = 0; g < 8; ++g) {
        if (g < ngrp) {
#pragma unroll
            for (int i = 8 * g; i < 8 * g + 8; ++i) key[i] = __float_as_uint(srow[64 * i + lane]);
        }
    }
    __builtin_amdgcn_sched_barrier(0);
#pragma unroll
    for (int g = 0; g < 8; ++g) {
        if (g < ngrp) {
#pragma unroll
            for (int i = 8 * g; i < 8 * g + 8; ++i) { const int e = 64 * i + lane; key[i] = (e < nvalid) ? sortable_(__uint_as_float(key[i])) : 0u; }
        } else {
#pragma unroll
            for (int i = 8 * g; i < 8 * g + 8; ++i) key[i] = 0u;
        }
    }
    unsigned kmx = 0u, kmn1 = 0xFFFFFFFFu;
#pragma unroll
    for (int g = 0; g < 8; ++g) {
        if (g < ngrp) {
#pragma unroll
            for (int i = 8 * g; i < 8 * g + 8; ++i) { kmx = kmx > key[i] ? kmx : key[i]; const unsigned k1 = key[i] - 1u; kmn1 = kmn1 < k1 ? kmn1 : k1; }
        }
    }
#pragma unroll
    for (int o = 1; o < 64; o <<= 1) { const unsigned a_ = (unsigned)__shfl_xor((int)kmx, o), b_ = (unsigned)__shfl_xor((int)kmn1, o); kmx = kmx > a_ ? kmx : a_; kmn1 = kmn1 < b_ ? kmn1 : b_; }
    unsigned lo = (unsigned)__builtin_amdgcn_readfirstlane((int)(kmn1 + 1u)), hi = (unsigned)__builtin_amdgcn_readfirstlane((int)kmx); hi = hi == 0xFFFFFFFFu ? hi : hi + 1u;
    int clo = nvalid, chi = 0; bool interp = true;
#pragma unroll 1
    while (clo != 256 && hi - lo > 1u) {
        unsigned cand;
        if (interp) { const float f = ((float)(clo - 256) + 0.5f) / (float)(clo - chi); cand = lo + (unsigned)((float)(hi - lo) * f); }
        else cand = lo + ((hi - lo) >> 1);
        cand = cand <= lo ? lo + 1u : cand; cand = cand >= hi ? hi - 1u : cand;
        cand = (unsigned)__builtin_amdgcn_readfirstlane((int)cand);
        int cnt = 0;
#pragma unroll
        for (int g = 0; g < 8; ++g) {
            if (g < ngrp) {
#pragma unroll
                for (int i = 0; i < 8; ++i) cnt += __builtin_popcountll(__ballot(key[8 * g + i] >= cand));
            }
            __builtin_amdgcn_sched_barrier(0);
        }
        if (cnt >= 256) { lo = cand; clo = cnt; } else { hi = cand; chi = cnt; }
        interp = !interp;
    }
    const unsigned T = lo;
    int cgt = 0;
#pragma unroll
    for (int g = 0; g < 8; ++g) {
        if (g < ngrp) {
#pragma unroll
            for (int i = 0; i < 8; ++i) cgt += __builtin_popcountll(__ballot(key[8 * g + i] > T));
        }
        __builtin_amdgcn_sched_barrier(0);
    }
    const int need = 256 - cgt; int pos = 0, eqseen = 0;
#pragma unroll
    for (int g = 0; g < 8; ++g) {
        if (g < ngrp) {
#pragma unroll
            for (int i = 8 * g; i < 8 * g + 8; ++i) {
                const bool gt = key[i] > T, eq = key[i] == T;
                const unsigned long long meq = __ballot(eq);
                const int rank = eqseen + (int)__builtin_amdgcn_mbcnt_hi((unsigned)(meq >> 32), __builtin_amdgcn_mbcnt_lo((unsigned)meq, 0u));
                const bool take = gt || (eq && rank < need);
                const unsigned long long mt = __ballot(take);
                const int p = pos + (int)__builtin_amdgcn_mbcnt_hi((unsigned)(mt >> 32), __builtin_amdgcn_mbcnt_lo((unsigned)mt, 0u));
                if (take && p < 256) sel[p] = 64 * i + lane;
                pos += __builtin_popcountll(mt); eqseen += __builtin_popcountll(meq);
            }
        }
    }
}
__device__ __forceinline__ void phase_indexer(const Args& a, LAS unsigned char* lds, int G, int bx, const int wave, const bool do_topk) {
    unsigned char* ws_ = a.ws; OPAQUE_S(ws_); GAS unsigned char* ws = (GAS unsigned char*)ws_;
    const GAS bf16_t* qbuf = (const GAS bf16_t*)(ws + WS_QBUF); const GAS bf16_t* kidx = (const GAS bf16_t*)(ws + WS_KIDX); const GAS float* widx = (const GAS float*)(ws + WS_WIDX);
    GAS float* score = (GAS float*)(ws + WS_SCORE) + (size_t)bx * 16 * 4096; GAS int* sel = (GAS int*)(ws + WS_SEL);
    for (int u = bx; u < 256; u += G) {
        const int b = u >> 7, i0 = u & 127;
        for (int half = 0; half < 2; ++half) {
            const int lane = lane_id_(), tid = wave * 64 + lane, h = lane >> 5;
            const unsigned key = lane & 31, x = (key >> 1) & 7;
            const unsigned bbase = 128u * key + 16u * ((x & 6u) | ((unsigned)h ^ (x & 1u)));
            const int qg = half ? 255 - i0 : i0;
            const int tq = 16 * qg + 2 * wave; const size_t rowb = (size_t)b * SEQ;
            bf16x8 qa[2][4]; f32x4 wv[2][4];
#pragma unroll
            for (int q = 0; q < 2; ++q) { const GAS bf16_t* qp = qbuf + (rowb + tq + q) * QW + 4096 + (lane & 31) * 64 + 8 * h; const GAS float* wp = widx + (rowb + tq + q) * 32 + 4 * h;
#pragma unroll
                for (int s = 0; s < 4; ++s) qa[q][s] = *(const GAS bf16x8*)(qp + 16 * s);
#pragma unroll
                for (int g4 = 0; g4 < 4; ++g4) wv[q][g4] = *(const GAS f32x4*)(wp + 8 * g4); }
            const int kmax = 16 * qg + 15, ntile = kmax / 256 + 1;
            const GAS bf16_t* kg = kidx + rowb * 64 + tid * 8;
            u32x4 st[4];
#pragma unroll
            for (int i = 0; i < 4; ++i) st[i] = *(const GAS u32x4*)(kg + i * 4096);
            __syncthreads();
#pragma unroll
            for (int i = 0; i < 4; ++i) { const int c = tid + 512 * i, row = c >> 3, ch = c & 7; *(LAS u32x4*)(lds + row * 128 + ((ch ^ ((row >> 1) & 7)) << 4)) = st[i]; }
            __syncthreads();
            for (int kt = 0; kt < ntile; ++kt) {
                const int cur = kt & 1; const bool more = kt + 1 < ntile;
                if (more) {
#pragma unroll
                    for (int i = 0; i < 4; ++i) st[i] = *(const GAS u32x4*)(kg + (size_t)(kt + 1) * 16384 + i * 4096); }
                const LAS unsigned char* Kt = lds + cur * 32768;
                const int nkb = (kmax - 256 * kt) / 32 + 1 < 8 ? (kmax - 256 * kt) / 32 + 1 : 8;
#define IDX_LOAD(B, kb_) do { _Pragma("unroll") for (int s_ = 0; s_ < 4; ++s_) B[s_] = *(const LAS bf16x8*)(Kt + (bbase ^ (unsigned)(s_ << 5)) + 4096 * (kb_)); } while (0)
#define IDX_BLOCK(B, kb_) do { f32x16 acc0, acc1; \
                    _Pragma("unroll") for (int r = 0; r < 16; ++r) { acc0[r] = 0.f; acc1[r] = 0.f; } \
                    _Pragma("unroll") for (int s_ = 0; s_ < 4; ++s_) acc0 = __builtin_amdgcn_mfma_f32_32x32x16_bf16(qa[0][s_], B[s_], acc0, 0, 0, 0); \
                    _Pragma("unroll") for (int s_ = 0; s_ < 4; ++s_) acc1 = __builtin_amdgcn_mfma_f32_32x32x16_bf16(qa[1][s_], B[s_], acc1, 0, 0, 0); \
                    float sc0 = 0.f, sc1 = 0.f; \
                    _Pragma("unroll") for (int r = 0; r < 16; ++r) sc0 += wv[0][r >> 2][r & 3] * fmaxf(acc0[r], 0.f); \
                    _Pragma("unroll") for (int r = 0; r < 16; ++r) sc1 += wv[1][r >> 2][r & 3] * fmaxf(acc1[r], 0.f); \
                    sc0 = xhalf_sum(sc0); sc1 = xhalf_sum(sc1); \
                    if (lane < 32) { score[(size_t)(2 * wave) * 4096 + 256 * kt + 32 * (kb_) + lane] = sc0; score[(size_t)(2 * wave + 1) * 4096 + 256 * kt + 32 * (kb_) + lane] = sc1; } } while (0)
                { bf16x8 fa[4], fb[4];
                  IDX_LOAD(fa, 0);
                  for (int kb = 0; kb < nkb; kb += 2) {
                      if (kb + 1 < nkb) IDX_LOAD(fb, kb + 1);
                      IDX_BLOCK(fa, kb);
                      if (kb + 1 < nkb) { if (kb + 2 < nkb) IDX_LOAD(fa, kb + 2); IDX_BLOCK(fb, kb + 1); }
                  } }
#undef IDX_LOAD
#undef IDX_BLOCK
                if (more) {
#pragma unroll
                    for (int i = 0; i < 4; ++i) { const int c = tid + 512 * i, row = c >> 3, ch = c & 7; *(LAS u32x4*)(lds + (cur ^ 1) * 32768 + row * 128 + ((ch ^ ((row >> 1) & 7)) << 4)) = st[i]; } }
                __syncthreads();
            }
            VM_WAIT();
            __builtin_amdgcn_fence(__ATOMIC_ACQUIRE, "agent");
            VM_WAIT();
            if (do_topk) { const int lane2 = lane_id_();
#pragma unroll 1
              for (int q = 0; q < 2; ++q) topk_row(score + (size_t)(2 * wave + q) * 4096, sel + (rowb + tq + q) * 256, tq + q, lane2); }
        }
    }
    __syncthreads();
}

constexpr int DSA_LAT = 0, DSA_XCH = 65536, DSA_TAB = 131072, DSA_T5 = 143360, DSA_TCNT = 147456, DSA_MASKROW = 4352;
__device__ __forceinline__ void phase_dsa(const Args& a, LAS unsigned char* lds, int G, int bx, const int wave, const int mode) {
    (void)mode;
    const int lane = lane_id_(), tid = wave * 64 + lane, h = lane >> 5, team = wave >> 2, wq = wave & 3, ttid = tid & 255;
    unsigned char* ws_ = a.ws; OPAQUE_S(ws_); GAS unsigned char* ws = (GAS unsigned char*)ws_;
    const GAS bf16_t* qabs = (const GAS bf16_t*)(ws + WS_QABS); const GAS bf16_t* lat = (const GAS bf16_t*)(ws + WS_LAT); const GAS int* sel = (const GAS int*)(ws + WS_SEL); GAS bf16_t* olat = (GAS bf16_t*)(ws + WS_OLAT);
    LAS float* t5c = (LAS float*)(lds + DSA_T5);
    volatile LAS unsigned* tcnt = (volatile LAS unsigned*)(lds + DSA_TCNT + team * 64);
    __syncthreads();
    for (int i = tid; i < 1024; i += 512) t5c[i] = ((const GAS float*)karg_in(I_T5))[(i >> 5) * 64 + 32 + (i & 31)] * LOG2E;
    if (tid < 32) ((volatile LAS unsigned*)(lds + DSA_TCNT))[tid] = 0u;
    if (tid >= 64 && tid < 96) ((LAS float*)((LAS unsigned char*)t5c + DSA_MASKROW))[tid - 64] = -1e30f;
    __syncthreads();
    LAS unsigned char* latw = lds + DSA_LAT + wave * 8192; LAS unsigned char* xch = lds + DSA_XCH + team * 32768;
    LAS unsigned char* pbuf = xch + 16384; LAS unsigned char* mbuf = xch + 18432; LAS unsigned char* lbuf = xch + 18944;
    const unsigned qoff = (unsigned)(((wq >> 1) * 64 + lane) * 16 + (wq & 1) * 8);
    LAS unsigned char* tabs = lds + DSA_TAB + team * 6144;
#define TAB_SEL(p) ((LAS int*)(tabs + (p) * 3072))
#define TAB_BKT(p) ((LAS int*)(tabs + (p) * 3072 + 1024))
    const unsigned kbase = krow_base(lane), vbase = vt_base(lane);
    const float cs = 0.08838834764831845f * LOG2E;
    unsigned tepoch = 0u;
#define TEAM_BAR() do { asm volatile("s_waitcnt lgkmcnt(0)" ::: "memory"); ++tepoch; if (lane == 0) __hip_atomic_fetch_add((LAS unsigned*)tcnt, 1u, __ATOMIC_RELAXED, __HIP_MEMORY_SCOPE_WORKGROUP); \
        while (__builtin_amdgcn_readfirstlane((int)*tcnt) < (int)(4u * tepoch)) __builtin_amdgcn_s_sleep(1); asm volatile("" ::: "memory"); } while (0)
    const int gr = lane >> 4, gc = lane & 15;
    const unsigned wbase = 256u * gr + 16u * (gc ^ (gr << 2));
#define DSA_TABLES(p, qq, idxv) do { const int t_ = (qq) & 4095, ns_ = t_ + 1 < 256 ? t_ + 1 : 256; const bool valid_ = ttid < ns_; const int id_ = valid_ ? (idxv) : 0; \
        TAB_SEL(p)[ttid] = id_; TAB_BKT(p)[ttid] = valid_ ? 128 * t5_bucket_(t_ - id_) : DSA_MASKROW; } while (0)
#define DSA_SELLOAD(qq) ((ttid < ((((qq) & 4095) + 1 < 256) ? ((qq) & 4095) + 1 : 256)) ? sel[(size_t)(qq) * 256 + ttid] : 0)
#define DSA_QLOAD(qq) do { const GAS bf16_t* qp_ = qabs + (size_t)(qq) * 16384 + (lane & 31) * 512 + 128 * wq + 8 * h; _Pragma("unroll") for (int s_ = 0; s_ < 8; ++s_) qf[s_] = *(const GAS bf16x8*)(qp_ + 16 * s_); } while (0)
#define DSA_GATHER(ST, lr, tab, cc) do { _Pragma("unroll") for (int i = 0; i < 8; ++i) ST[i] = *(const GAS u32x4*)((lr) + (size_t)(tab)[32 * (cc) + gr + 4 * i] * 512); } while (0)
    int qp = bx, par = 0;
    bf16x8 qf[8]; u32x4 stA[8], stB[8];
    int nxt_idx = 0;
    { const int q0 = 2 * qp + team;
      DSA_TABLES(0, q0, sel[(size_t)q0 * 256 + ttid]);
      if (qp + G < 4096) nxt_idx = DSA_SELLOAD(q0 + 2 * G);
      DSA_QLOAD(q0);
      TEAM_BAR();
      const GAS bf16_t* lr0 = lat + (size_t)(q0 >> 12) * SEQ * 512 + 128 * wq + gc * 8;
      DSA_GATHER(stA, lr0, TAB_SEL(0), 0); DSA_GATHER(stB, lr0, TAB_SEL(0), 1); }
    for (; qp < 4096; qp += G, par ^= 1) {
        const int q = 2 * qp + team, b = q >> 12;
        const bool has_next = qp + G < 4096; const int qn = q + 2 * G;
        const LAS int* selP = TAB_SEL(par); const LAS int* bktP = TAB_BKT(par); const LAS int* selN = TAB_SEL(par ^ 1);
        const GAS bf16_t* lrow = lat + (size_t)b * SEQ * 512 + 128 * wq + gc * 8;
        const GAS bf16_t* lrowN = lat + (size_t)(qn >> 12) * SEQ * 512 + 128 * wq + gc * 8;
        f32x16 o[4];
#pragma unroll
        for (int c = 0; c < 4; ++c)
#pragma unroll
            for (int r = 0; r < 16; ++r) o[c][r] = 0.f;
        float m = -1e30f, l = 0.f;
#define DSA_CHUNK(ST, c) do { \
            _Pragma("unroll") for (int i = 0; i < 8; ++i) *(LAS u32x4*)(latw + (wbase ^ (unsigned)((i & 3) << 4)) + 1024 * i) = ST[i];        \
            if ((c) + 2 < 8) DSA_GATHER(ST, lrow, selP, (c) + 2); else if (has_next) DSA_GATHER(ST, lrowN, selN, (c) + 2 - 8);        \
            f32x16 sc[1]; \
            _Pragma("unroll") for (int r = 0; r < 16; ++r) sc[0][r] = 0.f; \
            _Pragma("unroll") for (int s_ = 0; s_ < 8; ++s_) { const bf16x8 af = *(const LAS bf16x8*)(latw + (kbase ^ (unsigned)(s_ << 5))); sc[0] = __builtin_amdgcn_mfma_f32_32x32x16_bf16(af, qf[s_], sc[0], 0, 0, 0); } \
            if ((c) == 7 && has_next) DSA_QLOAD(qn);            \
            LAS unsigned char* xc = xch + ((c) & 1) * 8192; \
            _Pragma("unroll") for (int g8 = 0; g8 < 2; ++g8) *(LAS bf16x8*)(xc + wq * 2048 + (g8 * 64 + lane) * 16) = pack8(sc[0], 8 * g8);        \
            TEAM_BAR();                                        \
              \
            float lg[4]; float mx; \
            { f32x4 v = {0.f, 0.f, 0.f, 0.f}; \
              _Pragma("unroll") for (int w = 0; w < 4; ++w) { const u32x2 pw = *(const LAS u32x2*)(xc + w * 2048 + qoff); v = v + (f32x4){bflo(pw.x), bfhi(pw.x), bflo(pw.y), bfhi(pw.y)}; } \
              const u32x4 bk4 = *(const LAS u32x4*)(bktP + 32 * (c) + 8 * wq + 4 * h); \
              _Pragma("unroll") for (int e = 0; e < 4; ++e) { const float bias = *(const LAS float*)((const LAS unsigned char*)t5c + bk4[e] + 4 * (lane & 31)); lg[e] = v[e] * cs + bias; } \
              mx = xhalf_max(fmaxf(fmaxf(lg[0], lg[1]), fmaxf(lg[2], lg[3]))); } \
            if ((c) == 0) {                                    \
                *(LAS float*)(mbuf + (lane & 31) * 16 + wq * 4) = mx; \
                TEAM_BAR(); \
                const f32x4 m4 = *(const LAS f32x4*)(mbuf + (lane & 31) * 16); m = fmaxf(fmaxf(m4[0], m4[1]), fmaxf(m4[2], m4[3])); \
            } \
              \
            { const float p0 = fast_exp2(fminf(lg[0] - m, 100.f)), p1 = fast_exp2(fminf(lg[1] - m, 100.f)), p2 = fast_exp2(fminf(lg[2] - m, 100.f)), p3 = fast_exp2(fminf(lg[3] - m, 100.f)); \
              l += (p0 + p1) + (p2 + p3); \
              *(LAS u32x2*)(pbuf + qoff) = (u32x2){cvtpk(p0, p1), cvtpk(p2, p3)}; \
              if ((c) != 0) *(LAS float*)(mbuf + (lane & 31) * 16 + wq * 4) = mx; } \
            TEAM_BAR();                                        \
            bf16x8 p[1][2]; \
            p[0][0] = *(const LAS bf16x8*)(pbuf + lane * 16); p[0][1] = *(const LAS bf16x8*)(pbuf + (64 + lane) * 16); \
            _Pragma("unroll") for (int cc = 0; cc < 4; ++cc) \
                _Pragma("unroll") for (int s_ = 0; s_ < 2; ++s_) { const bf16x8 af = vfrag2(latw, vbase, cc, 4096 * s_); o[cc] = __builtin_amdgcn_mfma_f32_32x32x16_bf16(af, p[0][s_], o[cc], 0, 0, 0); } \
            if ((c) != 0) {                                    \
                const f32x4 m4 = *(const LAS f32x4*)(mbuf + (lane & 31) * 16); const float mxa = fmaxf(fmaxf(m4[0], m4[1]), fmaxf(m4[2], m4[3])); \
                if (__any(mxa > m + 8.0f)) { const float mn = fmaxf(m, mxa), alpha = fast_exp2(m - mn); l *= alpha; m = mn; \
                    _Pragma("unroll") for (int cc = 0; cc < 4; ++cc) o[cc] = o[cc] * alpha; } \
            } \
            if ((c) == 3 && has_next) { DSA_TABLES(par ^ 1, qn, nxt_idx);        \
                if (qp + 2 * G < 4096) nxt_idx = DSA_SELLOAD(qn + 2 * G); } \
        } while (0)
        for (int c2 = 0; c2 < 8; c2 += 2) { DSA_CHUNK(stA, c2); DSA_CHUNK(stB, c2 + 1); }
#undef DSA_CHUNK
        l = xhalf_sum(l);
        *(LAS float*)(lbuf + (lane & 31) * 16 + wq * 4) = l;
        TEAM_BAR();
        const f32x4 l4 = *(const LAS f32x4*)(lbuf + (lane & 31) * 16);
        const float il = 1.0f / ((l4[0] + l4[1]) + (l4[2] + l4[3]));
        GAS bf16_t* op = olat + (size_t)q * 16384 + (lane & 31) * 512 + 128 * wq + 4 * h;
#pragma unroll
        for (int cc = 0; cc < 4; ++cc)
#pragma unroll
            for (int g4 = 0; g4 < 4; ++g4) { u32x2 w; w.x = cvtpk(o[cc][4 * g4] * il, o[cc][4 * g4 + 1] * il); w.y = cvtpk(o[cc][4 * g4 + 2] * il, o[cc][4 * g4 + 3] * il); *(GAS u32x2*)(op + 32 * cc + 8 * g4) = w; }
    }
    __syncthreads();
#undef TEAM_BAR
#undef TAB_SEL
#undef TAB_BKT
#undef DSA_TABLES
#undef DSA_SELLOAD
#undef DSA_QLOAD
#undef DSA_GATHER
}

constexpr int PH_FINAL = 50, NPH = PH_FINAL + 1;

struct TJob { int in_id; long src_lstride; int ldsrc, K, src_col0, ncols; long dst_off  ; int ldt, dst_row0, gain_id; long gain_lstride, gain_off0; int lsel, flags; };
constexpr int NTJ_E = 12, NTJ_O = 11;
__constant__ TJob g_tj_even[NTJ_E] = {
#define EWIN_JOB(c0, n, r0) {I_EWIN, (long)4096 * 12816, 12816, 4096, c0, n, (long)WS_EWIN, 4096, r0, I_NORMG, (long)2 * 4096, 0, 0, 2}
    EWIN_JOB(0, 2048, E_QA), EWIN_JOB(2048, 2048, E_KA), EWIN_JOB(4096, 2048, E_VA), EWIN_JOB(6160, 2048, E_GA), EWIN_JOB(8208, 2048, E_QB),
    EWIN_JOB(10768, 2048, E_GB), EWIN_JOB(10256, 256, E_KB), EWIN_JOB(10512, 256, E_VB), EWIN_JOB(6144, 16, E_FA),
    {I_EWOUT, (long)4096 * 4096, 4096, 4096, 0, 4096, (long)WS_EWOUT, 4096, 0, -1, 0, 0, 0, 2},
    {I_PWGATE, (long)4096 * 4096, 4096, 4096, 0, 4096, (long)WS_EGATE, 4096, 0, I_PNORMG, (long)4096, 0, 1, 2},
    {I_PWPROJ, (long)256 * 4096, 4096, 256, 0, 4096, (long)WS_EPROJ, 256, 0, -1, 0, 0, 1, 0},
};
__constant__ TJob g_tj_odd[NTJ_O] = {
#define OWIN_JOB(c0, n, r0) {I_OWIN, (long)4096 * 5728, 5728, 4096, c0, n, (long)WS_OWIN, 4096, r0, I_NORMG, (long)2 * 4096, 4096, 0, 0}
    {I_OWIN, (long)4096 * 5728, 5728, 4096, 1632, 4096, (long)WS_OWIN8, 4096, 0, I_NORMG, (long)2 * 4096, 4096, 0, 2},
    OWIN_JOB(0, 1024, 0), OWIN_JOB(1024, 512, 1024), OWIN_JOB(1536, 64, 1536), OWIN_JOB(1600, 32, 1600),
    {I_OWOUT, (long)4096 * 4096, 4096, 4096, 0, 4096, (long)WS_OWOUT, 4096, 0, -1, 0, 0, 0, 2},
    {I_PWGATE, (long)4096 * 4096, 4096, 4096, 0, 4096, (long)WS_OGATE, 4096, 0, I_PNORMG, (long)4096, 0, 1, 2},
    {I_PWPROJ, (long)256 * 4096, 4096, 256, 0, 4096, (long)WS_OPROJ, 256, 0, -1, 0, 0, 1, 0},
    {I_OWUQ,  (long)1024 * 4096, 4096, 1024, 0, 4096, (long)WS_OWUQ, 1024, 0,    -1, 0, 0, 0, 0},
    {I_OWUQI, (long)1024 * 2048, 2048, 1024, 0, 2048, (long)WS_OWUQ, 1024, 4096, -1, 0, 0, 0, 0},
    {I_OWUV, (long)512 * 4096, 4096, 512, 0, 4096, (long)WS_OWUV, 1024, 0, -1, 0, 0, 0, 1},
};

__device__ __forceinline__ void transpose_item(const Args& a, GAS unsigned char* ws, const TJob& jb, int L, int item, LAS float* scr, int lane) {
    const int ncb = (jb.ncols + 31) >> 5, kb = item / ncb, nb = item % ncb, k0 = 64 * kb, n0 = 32 * nb;
    const int li = jb.lsel ? L : (L >> 1);
    const GAS float* W = (const GAS float*)karg_in(jb.in_id) + (size_t)li * jb.src_lstride;
    const GAS float* gain = jb.gain_id >= 0 ? (const GAS float*)karg_in(jb.gain_id) + (size_t)li * jb.gain_lstride + jb.gain_off0 : nullptr;
    const int r8 = lane >> 3, c4 = lane & 7; const bool cv = (n0 + 4 * c4) < jb.ncols;
    f32x4 v[8];
    const GAS float* src = W + (size_t)(k0 + r8) * jb.ldsrc + jb.src_col0 + n0 + 4 * c4;
#pragma unroll
    for (int i = 0; i < 8; ++i) v[i] = cv ? __builtin_nontemporal_load((const GAS f32x4*)(src + (size_t)(8 * i) * jb.ldsrc)) : (f32x4){0.f, 0.f, 0.f, 0.f};
    const int c = lane & 7;
    f32x4 g0 = {1.f, 1.f, 1.f, 1.f}, g1 = g0;
    if (gain) { g0 = *(const GAS f32x4*)(gain + k0 + 8 * c); g1 = *(const GAS f32x4*)(gain + k0 + 8 * c + 4); }
#pragma unroll
    for (int i = 0; i < 8; ++i) { LAS float* d = scr + (8 * i + r8) * 33 + 4 * c4; d[0] = v[i][0]; d[1] = v[i][1]; d[2] = v[i][2]; d[3] = v[i][3]; }
    LDS_WAIT(); asm volatile("" ::: "memory");
    GAS bf16_t* WT = (GAS bf16_t*)(ws + jb.dst_off);
#pragma unroll
    for (int j = 0; j < 4; ++j) { const int n = (lane >> 3) + 8 * j; const LAS float* s = scr + (8 * c) * 33 + n;
        int drow = jb.dst_row0 + n0 + n, dk = k0 + 8 * c;
        if (jb.flags & 2) {
            u32x2 q; q.x = pack4_q8_(s[0 * 33] * g0[0] * W8_SCALE, s[1 * 33] * g0[1] * W8_SCALE, s[2 * 33] * g0[2] * W8_SCALE, s[3 * 33] * g0[3] * W8_SCALE);
            q.y = pack4_q8_(s[4 * 33] * g1[0] * W8_SCALE, s[5 * 33] * g1[1] * W8_SCALE, s[6 * 33] * g1[2] * W8_SCALE, s[7 * 33] * g1[3] * W8_SCALE);
            *(GAS u32x2*)((GAS unsigned char*)ws + jb.dst_off + (size_t)drow * jb.ldt + dk) = q; continue; }
        u32x4 o; o.x = cvtpk(s[0 * 33] * g0[0], s[1 * 33] * g0[1]); o.y = cvtpk(s[2 * 33] * g0[2], s[3 * 33] * g0[3]); o.z = cvtpk(s[4 * 33] * g1[0], s[5 * 33] * g1[1]); o.w = cvtpk(s[6 * 33] * g1[2], s[7 * 33] * g1[3]);
        if (jb.flags & 1) { const int col = n0 + n, h = col >> 7, d = col & 127; drow = (h >> 1) * 256 + (h & 1) * 128 + d; dk = (h & 1) * 512 + k0 + 8 * c; }
        *(GAS u32x4*)(WT + (size_t)drow * jb.ldt + dk) = o; }
    LDS_WAIT(); asm volatile("" ::: "memory");
}

__device__ __forceinline__ void convert_layer_weights(const Args& a, int L, LAS unsigned char* lds, int gw, int NGW, int wave, int part) {
    const int lane = lane_id_();
    unsigned char* ws_ = a.ws; OPAQUE_S(ws_); GAS unsigned char* ws = (GAS unsigned char*)ws_;
    LAS float* scr = (LAS float*)(lds + wave * 16384);
    const bool odd = (L & 1) != 0; const int nj = odd ? NTJ_O : NTJ_E;
    int jstart = 0;
    for (int j = 0; j < nj; ++j) {
        const TJob jb = odd ? g_tj_odd[j] : g_tj_even[j];
        if (part != 0 && ((part == 1) != (jb.in_id == I_OWIN))) continue;
        const int nitems = (jb.K >> 6) * ((jb.ncols + 31) >> 5);
        const int first = (gw - (jstart % NGW) + NGW) % NGW;
        for (int it = first; it < nitems; it += NGW) transpose_item(a, ws, jb, L, it, scr, lane);
        jstart += nitems;
    }
    if (part == 1) return;
    if (!odd) {
        GAS u32x4* z = (GAS u32x4*)(ws + WS_EWIN + (size_t)12832 * 4096); const int n = 224 * 4096 / 16;
        for (int i = gw * 64 + lane; i < n; i += NGW * 64) z[i] = zero4_();
    } else {
        GAS u32x4* z2 = (GAS u32x4*)(ws + WS_OWIN + (size_t)1632 * 4096 * 2); const int n2 = 160 * 4096 * 2 / 16;
        for (int i = gw * 64 + lane; i < n2; i += NGW * 64) z2[i] = zero4_();
        GAS u32x4* z3 = (GAS u32x4*)(ws + WS_OWUV);
        for (int i = gw * 64 + lane; i < 4096 * 64; i += NGW * 64) { const int r = i >> 6, c16 = i & 63; const int zh = ((r >> 7) & 1) ^ 1; z3[(size_t)r * 128 + zh * 64 + c16] = zero4_(); }
        const GAS f32x4* s = (const GAS f32x4*)(((const GAS float*)karg_in(I_OWUK)) + (size_t)(L >> 1) * 512 * 4096); GAS u32x2* d = (GAS u32x2*)(ws + WS_OWUK); const int n = 512 * 4096 / 4;
        for (int i = gw * 64 + lane; i < n; i += NGW * 64) { const f32x4 v = __builtin_nontemporal_load(s + i); d[i] = (u32x2){cvtpk(v[0], v[1]), cvtpk(v[2], v[3])}; }
    }
}

__device__ __forceinline__ void phase_convert(const Args& a, LAS unsigned char* lds, int gw, int NGW, int wave) {
    const int lane = lane_id_();
    unsigned char* ws_ = a.ws; OPAQUE_S(ws_); GAS unsigned char* ws = (GAS unsigned char*)ws_;
    {
        const GAS f32x4* s2 = (const GAS f32x4*)((const GAS float*)karg_in(I_P)); GAS u32x2* d2 = (GAS u32x2*)(ws + WS_PB); const int n2 = 4 * M * 256 / 4;
        for (int i = gw * 64 + lane; i < n2; i += NGW * 64) { const f32x4 v = __builtin_nontemporal_load(s2 + i); d2[i] = (u32x2){cvtpk(v[0], v[1]), cvtpk(v[2], v[3])}; }
    }
    {
        const GAS float* x = ((const GAS float*)karg_in(I_X)); GAS unsigned char* HQ = ws + WS_HQ; GAS float* asc = (GAS float*)(ws + WS_ASCALE); GAS u64* ss = (GAS u64*)(ws + WS_SUMSQ);
        f32x4 v[16], vn[16];
        if (gw < M) { const GAS f32x4* xr = (const GAS f32x4*)(x + (size_t)gw * DM);
#pragma unroll
            for (int j = 0; j < 16; ++j) v[j] = xr[lane + 64 * j]; }
        for (int row = gw; row < M; row += NGW) {
            GAS unsigned* qr = (GAS unsigned*)(HQ + (size_t)row * DM); GAS u32x2* hr = (GAS u32x2*)(ws + WS_H + (size_t)row * DM * 2);
            if (row + NGW < M) { const GAS f32x4* xn = (const GAS f32x4*)(x + (size_t)(row + NGW) * DM);
#pragma unroll
                for (int j = 0; j < 16; ++j) vn[j] = xn[lane + 64 * j]; }
            float s = 0.f, am = 0.f;
#pragma unroll
            for (int j = 0; j < 16; ++j) { s += (v[j][0] * v[j][0] + v[j][1] * v[j][1]) + (v[j][2] * v[j][2] + v[j][3] * v[j][3]); am = fmaxf(fmaxf(am, fmaxf(fabsf(v[j][0]), fabsf(v[j][1]))), fmaxf(fabsf(v[j][2]), fabsf(v[j][3]))); }
            s = wave_sum(s);
#pragma unroll
            for (int o = 1; o < 64; o <<= 1) am = fmaxf(am, __shfl_xor(am, o));
            am = fmaxf(am, 1e-20f); const float qs = 127.0f / am;
#pragma unroll
            for (int j = 0; j < 16; ++j) { qr[lane + 64 * j] = pack4_q8_(v[j][0] * qs, v[j][1] * qs, v[j][2] * qs, v[j][3] * qs); hr[lane + 64 * j] = (u32x2){cvtpk(v[j][0], v[j][1]), cvtpk(v[j][2], v[j][3])}; }
            if (lane == 0) { ss[row] = ss_fix(s); asc[row] = am * (1.0f / 127.0f); }
#pragma unroll
            for (int j = 0; j < 16; ++j) v[j] = vn[j];
        }
    }
}

__device__ __forceinline__ void phase_quant_yin(const Args& a, int gw, int NGW) {
    const int lane = lane_id_();
    unsigned char* ws_ = a.ws; OPAQUE_S(ws_); GAS unsigned char* ws = (GAS unsigned char*)ws_;
    const GAS bf16_t* yin = (const GAS bf16_t*)(ws + WS_YIN); GAS unsigned char* yq = ws + WS_YQ; GAS float* asc = (GAS float*)(ws + WS_ASCALEY);
    u32x4 w[8], wn[8];
    if (gw < M) { const GAS u32x4* yr = (const GAS u32x4*)(yin + (size_t)gw * DM);
#pragma unroll
        for (int j = 0; j < 8; ++j) w[j] = yr[lane + 64 * j]; }
    for (int row = gw; row < M; row += NGW) {
        GAS u32x2* qr = (GAS u32x2*)(yq + (size_t)row * DM);
        if (row + NGW < M) { const GAS u32x4* yn = (const GAS u32x4*)(yin + (size_t)(row + NGW) * DM);
#pragma unroll
            for (int j = 0; j < 8; ++j) wn[j] = yn[lane + 64 * j]; }
        float am = 0.f;
#pragma unroll
        for (int j = 0; j < 8; ++j)
            am = fmaxf(am, fmaxf(fmaxf(fmaxf(fabsf(bflo(w[j].x)), fabsf(bfhi(w[j].x))), fmaxf(fabsf(bflo(w[j].y)), fabsf(bfhi(w[j].y)))), fmaxf(fmaxf(fabsf(bflo(w[j].z)), fabsf(bfhi(w[j].z))), fmaxf(fabsf(bflo(w[j].w)), fabsf(bfhi(w[j].w))))));
#pragma unroll
        for (int o = 1; o < 64; o <<= 1) am = fmaxf(am, __shfl_xor(am, o));
        am = fmaxf(am, 1e-20f); const float qs = 127.0f / am;
#pragma unroll
        for (int j = 0; j < 8; ++j) { u32x2 q; q.x = pack4_q8_(bflo(w[j].x) * qs, bfhi(w[j].x) * qs, bflo(w[j].y) * qs, bfhi(w[j].y) * qs); q.y = pack4_q8_(bflo(w[j].z) * qs, bfhi(w[j].z) * qs, bflo(w[j].w) * qs, bfhi(w[j].w) * qs); qr[lane + 64 * j] = q; }
        if (lane == 0) asc[row] = am * (1.0f / 127.0f);
#pragma unroll
        for (int j = 0; j < 8; ++j) w[j] = wn[j];
    }
}
__device__ __forceinline__ void phase_final(const Args& a, int gw, int NGW) {
    const int lane = lane_id_();
    unsigned char* ws_ = a.ws; OPAQUE_S(ws_); GAS unsigned char* ws = (GAS unsigned char*)ws_;
    const GAS bf16_t* H = (const GAS bf16_t*)(ws + WS_H); const GAS u64* ss = (const GAS u64*)(ws + WS_SUMSQ) + 4 * M; const GAS f32x4* g = (const GAS f32x4*)((const GAS float*)karg_in(I_FINALG));
    f32x4 gg[16]; u32x2 hw[16], hn[16]; u64 sv = 0, svn = 0;
#pragma unroll
    for (int j = 0; j < 16; ++j) gg[j] = g[lane + 64 * j];
    if (gw < M) { const GAS u32x2* hr = (const GAS u32x2*)(H + (size_t)gw * DM); sv = ss[gw];
#pragma unroll
        for (int j = 0; j < 16; ++j) hw[j] = hr[lane + 64 * j]; }
    for (int row = gw; row < M; row += NGW) {
        if (row + NGW < M) { const GAS u32x2* hr = (const GAS u32x2*)(H + (size_t)(row + NGW) * DM); svn = ss[row + NGW];
#pragma unroll
            for (int j = 0; j < 16; ++j) hn[j] = hr[lane + 64 * j]; }
        const float r = 1.0f / sqrtf((float)sv * (1.0f / 16777216.0f) * (1.0f / 4096.0f) + EPS);
        GAS f32x4* orow = (GAS f32x4*)(a.out + (size_t)row * DM);
#pragma unroll
        for (int j = 0; j < 16; ++j) { const f32x4 v = (f32x4){bflo(hw[j].x), bfhi(hw[j].x), bflo(hw[j].y), bfhi(hw[j].y)}; orow[lane + 64 * j] = v * r * gg[j]; }
#pragma unroll
        for (int j = 0; j < 16; ++j) hw[j] = hn[j];
        sv = svn;
    }
}

__global__ void __launch_bounds__(512, 2) fwd(Args args) {
    extern __shared__ __attribute__((aligned(16))) unsigned char lds_raw[];
    LAS unsigned char* lds = (LAS unsigned char*)lds_raw;
    volatile LAS unsigned* MISC = (volatile LAS unsigned*)(lds + MISC_OFF);
    int wave0_ = __builtin_amdgcn_readfirstlane((int)threadIdx.x >> 6);
    asm volatile("" : "+s"(wave0_));
    const int wave0 = wave0_;
    if (wave0 == 0) { const int l_ = lane_id_(); MISC[l_] = (l_ == 16) ? (unsigned)gridDim.x : (l_ == 17) ? (unsigned)blockIdx.x : (l_ == 18) ? (unsigned)args.ph_lo : (l_ == 19) ? (unsigned)args.ph_hi : 0u; }
    __syncthreads();
#define KS_RD(i) ((int)__builtin_amdgcn_readfirstlane((int)*(volatile LAS unsigned*)(size_t)(opaque_vu_((unsigned)MISC_OFF) + 4u * (i))))
#define KS_G0 KS_RD(16)
#define KS_BX0 KS_RD(17)
#define KS_LO KS_RD(18)
#define KS_HI KS_RD(19)
    if (KS_HI - KS_LO > 1) (void)xcd_barrier_post((unsigned*)(args.ws + WS_CTL), MISC + 8, wave0);
#define IN(k) (KS_LO <= (k) && (k) < KS_HI)
#define PHASE_LOCALS() int wave = wave0, G = KS_G0, bx = KS_BX0; asm volatile("" : "+s"(wave), "+s"(G), "+s"(bx)); const int gw = bx * 8 + wave, NGW = G * 8; (void)gw; (void)NGW; \
        unsigned char* ws = args.ws; OPAQUE_S(ws); u64* sumsq = (u64*)(ws + WS_SUMSQ); (void)sumsq; \
        bf16_t* hb_cur = (bf16_t*)(ws + (hbswap ? WS_HBB : WS_HBA)); bf16_t* hb_oth = (bf16_t*)(ws + (hbswap ? WS_HBA : WS_HBB)); (void)hb_cur; (void)hb_oth
#undef SEAM
#define SEAM(k) do { if (IN(k) && IN((k) + 1)) { int wave = wave0; asm volatile("" : "+s"(wave)); unsigned char* _w = args.ws; OPAQUE_S(_w); XcdBarrier _b; _b.bar = (unsigned*)(_w + WS_CTL); _b.x = xb_xcc_id(); _b.st = (volatile LAS unsigned*)(lds + MISC_OFF) + 8; xcd_barrier(_b, wave); } } while (0)
    for (int LL = -2; LL < 8; ++LL) {
        const int L = LL >> 1, st_ = LL & 1;
        const int base = 10 * (L + 1); const bool odd = L >= 0 && (L & 1) != 0;
        const bool mixed = MK_STAGE >= (odd ? 3 : 2);
        const bool hbswap = (MK_STAGE < 3) && ((MK_STAGE == 1 && (L & 1)) || (MK_STAGE == 2 && L >= 2));
        if (st_ == 0) {
        if (IN(base + 0) && mixed && L >= 0)
#pragma unroll 1
        for (int rep_ = 0; rep_ < (((MK_DUP & (1024 | (1 << 26))) && !odd) || ((MK_DUP & 2048) && odd) ? 2 : 1); ++rep_) {
            PHASE_LOCALS();
            if (odd) {
                {
                    pg8::Gemm g{(const bf16_t*)(ws + WS_HQ), (const bf16_t*)(ws + WS_OWIN8), DM, DM, DM, 32, 16, 1, 0, 0};
                    pg8::Sched S; S.init(g, G, bx);
                    pg8::EpiBf16Q E{(bf16_t*)(ws + WS_PROJ), ON, sumsq + L * M, (const float*)(ws + WS_ASCALE), nullptr, 0};
                    pg8::gemm_phase<pg8::EpiBf16Q, true>(lds, g, S, E, wave); }
                {
                    PHASE_LOCALS();
                    pg8::Gemm g{(const bf16_t*)(ws + WS_H), (const bf16_t*)(ws + WS_OWIN), DM, DM, DM, 32, 7, 1, 0, 0};
                    pg8::Sched S; S.init(g, G, bx);
                    pg8::EpiBf16 E{(bf16_t*)(ws + WS_PROJ) + 4096, ON, 0, sumsq + L * M};
                    pg8::gemm_phase(lds, g, S, E, wave); }
            } else {
                pg8::Gemm g{(const bf16_t*)(ws + WS_HQ), (const bf16_t*)(ws + WS_EWIN), DM, DM, DM, 32, EN / 256, 1, 0, 0};
                pg8::Sched S; S.init(g, G, bx);
                pg8::EpiBf16Q E{(bf16_t*)(ws + WS_PROJ), EN, sumsq + L * M, (const float*)(ws + WS_ASCALE), (u64*)(ws + WS_KN) + (size_t)(L >> 1) * 16 * M, ((MK_DUP & (1 << 26)) && rep_ == 0) ? 1 : 0};
                pg8::gemm_phase<pg8::EpiBf16Q, true>(lds, g, S, E, wave);
            }
        }
        } else if (IN(base + 1)) {
            PHASE_LOCALS();
            if (mixed && !odd && L >= 0) { phase_even_attn(args, L >> 1, lds, G, bx, wave, 3); if (MK_DUP & 1) phase_even_attn(args, L >> 1, lds, G, bx, wave, 3); if (MK_DUP & 32) phase_even_attn(args, L >> 1, lds, G, bx, wave, 1); if (MK_DUP & 64) phase_even_attn(args, L >> 1, lds, G, bx, wave, 2); }
            if (mixed && odd) for (int rep_ = 0; rep_ < ((MK_DUP & 65536) ? 2 : 1); ++rep_) phase_odd_norms(args, L >> 1, gw, NGW);
            __syncthreads();
            if (L < 0) for (int rep_ = 0; rep_ < ((MK_DUP & 262144) ? 2 : 1); ++rep_) phase_convert(args, lds, gw, NGW, wave);
        }
        { const bool go_ = st_ == 0 ? (IN(base + 0) && mixed && L >= 0 && !odd && L < 3) : (IN(base + 1) && L < 3);
          if (go_) {
            PHASE_LOCALS();
            const int tail_ = (L >= 0 && !odd) ? (32 * (EN / 256)) % G : 0;
            int cgw_ = gw, cn_ = NGW, part_ = tail_ > 0 ? 2 : 0;
            if (st_ == 0) { part_ = (tail_ > 0 && bx >= tail_) ? 1 : -1; cgw_ = (bx - tail_) * 8 + wave; cn_ = (G - tail_) * 8; }
            asm volatile("" : "+s"(cgw_), "+s"(cn_), "+s"(part_));
            if (part_ >= 0) { __syncthreads(); convert_layer_weights(args, L + 1, lds, cgw_, cn_, wave, part_); __syncthreads(); }
          } }
        if (st_ == 0) { if (L >= 0) SEAM(base + 0); continue; }
        SEAM(base + 1);
        if (mixed && odd) {
            if (IN(base + 2))
#pragma unroll 1
            for (int rep_ = 0; rep_ < ((MK_DUP & 4096) ? 2 : 1); ++rep_) {
                PHASE_LOCALS();
                pg8::Gemm g{(const bf16_t*)(ws + WS_CQN), (const bf16_t*)(ws + WS_OWUQ), 1024, 1024, 1024, 32, QW / 256, 1, 0, 0};
                pg8::Sched S; S.init(g, G, bx);
                pg8::EpiBf16 E{(bf16_t*)(ws + WS_QBUF), QW, 0, nullptr};
                pg8::gemm_phase(lds, g, S, E, wave);
            }
            SEAM(base + 2);
            if (IN(base + 3)) {
#pragma unroll 1
                for (int rep_ = 0; rep_ < ((MK_DUP & 8192) ? 2 : 1); ++rep_) { PHASE_LOCALS();
                  pg8::Gemm g{(const bf16_t*)(ws + WS_QBUF), (const bf16_t*)(ws + WS_OWUK), QW, 4096, 128, 32, 2, 32, 128, 128};
                  pg8::Sched S; S.init(g, G, bx);
                  pg8::EpiBf16 E{(bf16_t*)(ws + WS_QABS), 16384, 512, nullptr};
                  pg8::gemm_phase(lds, g, S, E, wave); }
                { PHASE_LOCALS(); if (MK_DUP & 128) phase_indexer(args, lds, G, bx, wave, false); phase_indexer(args, lds, G, bx, wave, true); if (MK_DUP & 2) phase_indexer(args, lds, G, bx, wave, true); }
            }
            SEAM(base + 3);
            if (IN(base + 4)) { PHASE_LOCALS(); phase_dsa(args, lds, G, bx, wave, 0); if (MK_DUP & 4) phase_dsa(args, lds, G, bx, wave, 0); }
            SEAM(base + 4);
            if (IN(base + 5))
#pragma unroll 1
            for (int rep_ = 0; rep_ < ((MK_DUP & 16384) ? 2 : 1); ++rep_) {
                PHASE_LOCALS();
                pg8::Gemm g{(const bf16_t*)(ws + WS_OLAT), (const bf16_t*)(ws + WS_OWUV), 16384, 1024, 1024, 32, 1, 16, 1024, (size_t)256 * 1024};
                pg8::Sched S; S.init(g, G, bx);
                pg8::EpiOGate E{(bf16_t*)(ws + WS_YIN), (const bf16_t*)(ws + WS_PROJ) + O_GC, ON};
                pg8::gemm_phase(lds, g, S, E, wave);
            }
            SEAM(base + 5);
        }
        const int phq = odd ? base + 6 : base + 2, ph5 = phq + 1, ph6 = ph5 + 1;
        if (IN(phq) && L >= 0) for (int rep_ = 0; rep_ < ((MK_DUP & 32768) ? 2 : 1); ++rep_) { PHASE_LOCALS(); phase_quant_yin(args, gw, NGW); }
        if (L >= 0) SEAM(phq);
        if (IN(ph5) && L >= 0) {
            if (mixed) {
                PHASE_LOCALS();
                pg8::Gemm g{(const bf16_t*)(ws + WS_YQ), (const bf16_t*)(ws + (odd ? WS_OWOUT : WS_EWOUT)), DM, DM, DM, 32, 16, 1, 0, 0};
                pg8::Sched S; S.init(g, G, bx);
                pg8::EpiResid E{(const bf16_t*)(ws + WS_H), (bf16_t*)(ws + WS_H), (signed char*)(ws + WS_HBB), (float*)(ws + WS_ASCALE1), sumsq + L * M, sumsq + (5 + L) * M, (const float*)(ws + WS_ASCALEY)};
                pg8::gemm_phase<pg8::EpiResid, true>(lds, g, S, E, wave);
            }
#pragma unroll 1
            for (int rep_ = 0; rep_ < ((MK_DUP & 131072) ? 2 : 1); ++rep_) {
                PHASE_LOCALS();
                pg8::Gemm g{(const bf16_t*)(ws + WS_PB) + (size_t)L * M * 256, (const bf16_t*)(ws + (odd ? WS_OPROJ : WS_EPROJ)), 256, 256, 256, 32, 16, 1, 0, 0};
                pg8::Sched S; S.init(g, G, bx);
                pg8::EpiBf16 E{(bf16_t*)(ws + WS_PP), DM, 0, nullptr};
                pg8::gemm_phase(lds, g, S, E, wave);
            }
        }
        if (L >= 0) SEAM(ph5);
        if (IN(ph6) && L >= 0) {
            PHASE_LOCALS();
            pg8::Gemm g{(const bf16_t*)(ws + WS_HBB), (const bf16_t*)(ws + (odd ? WS_OGATE : WS_EGATE)), DM, DM, DM, 32, 16, 1, 0, 0};
            pg8::Sched S; S.init(g, G, bx);
            pg8::EpiGate E{(bf16_t*)(ws + WS_H), (const bf16_t*)(ws + WS_PP), sumsq + (mixed ? (5 + L) : L) * M, sumsq + (L + 1) * M, (L < 3) ? (signed char*)(ws + WS_HQ) : nullptr, (float*)(ws + WS_ASCALE), (const float*)(ws + WS_ASCALE1)};
            pg8::gemm_phase<pg8::EpiGate, true>(lds, g, S, E, wave);
        }
        if (L >= 0) SEAM(ph6);
    }
    if (IN(PH_FINAL)) for (int rep_ = 0; rep_ < ((MK_DUP & 524288) ? 2 : 1); ++rep_) phase_final(args, KS_BX0 * 8 + wave0, KS_G0 * 8);
#undef IN
#undef SEAM
}

extern "C" void kernel_launch(void* const* d_in, const int* in_sizes, int n_in, void* d_out, int out_size, void* d_ws, size_t ws_size, hipStream_t stream) {
    static int grid = 0;
    if (grid == 0) {
        if (n_in != 22 || out_size != M * DM || ws_size < WS_END) { fprintf(stderr, "kernel_launch: unexpected shapes (n_in %d out %d ws %zu, need %zu)\n", n_in, out_size, ws_size, (size_t)WS_END); grid = -1; return; }
        int dev = 0, cus = 0, per_cu = 0;
        if (hipGetDevice(&dev) != hipSuccess || hipDeviceGetAttribute(&cus, hipDeviceAttributeMultiprocessorCount, dev) != hipSuccess) { grid = -1; return; }
        if (hipFuncSetAttribute((const void*)fwd, hipFuncAttributeMaxDynamicSharedMemorySize, LDS_BYTES) != hipSuccess) { fprintf(stderr, "kernel_launch: hipFuncSetAttribute failed\n"); grid = -1; return; }
        if (hipOccupancyMaxActiveBlocksPerMultiprocessor(&per_cu, (const void*)fwd, 512, LDS_BYTES) != hipSuccess || per_cu < 1) { fprintf(stderr, "kernel_launch: occupancy query says %d\n", per_cu); }
        (void)hipGetLastError();
        grid = cus;
    }
    if (grid < 0) return;
    if (hipMemsetAsync((char*)d_ws + WS_CTL, 0, WS_ZERO_BYTES, stream) != hipSuccess) return;
    Args a{};
    for (int i = 0; i < 22; ++i) a.in[i] = (const float*)d_in[i];
    a.out = (float*)d_out; a.ws = (unsigned char*)d_ws;
#if MK_ONE_LAUNCH
    a.ph_lo = 0; a.ph_hi = NPH;
    hipLaunchKernelGGL(fwd, dim3(grid), dim3(512), LDS_BYTES, stream, a);
#else
    for (int ph = 0; ph < NPH; ++ph) {
        if (ph < PH_FINAL) { const int L = ph / 10 - 1, k = ph % 10; if (L < 0 && k != 1) continue; if (L >= 0 && !(L & 1) && k >= 5) continue; if (L >= 0 && (L & 1) && k >= 9) continue; }
        a.ph_lo = ph; a.ph_hi = ph + 1;
        hipLaunchKernelGGL(fwd, dim3(grid), dim3(512), LDS_BYTES, stream, a);
    }
#endif
}
```
